# Optimizing an MI355X kernel written in HIP

```python
import math
import jax
import jax.numpy as jnp
from jax import lax
import numpy as np

D_MODEL = 2048
BATCH = 16
SEQ = 2048
DEPTH = 2

GRID_W = 64
CTX_LEN = 256
HEAD_DIM = 128
MIX_HEADS = D_MODEL // HEAD_DIM
ROPE_THETA = 10000.0
SCALE = HEAD_DIM ** -0.5
NEG_INF = -1e30
A_HEADS = MIX_HEADS // 2
A_KV_HEADS = A_HEADS // 4
A_WINDOW = 128
A_BLOCK = 128
B_HEADS = MIX_HEADS - A_HEADS
NA_ROWS = 8
NA_COLS = 16
C_HEADS = MIX_HEADS // 2
C_KV_HEADS = C_HEADS // 4
D_HEADS = (MIX_HEADS - C_HEADS) // 2
Q_BLOCK = 128
EVEN_SPLITS = (A_HEADS * HEAD_DIM, A_KV_HEADS * HEAD_DIM, A_KV_HEADS * HEAD_DIM,
               B_HEADS * HEAD_DIM, B_HEADS * HEAD_DIM, B_HEADS * HEAD_DIM)
ODD_SPLITS = (C_HEADS * HEAD_DIM, C_KV_HEADS * HEAD_DIM, C_KV_HEADS * HEAD_DIM,
              D_HEADS * 2 * HEAD_DIM, D_HEADS * 2 * HEAD_DIM, D_HEADS * 2 * HEAD_DIM)
EVEN_OUT = (A_HEADS + B_HEADS) * HEAD_DIM
ODD_OUT = (C_HEADS + 2 * D_HEADS) * HEAD_DIM
N_EXPERTS = 16
N_GROUPS = 4
EXPERTS_PER_GROUP = N_EXPERTS // N_GROUPS
TOP_K = 2
EXPERT_FF = D_MODEL // 2
ALPHA = (2 * DEPTH) ** 0.25
BETA = (8 * DEPTH) ** -0.25

kernel_name = 'hybrid_diffusion_prefix_block'


def _cuts(sizes):
    return [int(v) for v in np.cumsum(sizes)[:-1]]


def layer_norm(x, g, b, eps=1e-5):
    xf = x.astype(jnp.float32)
    mu = jnp.mean(xf, -1, keepdims=True)
    var = jnp.mean(jnp.square(xf - mu), -1, keepdims=True)
    return ((xf - mu) * lax.rsqrt(var + eps)).astype(x.dtype) * g + b


def rms_norm(x, g, eps=1e-6):
    xf = x.astype(jnp.float32)
    return (xf * lax.rsqrt(jnp.mean(jnp.square(xf), -1, keepdims=True) + eps)).astype(x.dtype) * g


def axial_rope(n_tokens):
    t = jnp.arange(n_tokens, dtype=jnp.int32)
    row = (t // GRID_W).astype(jnp.float32)
    col = (t % GRID_W).astype(jnp.float32)
    n_freq = HEAD_DIM // 4
    inv = ROPE_THETA ** (-jnp.arange(n_freq, dtype=jnp.float32) / n_freq)
    ang = jnp.concatenate([row[:, None] * inv[None], col[:, None] * inv[None]], -1)
    return jnp.cos(ang), jnp.sin(ang)


def apply_rope(x, cos, sin):
    shp = (1, x.shape[1]) + (1,) * (x.ndim - 3) + (cos.shape[-1],)
    c = cos.reshape(shp).astype(x.dtype)
    s = sin.reshape(shp).astype(x.dtype)
    x1, x2 = x[..., 0::2], x[..., 1::2]
    return jnp.stack([x1 * c - x2 * s, x1 * s + x2 * c], -1).reshape(x.shape)


def softmax_with_sink(s, sink):
    sk = jnp.broadcast_to(sink.astype(jnp.float32)[None, :, :, None, None], s.shape[:-1] + (1,))
    return jax.nn.softmax(jnp.concatenate([s, sk], -1), -1)[..., :-1]


def ctx_gqa(q, k, v, sink=None):
    B, L = q.shape[:2]
    s = jnp.einsum('bqhgd,bkhd->bhgqk', q, k, preferred_element_type=jnp.float32) * SCALE
    p = jax.nn.softmax(s, -1) if sink is None else softmax_with_sink(s, sink)
    o = jnp.einsum('bhgqk,bkhd->bqhgd', p.astype(v.dtype), v)
    return o.reshape(B, L, -1)


def windowed_gqa_sink(q, q_nopos, k, v, k_ctx, v_ctx, sink):
    B, S, KV, G, Dh = q.shape
    nblk = S // A_BLOCK
    span = 3 * A_BLOCK
    pad = jnp.zeros((B, A_BLOCK, KV, Dh), k.dtype)
    k_pad = jnp.concatenate([pad, k, pad], 1)
    v_pad = jnp.concatenate([pad, v, pad], 1)
    rel = np.arange(span)[None, :] - np.arange(A_BLOCK)[:, None]
    band = jnp.asarray((rel >= A_BLOCK - A_WINDOW) & (rel <= A_BLOCK + A_WINDOW))
    to_blocks = lambda t: jnp.moveaxis(t.reshape(B, nblk, A_BLOCK, KV, G, Dh), 1, 0)

    def block(args):
        b, qb, qnb = args
        kb = lax.dynamic_slice_in_dim(k_pad, b * A_BLOCK, span, axis=1)
        vb = lax.dynamic_slice_in_dim(v_pad, b * A_BLOCK, span, axis=1)
        kpos = b * A_BLOCK - A_BLOCK + jnp.arange(span)
        valid = band & ((kpos >= 0) & (kpos < S))[None, :]
        s_loc = jnp.einsum('bqhgd,bkhd->bhgqk', qb, kb, preferred_element_type=jnp.float32) * SCALE
        s_loc = jnp.where(valid, s_loc, NEG_INF)
        s_ctx = jnp.einsum('bqhgd,bkhd->bhgqk', qnb, k_ctx, preferred_element_type=jnp.float32) * SCALE
        p = softmax_with_sink(jnp.concatenate([s_loc, s_ctx], -1), sink).astype(v.dtype)
        o = (jnp.einsum('bhgqk,bkhd->bqhgd', p[..., :span], vb)
             + jnp.einsum('bhgqk,bkhd->bqhgd', p[..., span:], v_ctx))
        return o.reshape(B, A_BLOCK, KV * G * Dh)

    o = lax.map(block, (jnp.arange(nblk), to_blocks(q), to_blocks(q_nopos)))
    return jnp.moveaxis(o, 0, 1).reshape(B, S, KV * G * Dh)


def neighbourhood_attn(q, k, v, k_ctx, v_ctx, rpb):
    B, S, H, Dh = q.shape
    rows = S // GRID_W
    kh, kw = min(NA_ROWS, rows), NA_COLS
    q_rows = jnp.moveaxis(q.reshape(B, rows, GRID_W, H, Dh), 1, 0)
    k_grid = k.reshape(B, rows, GRID_W, H, Dh)
    v_grid = v.reshape(B, rows, GRID_W, H, Dh)
    col = np.arange(GRID_W)
    col_start = np.clip(col - kw // 2, 0, GRID_W - kw)
    col_ok = jnp.asarray((col[None, :] >= col_start[:, None]) & (col[None, :] < col_start[:, None] + kw))
    dcol = jnp.asarray(np.clip(col[None, :] - col[:, None] + NA_COLS - 1, 0, 2 * NA_COLS - 2))
    n_loc = kh * GRID_W

    def row_block(args):
        r, qr = args
        r0 = jnp.clip(r - kh // 2, 0, rows - kh)
        kr = lax.dynamic_slice_in_dim(k_grid, r0, kh, axis=1)
        vr = lax.dynamic_slice_in_dim(v_grid, r0, kh, axis=1)
        drow = r0 + jnp.arange(kh) - r + NA_ROWS - 1
        bias = rpb[:, drow[None, :, None], dcol[:, None, :]].astype(jnp.float32)
        s = jnp.einsum('bqhd,bijhd->bhqij', qr, kr, preferred_element_type=jnp.float32) * SCALE + bias[None]
        s = jnp.where(col_ok[:, None, :], s, NEG_INF).reshape(B, H, GRID_W, n_loc)
        s_ctx = jnp.einsum('bqhd,bkhd->bhqk', qr, k_ctx, preferred_element_type=jnp.float32) * SCALE
        p = jax.nn.softmax(jnp.concatenate([s, s_ctx], -1), -1).astype(v.dtype)
        o = (jnp.einsum('bhqn,bnhd->bqhd', p[..., :n_loc], vr.reshape(B, n_loc, H, Dh))
             + jnp.einsum('bhqk,bkhd->bqhd', p[..., n_loc:], v_ctx))
        return o.reshape(B, GRID_W, H * Dh)

    o = lax.map(row_block, (jnp.arange(rows), q_rows))
    return jnp.moveaxis(o, 0, 1).reshape(B, S, H * Dh)


def dense_gqa_blocks(q, q_nopos, k, v, k_ctx, v_ctx):
    B, S, KV, G, Dh = q.shape
    nblk = S // Q_BLOCK
    to_blocks = lambda t: jnp.moveaxis(t.reshape(B, nblk, Q_BLOCK, KV, G, Dh), 1, 0)

    def block(args):
        qb, qnb = args
        s = jnp.einsum('bqhgd,bkhd->bhgqk', qb, k, preferred_element_type=jnp.float32) * SCALE
        s_ctx = jnp.einsum('bqhgd,bkhd->bhgqk', qnb, k_ctx, preferred_element_type=jnp.float32) * SCALE
        p = jax.nn.softmax(jnp.concatenate([s, s_ctx], -1), -1).astype(v.dtype)
        o = (jnp.einsum('bhgqk,bkhd->bqhgd', p[..., :S], v)
             + jnp.einsum('bhgqk,bkhd->bqhgd', p[..., S:], v_ctx))
        return o.reshape(B, Q_BLOCK, KV * G * Dh)

    o = lax.map(block, (to_blocks(q), to_blocks(q_nopos)))
    return jnp.moveaxis(o, 0, 1).reshape(B, S, KV * G * Dh)


def diff_attn_blocks(q, q_nopos, k, v, k_ctx, v_ctx, lam):
    B, S, H, _, Dh = q.shape
    nblk = S // Q_BLOCK
    to_blocks = lambda t: jnp.moveaxis(t.reshape(B, nblk, Q_BLOCK, H, 2, Dh), 1, 0)

    def block(args):
        qb, qnb = args
        s = jnp.einsum('bqhtd,bkhtd->bhtqk', qb, k, preferred_element_type=jnp.float32) * SCALE
        s_ctx = jnp.einsum('bqhtd,bkhtd->bhtqk', qnb, k_ctx, preferred_element_type=jnp.float32) * SCALE
        p = jax.nn.softmax(jnp.concatenate([s, s_ctx], -1), -1)
        a = (p[:, :, 0] - lam * p[:, :, 1]).astype(v.dtype)
        return (jnp.einsum('bhqk,bkhe->bqhe', a[..., :S], v)
                + jnp.einsum('bhqk,bkhe->bqhe', a[..., S:], v_ctx))

    o = lax.map(block, (to_blocks(q), to_blocks(q_nopos)))
    return jnp.moveaxis(o, 0, 1).reshape(B, S, H, 2 * Dh)


def ctx_diff(q, k, v, lam):
    s = jnp.einsum('bqhtd,bkhtd->bhtqk', q, k, preferred_element_type=jnp.float32) * SCALE
    p = jax.nn.softmax(s, -1)
    a = (p[:, :, 0] - lam * p[:, :, 1]).astype(v.dtype)
    return jnp.einsum('bhqk,bkhe->bqhe', a, v)


def even_mixer(h, hc, w_in, w_out, sink, rpb, cos, sin, ctx_out):
    B, S, _ = h.shape
    L = hc.shape[1]
    G = A_HEADS // A_KV_HEADS
    cuts = _cuts(EVEN_SPLITS)
    a_q, a_k, a_v, b_q, b_k, b_v = jnp.split(h @ w_in, cuts, axis=-1)
    a_qx, a_kx, a_vx, b_qx, b_kx, b_vx = jnp.split(hc @ w_in, cuts, axis=-1)
    sink = sink.reshape(A_KV_HEADS, G)
    a_q = a_q.reshape(B, S, A_KV_HEADS, G, HEAD_DIM)
    a_k = a_k.reshape(B, S, A_KV_HEADS, HEAD_DIM)
    a_v = a_v.reshape(B, S, A_KV_HEADS, HEAD_DIM)
    a_kx = a_kx.reshape(B, L, A_KV_HEADS, HEAD_DIM)
    a_vx = a_vx.reshape(B, L, A_KV_HEADS, HEAD_DIM)
    o_a = windowed_gqa_sink(apply_rope(a_q, cos, sin), a_q, apply_rope(a_k, cos, sin), a_v, a_kx, a_vx, sink)
    b_kx = b_kx.reshape(B, L, B_HEADS, HEAD_DIM)
    b_vx = b_vx.reshape(B, L, B_HEADS, HEAD_DIM)
    o_b = neighbourhood_attn(b_q.reshape(B, S, B_HEADS, HEAD_DIM), b_k.reshape(B, S, B_HEADS, HEAD_DIM),
                             b_v.reshape(B, S, B_HEADS, HEAD_DIM), b_kx, b_vx, rpb)
    y = jnp.concatenate([o_a, o_b], -1) @ w_out
    if not ctx_out:
        return y, None
    oc_a = ctx_gqa(a_qx.reshape(B, L, A_KV_HEADS, G, HEAD_DIM), a_kx, a_vx, sink)
    oc_b = ctx_gqa(b_qx.reshape(B, L, B_HEADS, 1, HEAD_DIM), b_kx, b_vx)
    yc = jnp.concatenate([oc_a, oc_b], -1) @ w_out
    return y, yc


def odd_mixer(h, hc, w_in, w_out, q_norm_g, k_norm_g, lambda_q1, lambda_k1, lambda_q2, lambda_k2,
              subln_g, lambda_init, cos, sin, ctx_out):
    B, S, _ = h.shape
    L = hc.shape[1]
    G = C_HEADS // C_KV_HEADS
    cuts = _cuts(ODD_SPLITS)
    c_q, c_k, c_v, d_q, d_k, d_v = jnp.split(h @ w_in, cuts, axis=-1)
    c_qx, c_kx, c_vx, d_qx, d_kx, d_vx = jnp.split(hc @ w_in, cuts, axis=-1)
    q = rms_norm(c_q.reshape(B, S, C_KV_HEADS, G, HEAD_DIM), q_norm_g)
    k = rms_norm(c_k.reshape(B, S, C_KV_HEADS, HEAD_DIM), k_norm_g)
    v = c_v.reshape(B, S, C_KV_HEADS, HEAD_DIM)
    k_x = rms_norm(c_kx.reshape(B, L, C_KV_HEADS, HEAD_DIM), k_norm_g)
    v_x = c_vx.reshape(B, L, C_KV_HEADS, HEAD_DIM)
    o_c = dense_gqa_blocks(apply_rope(q, cos, sin), q, apply_rope(k, cos, sin), v, k_x, v_x)
    lam = (jnp.exp(jnp.sum(lambda_q1.astype(jnp.float32) * lambda_k1.astype(jnp.float32)))
           - jnp.exp(jnp.sum(lambda_q2.astype(jnp.float32) * lambda_k2.astype(jnp.float32))) + lambda_init)
    dq = d_q.reshape(B, S, D_HEADS, 2, HEAD_DIM)
    dk = d_k.reshape(B, S, D_HEADS, 2, HEAD_DIM)
    dv = d_v.reshape(B, S, D_HEADS, 2 * HEAD_DIM)
    dk_x = d_kx.reshape(B, L, D_HEADS, 2, HEAD_DIM)
    dv_x = d_vx.reshape(B, L, D_HEADS, 2 * HEAD_DIM)
    o_d = diff_attn_blocks(apply_rope(dq, cos, sin), dq, apply_rope(dk, cos, sin), dv, dk_x, dv_x, lam)
    o_d = rms_norm(o_d, subln_g) * (1.0 - lambda_init)
    y = jnp.concatenate([o_c, o_d.reshape(B, S, -1)], -1) @ w_out
    if not ctx_out:
        return y, None
    q_x = rms_norm(c_qx.reshape(B, L, C_KV_HEADS, G, HEAD_DIM), q_norm_g)
    oc_c = ctx_gqa(q_x, k_x, v_x)
    oc_d = rms_norm(ctx_diff(d_qx.reshape(B, L, D_HEADS, 2, HEAD_DIM), dk_x, dv_x, lam), subln_g) * (1.0 - lambda_init)
    yc = jnp.concatenate([oc_c, oc_d.reshape(B, L, -1)], -1) @ w_out
    return y, yc


def moe(h, w_router, router_bias, w_gate, w_up, w_down):
    logits = jnp.einsum('...d,de->...e', h, w_router, preferred_element_type=jnp.float32)
    scores = jax.nn.sigmoid(logits)
    biased = scores + router_bias.astype(jnp.float32)
    grouped = biased.reshape(biased.shape[:-1] + (N_GROUPS, EXPERTS_PER_GROUP))
    group_score = lax.top_k(grouped, TOP_K)[0].sum(-1)
    best = jnp.argmax(group_score, -1)
    in_group = best[..., None] == jnp.arange(N_GROUPS)
    masked = jnp.where(in_group[..., None], grouped, -jnp.inf).reshape(biased.shape)
    _, idx = lax.top_k(masked, TOP_K)
    w = jnp.take_along_axis(scores, idx, -1)
    w = w / jnp.sum(w, -1, keepdims=True)
    gates = jnp.sum(jax.nn.one_hot(idx, N_EXPERTS, dtype=jnp.float32) * w[..., None], -2).astype(h.dtype)
    out = jnp.zeros_like(h)
    for e in range(N_EXPERTS):
        a = jax.nn.silu(h @ w_gate[e]) * (h @ w_up[e])
        out = out + gates[..., e:e + 1] * (a @ w_down[e])
    return out


def setup_inputs(seed: int = 0) -> dict:
    key = jax.random.key(seed)
    ks = jax.random.split(key, 28)

    def nrm(i, shape, scale):
        return jax.random.normal(ks[i], shape, jnp.float32) * scale

    n_even = (DEPTH + 1) // 2
    n_odd = DEPTH // 2
    return {
        'x': nrm(0, (BATCH, SEQ, D_MODEL), 1.0),
        'c': nrm(1, (BATCH, D_MODEL), 1.0),
        'ctx': nrm(2, (BATCH, CTX_LEN, D_MODEL), 1.0),
        'c_ctx': nrm(3, (D_MODEL,), 1.0),
        'w_ada': nrm(4, (DEPTH, D_MODEL, 6 * D_MODEL), 0.5 * D_MODEL ** -0.5),
        'b_ada': nrm(5, (DEPTH, 6 * D_MODEL), 0.02),
        'ln1_g': 1.0 + nrm(6, (DEPTH, D_MODEL), 0.02),
        'ln1_b': nrm(7, (DEPTH, D_MODEL), 0.02),
        'ln2_g': 1.0 + nrm(8, (DEPTH, D_MODEL), 0.02),
        'ln2_b': nrm(9, (DEPTH, D_MODEL), 0.02),
        'w_in_even': nrm(10, (n_even, D_MODEL, sum(EVEN_SPLITS)), D_MODEL ** -0.5),
        'w_out_even': nrm(11, (n_even, EVEN_OUT, D_MODEL), BETA * EVEN_OUT ** -0.5),
        'sink_logits': nrm(12, (n_even, A_HEADS), 0.5),
        'na_rpb': nrm(13, (n_even, B_HEADS, 2 * NA_ROWS - 1, 2 * NA_COLS - 1), 0.1),
        'w_in_odd': nrm(14, (n_odd, D_MODEL, sum(ODD_SPLITS)), D_MODEL ** -0.5),
        'w_out_odd': nrm(15, (n_odd, ODD_OUT, D_MODEL), BETA * ODD_OUT ** -0.5),
        'q_norm_g': 1.0 + nrm(16, (n_odd, HEAD_DIM), 0.02),
        'k_norm_g': 1.0 + nrm(17, (n_odd, HEAD_DIM), 0.02),
        'lambda_q1': nrm(18, (n_odd, HEAD_DIM), 0.1),
        'lambda_k1': nrm(19, (n_odd, HEAD_DIM), 0.1),
        'lambda_q2': nrm(20, (n_odd, HEAD_DIM), 0.1),
        'lambda_k2': nrm(21, (n_odd, HEAD_DIM), 0.1),
        'subln_g': 1.0 + nrm(22, (n_odd, 2 * HEAD_DIM), 0.02),
        'w_router': nrm(23, (D_MODEL, N_EXPERTS), D_MODEL ** -0.5),
        'router_bias': nrm(24, (N_EXPERTS,), 0.01),
        'w_exp_gate': nrm(25, (DEPTH, N_EXPERTS, D_MODEL, EXPERT_FF), D_MODEL ** -0.5),
        'w_exp_up': nrm(26, (DEPTH, N_EXPERTS, D_MODEL, EXPERT_FF), D_MODEL ** -0.5),
        'w_exp_down': nrm(27, (DEPTH, N_EXPERTS, EXPERT_FF, D_MODEL), BETA * EXPERT_FF ** -0.5),
    }


def reference(x, c, ctx, c_ctx, w_ada, b_ada, ln1_g, ln1_b, ln2_g, ln2_b,
              w_in_even, w_out_even, sink_logits, na_rpb,
              w_in_odd, w_out_odd, q_norm_g, k_norm_g,
              lambda_q1, lambda_k1, lambda_q2, lambda_k2, subln_g,
              w_router, router_bias, w_exp_gate, w_exp_up, w_exp_down):
    S = x.shape[1]
    cos, sin = axial_rope(S)
    silu_c = jax.nn.silu(c)
    silu_cc = jax.nn.silu(c_ctx)
    for l in range(DEPTH):
        last = l == DEPTH - 1
        j = l // 2
        mod = silu_c @ w_ada[l] + b_ada[l]
        sh1, sc1, g1, sh2, sc2, g2 = [m[:, None, :] for m in jnp.split(mod, 6, axis=-1)]
        modc = silu_cc @ w_ada[l] + b_ada[l]
        csh1, csc1, cg1, csh2, csc2, cg2 = jnp.split(modc, 6)
        h = x * (1.0 + sc1) + sh1
        hc = ctx * (1.0 + csc1) + csh1
        if l % 2 == 0:
            y, yc = even_mixer(h, hc, w_in_even[j], w_out_even[j], sink_logits[j], na_rpb[j], cos, sin, not last)
        else:
            lambda_init = 0.8 - 0.6 * math.exp(-0.3 * l)
            y, yc = odd_mixer(h, hc, w_in_odd[j], w_out_odd[j], q_norm_g[j], k_norm_g[j],
                              lambda_q1[j], lambda_k1[j], lambda_q2[j], lambda_k2[j], subln_g[j],
                              lambda_init, cos, sin, not last)
        x = layer_norm(ALPHA * x + g1 * y, ln1_g[l], ln1_b[l])
        f = moe(x * (1.0 + sc2) + sh2, w_router, router_bias, w_exp_gate[l], w_exp_up[l], w_exp_down[l])
        x = layer_norm(ALPHA * x + g2 * f, ln2_g[l], ln2_b[l])
        if not last:
            ctx = layer_norm(ALPHA * ctx + cg1 * yc, ln1_g[l], ln1_b[l])
            fc = moe(ctx * (1.0 + csc2) + csh2, w_router, router_bias, w_exp_gate[l], w_exp_up[l], w_exp_down[l])
            ctx = layer_norm(ALPHA * ctx + cg2 * fc, ln2_g[l], ln2_b[l])
    return x
```

```cpp
#include <hip/hip_runtime.h>
#include <cstdio>
#include <cstdint>

#ifndef MK_MULTI
#define MK_MULTI 0
#endif

#ifndef NAIVE_ATTN
#define NAIVE_ATTN 0
#endif

#ifndef REP_MASK
#define REP_MASK 0
#endif

#ifndef GEMM_PROBE_NOEPI
#define GEMM_PROBE_NOEPI 0
#endif
#ifndef GEMM_PROBE_NODMA
#define GEMM_PROBE_NODMA 0
#endif
#ifndef GEMM_PROBE_HALFST
#define GEMM_PROBE_HALFST 0
#endif
#ifndef BAR_PROBE
#define BAR_PROBE 0
#endif
#ifndef EPIQKV_PROBE
#define EPIQKV_PROBE 0
#endif
#ifndef EPI_REP
#define EPI_REP 0
#endif
#ifndef LN1_DRYVAR
#define LN1_DRYVAR 0
#endif

#define GAS __attribute__((address_space(1)))
#define LAS __attribute__((address_space(3)))
typedef unsigned short bf16_t;
typedef short bf16x8 __attribute__((ext_vector_type(8)));
typedef float f32x4 __attribute__((ext_vector_type(4)));
typedef float f32x2 __attribute__((ext_vector_type(2)));
typedef float f32x16 __attribute__((ext_vector_type(16)));
typedef unsigned u32x4 __attribute__((ext_vector_type(4)));
typedef unsigned u32x2 __attribute__((ext_vector_type(2)));

constexpr int DM = 2048, NB = 16, SEQ = 2048, CTXL = 256, PB = SEQ + CTXL, MROWS = NB * PB;
constexpr int NQKV = 4608, HD = 128, NE = 16, FF = 1024, GRIDW = 64;
constexpr float ALPHA = 1.4142135623730951f;
constexpr float SM_SCALE = 0.08838834764831845f;
constexpr float LAMBDA_INIT1 = 0.35550906759096927f;
constexpr float ONE_M_LI = 1.0f - LAMBDA_INIT1;
constexpr int LCAP = MROWS;
constexpr int MAXT = 304;

constexpr size_t MiB = 1u << 20;
constexpr size_t WS_CTL = 0, CTL_BYTES = 1 * MiB;
constexpr size_t WS_MOD = 1 * MiB;
constexpr size_t WS_CS = 3 * MiB;
constexpr size_t WS_GW = 4 * MiB;
constexpr size_t WS_PPOS = 4 * MiB + 512 * 1024;
constexpr size_t WS_LIST = 5 * MiB;
constexpr size_t WS_WIN = 8 * MiB;
constexpr size_t WS_WOUT = 44 * MiB;
constexpr size_t WS_WGU = 60 * MiB;
constexpr size_t WS_K8 = (60 + 128) * MiB;
constexpr size_t WS_V8 = (60 + 128 + 48) * MiB;
constexpr size_t WS_WD = 316 * MiB;
constexpr size_t WS_XC = 444 * MiB;
constexpr size_t WS_H = 476 * MiB;
constexpr size_t WS_QKV = 620 * MiB;
constexpr size_t WS_Q8 = (620 + 162) * MiB;
constexpr size_t WS_QN = 944 * MiB;
constexpr size_t WS_O = 1088 * MiB;
constexpr size_t WS_END = 1240 * MiB;
constexpr int CW_BAR = 4096;
constexpr int CW_CNT = 16384;

constexpr int LDS_BYTES = 163840;
constexpr int RING_BYTES = 131072;
constexpr int TB_OFF = RING_BYTES;
constexpr int STASH_OFF = RING_BYTES + 2048;
constexpr int MISC_OFF = LDS_BYTES - 64;

__device__ __forceinline__ unsigned cvt_pk_bf16(float lo, float hi) { unsigned r; asm volatile("v_cvt_pk_bf16_f32 %0, %1, %2" : "=v"(r) : "v"(lo), "v"(hi)); return r; }
__device__ __forceinline__ unsigned cvt4_fp8(float a, float b, float c, float d) { int w = __builtin_amdgcn_cvt_pk_fp8_f32(a, b, 0, false); w = __builtin_amdgcn_cvt_pk_fp8_f32(c, d, w, true); return (unsigned)w; }
constexpr float att_OSCALE = 16.0f;
constexpr float Y8SCALE = 16.0f;
__device__ __forceinline__ f32x4 fp8x4_to_f32(unsigned w) { const f32x2 lo = __builtin_amdgcn_cvt_pk_f32_fp8((int)w, false), hi = __builtin_amdgcn_cvt_pk_f32_fp8((int)w, true); return (f32x4){lo.x, lo.y, hi.x, hi.y}; }
constexpr float W8SCALE = 64.0f;
__device__ __forceinline__ float bf_lo(unsigned w) { return __uint_as_float(w << 16); }
__device__ __forceinline__ float bf_hi(unsigned w) { return __uint_as_float(w & 0xffff0000u); }
__device__ __forceinline__ float bf2f(bf16_t b) { return __uint_as_float((unsigned)b << 16); }
__device__ __forceinline__ float wave_sum(float v) {
#pragma unroll
    for (int o = 1; o < 64; o <<= 1) v += __shfl_xor(v, o);
    return v;
}
__device__ __forceinline__ float wave_max(float v) {
#pragma unroll
    for (int o = 1; o < 64; o <<= 1) v = fmaxf(v, __shfl_xor(v, o));
    return v;
}
__device__ __forceinline__ int lane_id() { int l; asm volatile("v_mbcnt_lo_u32_b32 %0, -1, 0\n\tv_mbcnt_hi_u32_b32 %0, -1, %0" : "=v"(l)); return l; }
#define LDS_WAIT() asm volatile("s_waitcnt lgkmcnt(0)" ::: "memory")
#define VM_WAIT() asm volatile("s_waitcnt vmcnt(0)" ::: "memory")

struct Args { const float* in[28]; float* out; unsigned char* ws; int ph_lo, ph_hi; };
typedef const __attribute__((address_space(4))) Args* KArgs;
__device__ __forceinline__ KArgs kargs() { KArgs p = (KArgs)__builtin_amdgcn_kernarg_segment_ptr(); asm volatile("" : "+s"(p)); return p; }
namespace pg8 {
constexpr int BM = 256, BK = 64, HALF = 128, HTB = HALF * BK * 2, STAGE_BYTES = 8 * HTB, NXCD = 8, WGM = 12;
__host__ __device__ __forceinline__ int lds_byte(int r, int c) { const int st = (r >> 4) * 2 + (c >> 5), rr = r & 15, cc = c & 31, ob = rr * 64 + cc * 2; return st * 1024 + (ob ^ (((ob >> 9) & 1) << 5)); }
__host__ __device__ __forceinline__ void stage_rc(int b, int& R, int& C) { const int st = b / 1024, sb = b % 1024, swz = sb ^ (((sb >> 9) & 1) << 5); R = (st >> 1) * 16 + swz / 64; C = (st & 1) * 32 + (swz % 64) / 2; }
__host__ __device__ __forceinline__ int perm32(int rho) { const int n = rho >> 4, i = rho & 15; return 8 * (i >> 2) + 4 * n + (i & 3); }

typedef int v4i_t __attribute__((ext_vector_type(4)));
typedef int v8i_t __attribute__((ext_vector_type(8)));
struct Unit { int pm, pn, e, mt; };

constexpr bool ALIGN_EPI_ = true;
template <class Epi, class Sched, bool FP8 = false>
__device__ __forceinline__ void gemm_phase(LAS unsigned char* lds, const int K, const Sched& S, const Epi& E, const int wid, const bool skip_epi = false) {
    const int lane = lane_id(), tid = wid * 64 + lane, wr = wid >> 2, wc = wid & 3, fr = lane & 15, fq = lane >> 4;
    const int nt = K / BK;
    int RA[2]; unsigned CA[2], voffB[2];
#pragma unroll
    for (int i = 0; i < 2; ++i) { int R, C; stage_rc(tid * 16 + i * 8192, R, C); const int Rb = (R & ~31) + perm32(R & 31);
        RA[i] = R; CA[i] = (unsigned)C * 2u; voffB[i] = (unsigned)(Rb * K + C) * 2u; }
    const size_t kstep = (size_t)(BK * 2);
    const size_t hstep = (size_t)HALF * K * 2;
    const unsigned ldsw = (unsigned)wid * 1024u;
    const int aoff = lds_byte(wr * 64 + fr, fq * 8), boff = lds_byte(wc * 32 + fr, fq * 8);
#define PG8_SA(b, h) (((b) * 2 + (h)) * HTB)
#define PG8_SB(b, h) ((4 + (b) * 2 + (h)) * HTB)
#define PG8_STAGE(bufoff, gbase, v0, v1) do { if (GEMM_PROBE_NODMA && skip_epi) break; \
        __builtin_amdgcn_global_load_lds((const unsigned*)((const char*)(gbase) + (v0)), (LAS unsigned*)(lds + (bufoff) + ldsw), 16, 0, 0); \
        __builtin_amdgcn_global_load_lds((const unsigned*)((const char*)(gbase) + (v1)), (LAS unsigned*)(lds + (bufoff) + ldsw + 8192), 16, 0, 0); } while (0)
#define PG8_LD8(p) __builtin_shufflevector(*(const LAS v4i_t*)(p), *(const LAS v4i_t*)((p) + 1024), 0, 1, 2, 3, 4, 5, 6, 7)
#define PG8_LDA(dst, b, h) do { if constexpr (FP8) { _Pragma("unroll") for (int m = 0; m < 4; ++m) dst##8[m] = PG8_LD8(lds + PG8_SA(b, h) + aoff + m * 2048); } \
        else { _Pragma("unroll") for (int m = 0; m < 4; ++m) _Pragma("unroll") for (int k = 0; k < 2; ++k) dst[m][k] = *(const LAS bf16x8*)(lds + PG8_SA(b, h) + aoff + m * 2048 + k * 1024); } } while (0)
#define PG8_LDB(dst, b, h) do { if constexpr (FP8) { _Pragma("unroll") for (int n = 0; n < 2; ++n) dst##8[n] = PG8_LD8(lds + PG8_SB(b, h) + boff + n * 2048); } \
        else { _Pragma("unroll") for (int n = 0; n < 2; ++n) _Pragma("unroll") for (int k = 0; k < 2; ++k) dst[n][k] = *(const LAS bf16x8*)(lds + PG8_SB(b, h) + boff + n * 2048 + k * 1024); } } while (0)
#define PG8_CAT(x) __builtin_shufflevector(__builtin_bit_cast(v4i_t, x[0]), __builtin_bit_cast(v4i_t, x[1]), 0, 1, 2, 3, 4, 5, 6, 7)
#define PG8_MMA(ai, bj, At, Bt) do { __builtin_amdgcn_s_setprio(1); \
        if constexpr (FP8) { _Pragma("unroll") for (int m = 0; m < 4; ++m) _Pragma("unroll") for (int n = 0; n < 2; ++n) \
            asm volatile("v_mfma_f32_16x16x128_f8f6f4 %0, %1, %2, %0" : "+v"(acc[ai][bj][m][n]) : "v"(Bt##8[n]), "v"(At##8[m])); } \
        else { _Pragma("unroll") for (int m = 0; m < 4; ++m) _Pragma("unroll") for (int n = 0; n < 2; ++n) _Pragma("unroll") for (int k = 0; k < 2; ++k) \
            acc[ai][bj][m][n] = __builtin_amdgcn_mfma_f32_16x16x32_bf16(Bt[n][k], At[m][k], acc[ai][bj][m][n], 0, 0, 0); } \
        __builtin_amdgcn_s_setprio(0); } while (0)
#define PG8_WAIT_V(n) asm volatile("s_waitcnt vmcnt(" #n ")" ::: "memory")
#define PG8_WAIT_L(n) asm volatile("s_waitcnt lgkmcnt(" #n ")" ::: "memory")
#define PG8_BAR __builtin_amdgcn_s_barrier()
#define PG8_SCHED __builtin_amdgcn_sched_barrier(0)
    Unit cur, nxt; int ui = 0;
    if (!S.next(0, cur)) return;
    f32x4 acc[2][2][4][2];
#pragma unroll
    for (int a = 0; a < 2; ++a)
#pragma unroll
        for (int b = 0; b < 2; ++b)
#pragma unroll
            for (int m = 0; m < 4; ++m)
#pragma unroll
                for (int n = 0; n < 2; ++n) acc[a][b][m][n] = (f32x4){0.f, 0.f, 0.f, 0.f};
    bf16x8 At[4][2], B0[2][2], B1[2][2];
    v8i_t At8[4], B08[2], B18[2];
    unsigned c00 = S.a_off(cur, 0, RA[0]) + CA[0], c01 = S.a_off(cur, 0, RA[1]) + CA[1], c10 = S.a_off(cur, 1, RA[0]) + CA[0], c11 = S.a_off(cur, 1, RA[1]) + CA[1];
    const char* cA = S.a_base(cur); const char* cB = S.b_base(cur);
    PG8_STAGE(PG8_SB(0, 0), cB, voffB[0], voffB[1]); PG8_STAGE(PG8_SB(0, 1), cB + hstep, voffB[0], voffB[1]); PG8_STAGE(PG8_SA(0, 0), cA, c00, c01); PG8_STAGE(PG8_SA(0, 1), cA, c10, c11);
    if (wr == 1) PG8_BAR;
    PG8_WAIT_V(2); PG8_BAR;
    PG8_STAGE(PG8_SB(1, 0), cB + kstep, voffB[0], voffB[1]); PG8_STAGE(PG8_SA(1, 0), cA + kstep, c00, c01); PG8_STAGE(PG8_SB(1, 1), cB + hstep + kstep, voffB[0], voffB[1]);
    PG8_WAIT_V(6); PG8_BAR;
    LAS u32x4* stash = (LAS u32x4*)(lds + STASH_OFF) + tid;
    for (;;) {
        const bool has_next = S.next(ui + 1, nxt);
        const char* nA = cA; const char* nB = cB;
        if (has_next) { nA = S.a_base(nxt); nB = S.b_base(nxt); }
        if constexpr (Sched::GATHER) {
            u32x4 sv = (u32x4){c00, c01, c10, c11};
            if (has_next) { sv.x = S.a_off(nxt, 0, RA[0]) + CA[0]; sv.y = S.a_off(nxt, 0, RA[1]) + CA[1]; sv.z = S.a_off(nxt, 1, RA[0]) + CA[0]; sv.w = S.a_off(nxt, 1, RA[1]) + CA[1]; }
            *stash = sv;
        }
#pragma clang loop unroll(disable)
        for (int t = 0; t < nt; t += 2) {
            const bool last = (t == nt - 2);
            const char* a1 = cA + (size_t)(t + 1) * kstep;
            const char* a2 = last ? nA : cA + (size_t)(t + 2) * kstep; const char* b2 = last ? nB : cB + (size_t)(t + 2) * kstep;
            const char* a3 = a2 + kstep; const char* b3 = b2 + kstep;
            unsigned x00 = c00, x01 = c01, x10 = c10, x11 = c11;
            if constexpr (Sched::GATHER) { if (last) { const u32x4 sv = *stash; x00 = sv.x; x01 = sv.y; x10 = sv.z; x11 = sv.w; } }
            PG8_LDB(B0, 0, 0); PG8_LDB(B1, 0, 1); PG8_SCHED; PG8_LDA(At, 0, 0); PG8_STAGE(PG8_SA(1, 1), a1, c10, c11);
            PG8_WAIT_V(8); PG8_WAIT_L(0); PG8_BAR; PG8_MMA(0, 0, At, B0); PG8_MMA(0, 1, At, B1); PG8_BAR; PG8_SCHED;
            PG8_LDA(At, 0, 1); PG8_STAGE(PG8_SB(0, 0), b2, voffB[0], voffB[1]); PG8_STAGE(PG8_SB(0, 1), b2 + hstep, voffB[0], voffB[1]); PG8_STAGE(PG8_SA(0, 0), a2, x00, x01);
            PG8_WAIT_V(8); PG8_WAIT_L(0); PG8_BAR; PG8_MMA(1, 0, At, B0); PG8_MMA(1, 1, At, B1); PG8_BAR; PG8_SCHED;
            PG8_LDB(B0, 1, 0); PG8_LDB(B1, 1, 1); PG8_SCHED; PG8_LDA(At, 1, 0); PG8_STAGE(PG8_SA(0, 1), a2, x10, x11);
            PG8_WAIT_V(8); PG8_WAIT_L(0); PG8_BAR; PG8_MMA(0, 0, At, B0); PG8_MMA(0, 1, At, B1); PG8_BAR; PG8_SCHED;
            PG8_LDA(At, 1, 1); PG8_STAGE(PG8_SB(1, 0), b3, voffB[0], voffB[1]); PG8_STAGE(PG8_SB(1, 1), b3 + hstep, voffB[0], voffB[1]); PG8_STAGE(PG8_SA(1, 0), a3, x00, x01);
            PG8_WAIT_V(8); PG8_WAIT_L(0); PG8_BAR; PG8_MMA(1, 0, At, B0); PG8_MMA(1, 1, At, B1); PG8_BAR; PG8_SCHED;
        }
        if constexpr (ALIGN_EPI_) { if (wr == 0) PG8_BAR; }
        if constexpr (FP8) asm volatile("s_nop 15\n\ts_nop 15" ::: "memory");
        if constexpr (EPI_REP == 0) { if (!(GEMM_PROBE_NOEPI && skip_epi)) E(acc, cur, wr, wc, fr, fq); }
        else { int nrep_ = EPI_REP + 1; asm volatile("" : "+s"(nrep_)); for (int er_ = 0; er_ < nrep_; ++er_) { asm volatile("" ::: "memory"); E(acc, cur, wr, wc, fr, fq); } }
        if (!has_next) break;
#pragma unroll
        for (int a = 0; a < 2; ++a)
#pragma unroll
            for (int b = 0; b < 2; ++b)
#pragma unroll
                for (int m = 0; m < 4; ++m)
#pragma unroll
                    for (int n = 0; n < 2; ++n) acc[a][b][m][n] = (f32x4){0.f, 0.f, 0.f, 0.f};
        cur = nxt; cA = nA; cB = nB; ++ui;
        if constexpr (Sched::GATHER) { const u32x4 sv = *stash; c00 = sv.x; c01 = sv.y; c10 = sv.z; c11 = sv.w; }
        if constexpr (ALIGN_EPI_) { if (wr == 1) PG8_BAR; }
    }
    PG8_WAIT_V(0);
    if constexpr (!ALIGN_EPI_) { if (wr == 0) PG8_BAR; }
    PG8_BAR;
#undef PG8_SA
#undef PG8_SB
#undef PG8_STAGE
#undef PG8_LDA
#undef PG8_LD8
#undef PG8_LDB
#undef PG8_MMA
#undef PG8_CAT
#undef PG8_WAIT_V
#undef PG8_WAIT_L
#undef PG8_BAR
#undef PG8_SCHED
}

struct DenseOrder {
    static constexpr bool GATHER = false;
    const char* A; const char* Bt; int K; int nMe, nN, nwg, ntot, G, c; int mode;
    __device__ __forceinline__ void init(const void* A_, const void* Bt_, int K_, int N, int mode_, int G_, int c_) { A = (const char*)A_; Bt = (const char*)Bt_; K = K_; mode = mode_; nMe = mode_ ? 128 : 144; nN = N / BM; nwg = nMe * nN; ntot = nwg + (mode_ == 2 ? 160 : 0); G = G_; c = c_; }
    __device__ __forceinline__ bool next(int i, Unit& u) const {
        const long L = (long)i * G + c; if (L >= ntot) return false;
        u.e = 0; u.mt = 0;
        if (L >= nwg) { const int idx = (int)L - nwg; const int b = idx / 10, j = idx - b * 10; u.pm = 9 * b; u.pn = j < 2 ? 4 + j : 8 + j; return true; }
        int wgid = (int)L; { const int q = nwg / NXCD, r = nwg % NXCD, xcd = wgid % NXCD, off = wgid / NXCD; wgid = (xcd < r ? xcd * (q + 1) : r * (q + 1) + (xcd - r) * q) + off; }
        const int nig = WGM * nN, gid = wgid / nig, fm = gid * WGM, gsz = (nMe - fm) < WGM ? (nMe - fm) : WGM;
        const int pme = fm + ((wgid % nig) % gsz); u.pn = (wgid % nig) / gsz; u.pm = mode ? pme + (pme >> 3) + 1 : pme; return true;
    }
    __device__ __forceinline__ const char* a_base(const Unit& u) const { return A + (size_t)u.pm * BM * K * 2; }
    __device__ __forceinline__ const char* b_base(const Unit& u) const { return Bt + (size_t)u.pn * BM * K * 2; }
    __device__ __forceinline__ unsigned a_off(const Unit&, int h, int R) const { return (unsigned)((h * HALF + R) * K * 2); }
};
template <bool GATHER_>
struct GroupedOrder {
    static constexpr bool GATHER = GATHER_;
    const char* A; const char* Bt; int K; size_t bstride; const int* list; const LAS int* tb; int G, vcu;
    __device__ __forceinline__ bool next(int i, Unit& u) const {
        const int L = i * G + vcu; const int T = tb[16]; if (L >= T * 8) return false;
        u.pm = L >> 3; u.pn = L & 7; u.e = tb[33 + u.pm]; u.mt = u.pm - tb[u.e]; return true;
    }
    __device__ __forceinline__ const char* a_base(const Unit& u) const { return GATHER ? A : A + (size_t)u.pm * BM * K * 2; }
    __device__ __forceinline__ const char* b_base(const Unit& u) const { return Bt + (size_t)u.e * bstride + (size_t)u.pn * BM * K * 2; }
    __device__ __forceinline__ unsigned a_off(const Unit& u, int h, int R) const {
        if (!GATHER) return (unsigned)((h * HALF + R) * K * 2);
        const int s = u.mt * BM + h * HALF + R; const int n = tb[17 + u.e];
        const int pair = (s < n) ? list[(size_t)u.e * LCAP + s] : 0;
        return (unsigned)(pair >> 1) * (unsigned)(K * 2);
    }
};

struct EpiQKV {
    bf16_t* RAW; unsigned char* Q8; unsigned char* QN8; const float* CS; unsigned ropemask, qnmask, k8mask, rawmask; unsigned char* K8; unsigned char* V8; bool dry;
    __device__ __forceinline__ void operator()(const f32x4 (&acc)[2][2][4][2], const Unit& u, int wr, int wc, int fr, int fq) const {
        const int pn = u.pn; const int bidx = u.pm / 9; const bool isctx = (u.pm - bidx * 9) == 0;
        const bool rope = !isctx && ((ropemask >> pn) & 1u) && !((EPIQKV_PROBE & 1) && dry); const bool qn = !isctx && ((qnmask >> pn) & 1u) && !((EPIQKV_PROBE & 2) && dry);
        const int row0 = u.pm * BM + wr * 64 + fr;
        const int col0 = pn * BM + wc * 32 + 8 * fq;
        const int qncol0 = ((pn < 4) ? 256 * pn : 1024 + 256 * (pn - 6)) + wc * 32 + 8 * fq;
        const int p0 = 16 * wc + 4 * fq;
        const bool raw = (rawmask >> pn) & 1u;
        const bool isv = (pn == 5) || (pn >= 14); const bool k8 = ((k8mask >> pn) & 1u) || isv;
        const int k8col0 = (isv ? (pn == 5 ? 0 : 256 + (pn - 14) * 256) : (pn == 4 ? 0 : 256 + (pn - 10) * 256)) + wc * 32 + 8 * fq;
        unsigned char* KV8 = isv ? V8 : K8;
        f32x4 csA[8], csB[8];
#pragma unroll
        for (int i = 0; i < 8; ++i) { csA[i] = (f32x4){1.f, 0.f, 1.f, 0.f}; csB[i] = csA[i];
            if (rope) { const int t = row0 + (i >> 2) * HALF + (i & 3) * 16 - bidx * PB - CTXL; const float* cp = CS + ((size_t)t * 64 + p0) * 2; csA[i] = *(const f32x4*)cp; csB[i] = *(const f32x4*)(cp + 4); } }
#pragma unroll
        for (int ai = 0; ai < 2; ++ai)
#pragma unroll
            for (int m = 0; m < 4; ++m) {
                const int row = row0 + ai * HALF + m * 16;
                const f32x4 cs0 = csA[ai * 4 + m], cs1 = csB[ai * 4 + m];
#pragma unroll
                for (int bj = 0; bj < 2; ++bj) {
                    f32x4 v0 = acc[ai][bj][m][0] * (1.0f / W8SCALE), v1 = acc[ai][bj][m][1] * (1.0f / W8SCALE);
                    if (qn) { u32x2 w; w.x = cvt4_fp8(v0[0], v0[1], v0[2], v0[3]); w.y = cvt4_fp8(v1[0], v1[1], v1[2], v1[3]);
                        *(u32x2*)(QN8 + (size_t)row * DM + qncol0 + bj * HALF) = w; }
                    if (rope) {
                        f32x4 r0, r1;
                        r0[0] = v0[0] * cs0[0] - v0[1] * cs0[1]; r0[1] = v0[0] * cs0[1] + v0[1] * cs0[0];
                        r0[2] = v0[2] * cs0[2] - v0[3] * cs0[3]; r0[3] = v0[2] * cs0[3] + v0[3] * cs0[2];
                        r1[0] = v1[0] * cs1[0] - v1[1] * cs1[1]; r1[1] = v1[0] * cs1[1] + v1[1] * cs1[0];
                        r1[2] = v1[2] * cs1[2] - v1[3] * cs1[3]; r1[3] = v1[2] * cs1[3] + v1[3] * cs1[2];
                        v0 = r0; v1 = r1;
                    }
                    if (k8) { u32x2 w; w.x = cvt4_fp8(v0[0], v0[1], v0[2], v0[3]); w.y = cvt4_fp8(v1[0], v1[1], v1[2], v1[3]);
                        *(u32x2*)(KV8 + (size_t)row * 1280 + k8col0 + bj * HALF) = w; }
                    else if (raw) { u32x4 w; w.x = cvt_pk_bf16(v0[0], v0[1]); w.y = cvt_pk_bf16(v0[2], v0[3]); w.z = cvt_pk_bf16(v1[0], v1[1]); w.w = cvt_pk_bf16(v1[2], v1[3]);
                        *(u32x4*)(RAW + (size_t)row * 1280 + col0 + bj * HALF) = w; }
                    else { u32x2 w; w.x = cvt4_fp8(v0[0], v0[1], v0[2], v0[3]); w.y = cvt4_fp8(v1[0], v1[1], v1[2], v1[3]);
                        *(u32x2*)(Q8 + (size_t)row * NQKV + col0 + bj * HALF) = w; }
                }
            }
    }
};
struct EpiPlain {
    unsigned char* O; int ldc; float scale; bool dry;
    __device__ __forceinline__ void operator()(const f32x4 (&acc)[2][2][4][2], const Unit& u, int wr, int wc, int fr, int fq) const {
        const int row0 = u.pm * BM + wr * 64 + fr; const int col0 = u.pn * BM + wc * 32 + 8 * fq;
#pragma unroll
        for (int ai = 0; ai < 2; ++ai)
#pragma unroll
            for (int m = 0; m < 4; ++m) { unsigned char* rowp = O + (size_t)(row0 + ai * HALF + m * 16) * ldc + col0;
#pragma unroll
                for (int bj = 0; bj < 2; ++bj) { const f32x4 v0 = acc[ai][bj][m][0] * scale, v1 = acc[ai][bj][m][1] * scale;
                    u32x2 w; w.x = cvt4_fp8(v0[0], v0[1], v0[2], v0[3]); w.y = cvt4_fp8(v1[0], v1[1], v1[2], v1[3]);
                    if (!(GEMM_PROBE_HALFST && dry && bj == 1)) *(u32x2*)(rowp + bj * HALF) = w; } }
    }
};
struct EpiSwiGLU {
    unsigned char* ACT;
    __device__ __forceinline__ void operator()(const f32x4 (&acc)[2][2][4][2], const Unit& u, int wr, int wc, int fr, int fq) const {
        const int row0 = u.pm * BM + wr * 64 + fr; const int col0 = u.pn * HALF + wc * 32 + 8 * fq;
#pragma unroll
        for (int ai = 0; ai < 2; ++ai)
#pragma unroll
            for (int m = 0; m < 4; ++m) {
                float o[8];
#pragma unroll
                for (int n = 0; n < 2; ++n)
#pragma unroll
                    for (int j = 0; j < 4; ++j) { const float g = acc[ai][0][m][n][j] * (1.0f / W8SCALE), up = acc[ai][1][m][n][j] * (1.0f / W8SCALE);
                        const float s = __builtin_amdgcn_rcpf(1.0f + __builtin_amdgcn_exp2f(-g * 1.4426950408889634f)); o[n * 4 + j] = g * s * up; }
                u32x2 w; w.x = cvt4_fp8(o[0], o[1], o[2], o[3]); w.y = cvt4_fp8(o[4], o[5], o[6], o[7]);
                *(u32x2*)(ACT + (size_t)(row0 + ai * HALF + m * 16) * FF + col0) = w;
            }
    }
};
struct EpiSlots {
    unsigned char* DNS;
    __device__ __forceinline__ void operator()(const f32x4 (&acc)[2][2][4][2], const Unit& u, int wr, int wc, int fr, int fq) const {
        const int row0 = u.pm * BM + wr * 64 + fr; const int col0 = u.pn * BM + wc * 32 + 8 * fq; constexpr float sc = Y8SCALE / W8SCALE;
#pragma unroll
        for (int ai = 0; ai < 2; ++ai)
#pragma unroll
            for (int m = 0; m < 4; ++m) { unsigned char* rowp = DNS + (size_t)(row0 + ai * HALF + m * 16) * DM + col0;
#pragma unroll
                for (int bj = 0; bj < 2; ++bj) { const f32x4 v0 = acc[ai][bj][m][0] * sc, v1 = acc[ai][bj][m][1] * sc;
                    u32x2 w; w.x = cvt4_fp8(v0[0], v0[1], v0[2], v0[3]); w.y = cvt4_fp8(v1[0], v1[1], v1[2], v1[3]);
                    *(u32x2*)(rowp + bj * HALF) = w; } }
    }
};
}
typedef GAS unsigned gu32;
#define XB_TMO      128
#define XB_XCNT(j)  (256  + 64 * (j))
#define XB_XSUB(j)  (1280 + 64 * (j))
#define XB_XGEN(j)  (2304 + 64 * (j))
#define XB_TOP      3328
#define XB_TOPGEN   3392
#define XCD_BAR_WORDS 3456
#define XB_SPIN_CAP (1u << 18)
__device__ __forceinline__ unsigned xb_ld(unsigned* p)              { return __hip_atomic_load((GAS unsigned*)p, __ATOMIC_RELAXED, __HIP_MEMORY_SCOPE_AGENT); }
__device__ __forceinline__ unsigned xb_add(unsigned* p, unsigned v) { return __hip_atomic_fetch_add((GAS unsigned*)p, v, __ATOMIC_RELAXED, __HIP_MEMORY_SCOPE_AGENT); }
__device__ __forceinline__ unsigned xb_xcc_id() { return (unsigned)__builtin_amdgcn_s_getreg((3 << 11) | 20) & 0xFu; }
#define XB_SPIN(cond, bar) do { unsigned _sp = 0; while (cond) { __builtin_amdgcn_s_sleep(1); \
    if ((++_sp & 255u) == 0u) { if (xb_ld(&(bar)[XB_TMO])) break; if (_sp > XB_SPIN_CAP) { (void)xb_add(&(bar)[XB_TMO], 1u); break; } } } } while (0)
struct XcdBarrier { unsigned* bar; unsigned x; volatile LAS unsigned* st; int wave; };
__device__ __forceinline__ XcdBarrier xcd_barrier_post(unsigned* bar, volatile LAS unsigned* st, int wave) {
    XcdBarrier b; b.bar = bar; b.x = xb_xcc_id(); b.st = st; b.wave = wave;
    if (wave == 0 && lane_id() == 0) (void)xb_add(&bar[XB_XCNT(b.x)], 1u);
    return b;
}
__device__ __forceinline__ void xcd_barrier_complete(unsigned* bar, unsigned x, unsigned& nloc, unsigned& nx) {
    const unsigned G = gridDim.x * gridDim.y * gridDim.z;
    unsigned sum, cnt, mine, sp = 0u;
    for (;;) {
        sum = 0u; cnt = 0u; mine = 0u;
#pragma unroll
        for (unsigned j = 0; j < 16; ++j) { const unsigned c = xb_ld(&bar[XB_XCNT(j)]); sum += c; cnt += (c > 0u) ? 1u : 0u; mine = (j == x) ? c : mine; }
        if (sum == G) break;
        __builtin_amdgcn_s_sleep(1);
        if ((++sp & 255u) == 0u) { if (xb_ld(&bar[XB_TMO])) break; if (sp > XB_SPIN_CAP) { (void)xb_add(&bar[XB_TMO], 1u); break; } }
    }
    nloc = mine > 0u ? mine : 1u; nx = cnt > 0u ? cnt : 1u;
}
__device__ __forceinline__ void xcd_barrier(const XcdBarrier& b) {
    asm volatile("s_waitcnt vmcnt(0)" ::: "memory");
    __syncthreads();
    if (b.wave == 0 && lane_id() == 0) {
        unsigned* bar = b.bar; asm volatile("" : "+s"(bar));
        __builtin_amdgcn_s_waitcnt(0);
        unsigned nloc = b.st[0], nx = b.st[1];
        if (nloc == 0u) { xcd_barrier_complete(bar, b.x, nloc, nx); b.st[0] = nloc; b.st[1] = nx; }
        const unsigned old = xb_add(&bar[XB_XSUB(b.x)], 1u);
        const unsigned gen = old / nloc;
        if (old + 1u == (gen + 1u) * nloc) {
            __builtin_amdgcn_fence(__ATOMIC_RELEASE, "agent");
            asm volatile("s_waitcnt vmcnt(0)" ::: "memory");
            const unsigned og = xb_add(&bar[XB_TOP], 1u);
            const unsigned tg = og / nx;
            if (og + 1u == (tg + 1u) * nx) xb_add(&bar[XB_TOPGEN], 1u);
            else XB_SPIN(xb_ld(&bar[XB_TOPGEN]) == tg, bar);
            __builtin_amdgcn_fence(__ATOMIC_ACQUIRE, "agent");
            xb_add(&bar[XB_XGEN(b.x)], 1u);
            asm volatile("s_waitcnt vmcnt(0)" ::: "memory");
        } else {
            XB_SPIN(xb_ld(&bar[XB_XGEN(b.x)]) == gen, bar);
            __builtin_amdgcn_fence(__ATOMIC_ACQUIRE, "agent");
            asm volatile("s_waitcnt vmcnt(0)" ::: "memory");
        }
    }
    __syncthreads();
}

__device__ __forceinline__ const float* res_in0(KArgs a, int b, int p) {
    return (p < CTXL) ? a->in[2] + ((size_t)b * CTXL + p) * DM : a->in[0] + ((size_t)b * SEQ + (p - CTXL)) * DM;
}
__device__ __forceinline__ bf16_t* res_bf(KArgs a, int b, int p) {
    return (p < CTXL) ? (bf16_t*)(a->ws + WS_XC) + ((size_t)b * CTXL + p) * DM : (bf16_t*)(a->out + ((size_t)b * SEQ + (p - CTXL)) * DM);
}
__device__ __forceinline__ const float* mod_ptr(KArgs a, int layer, int b, bool isctx, int seg) {
    return (const float*)(a->ws + WS_MOD) + ((size_t)layer * 17 + (isctx ? 16 : b)) * (6 * DM) + (size_t)seg * DM;
}

template <bool F8>
__device__ __forceinline__ void transpose_item(const float* W, int K, int N, void* WTv, int rowmode, const float* kscale, LAS float* scr, int item, int lane) {
    const int nblk = N / 32, kb = item / nblk, nb = item - kb * nblk, k0 = 64 * kb, n0 = 32 * nb;
#pragma unroll 8
    for (int i = 0; i < 32; ++i) { const int kk = 2 * i + (lane >> 5); const int k = k0 + kk;
        float v = W[(size_t)k * N + n0 + (lane & 31)];
        if (kscale != nullptr && k >= 1024) v *= kscale[(k - 1024) & 255] * ONE_M_LI;
        scr[kk * 33 + (lane & 31)] = v; }
    LDS_WAIT(); asm volatile("" ::: "memory");
    const int c = lane & 7;
#pragma unroll
    for (int j = 0; j < 4; ++j) { const int n = (lane >> 3) + 8 * j; const LAS float* s = scr + (8 * c) * 33 + n;
        const int ng = n0 + n; const int dest = (rowmode == 0) ? ng : ((ng >> 7) * 256 + (ng & 127) + (rowmode == 2 ? 128 : 0));
        if constexpr (F8) { u32x2 o; o.x = cvt4_fp8(s[0 * 33] * W8SCALE, s[1 * 33] * W8SCALE, s[2 * 33] * W8SCALE, s[3 * 33] * W8SCALE); o.y = cvt4_fp8(s[4 * 33] * W8SCALE, s[5 * 33] * W8SCALE, s[6 * 33] * W8SCALE, s[7 * 33] * W8SCALE);
            *(u32x2*)((unsigned char*)WTv + (size_t)dest * K + k0 + 8 * c) = o; }
        else { u32x4 o; o.x = cvt_pk_bf16(s[0 * 33], s[1 * 33]); o.y = cvt_pk_bf16(s[2 * 33], s[3 * 33]); o.z = cvt_pk_bf16(s[4 * 33], s[5 * 33]); o.w = cvt_pk_bf16(s[6 * 33], s[7 * 33]);
            *(u32x4*)((bf16_t*)WTv + (size_t)dest * K + k0 + 8 * c) = o; } }
    LDS_WAIT(); asm volatile("" ::: "memory");
}
__device__ __forceinline__ void phase_prologue(KArgs a, LAS unsigned char* lds, int tid, int lane, int wave, int G) {
    const int bx = blockIdx.x;
    if (bx < 192) {
        const int l = bx / 96, jg = bx - l * 96;
        LAS float* S = (LAS float*)lds;
        for (int idx = tid; idx < 17 * DM; idx += 512) { const int r = idx >> 11, k = idx & 2047; const float v = (r < 16) ? a->in[1][r * DM + k] : a->in[3][k]; S[idx] = v / (1.0f + __expf(-v)); }
        __syncthreads();
        const int c2 = tid & 63, kp = wave;
        const float* wbase = a->in[4] + (size_t)l * DM * (6 * DM) + jg * 128 + 2 * c2;
        float acc0[17], acc1[17];
#pragma unroll
        for (int r = 0; r < 17; ++r) { acc0[r] = 0.f; acc1[r] = 0.f; }
#pragma unroll 2
        for (int k4 = 0; k4 < 64; ++k4) {
            const int k = kp * 256 + k4 * 4;
            f32x2 w[4];
#pragma unroll
            for (int q = 0; q < 4; ++q) w[q] = *(const f32x2*)(wbase + (size_t)(k + q) * (6 * DM));
#pragma unroll
            for (int r = 0; r < 17; ++r) { const f32x4 s4 = *(const LAS f32x4*)(S + r * DM + k);
#pragma unroll
                for (int q = 0; q < 4; ++q) { acc0[r] += s4[q] * w[q].x; acc1[r] += s4[q] * w[q].y; } }
        }
        __syncthreads();
        LAS float* P = (LAS float*)lds;
#pragma unroll
        for (int r = 0; r < 17; ++r) { P[(kp * 17 + r) * 128 + 2 * c2] = acc0[r]; P[(kp * 17 + r) * 128 + 2 * c2 + 1] = acc1[r]; }
        __syncthreads();
        float* MOD = (float*)(a->ws + WS_MOD);
        for (int idx = tid; idx < 17 * 128; idx += 512) { const int r = idx >> 7, cc = idx & 127; float s = 0.f;
#pragma unroll
            for (int q = 0; q < 8; ++q) s += P[(q * 17 + r) * 128 + cc];
            const int col = jg * 128 + cc; MOD[((size_t)l * 17 + r) * (6 * DM) + col] = s + a->in[5][l * (6 * DM) + col]; }
        __syncthreads();
    }
    {
        float* CS = (float*)(a->ws + WS_CS);
        for (int idx = bx * 512 + tid; idx < SEQ * 64; idx += G * 512) { const int t = idx >> 6, p = idx & 63; const int i = p & 31;
            const float inv = powf(10000.0f, -(float)i / 32.0f); const float pos = (p < 32) ? (float)(t / GRIDW) : (float)(t % GRIDW); const float ang = pos * inv;
            CS[2 * idx] = cosf(ang); CS[2 * idx + 1] = sinf(ang); }
    }
    {
        LAS float* scr = (LAS float*)(lds + wave * 16384);
        const int gwv = bx * 8 + wave, NGW = G * 8;
        constexpr int I_IN = 32 * 144, I_OUT = 32 * 64, I_E = 1024;
        constexpr int NITEMS = 2 * I_IN + 2 * I_OUT + 3 * 32 * I_E;
        bf16_t* WIN = (bf16_t*)(a->ws + WS_WIN); bf16_t* WOUT = (bf16_t*)(a->ws + WS_WOUT); bf16_t* WGU = (bf16_t*)(a->ws + WS_WGU); bf16_t* WD = (bf16_t*)(a->ws + WS_WD);
        for (int it = gwv; it < NITEMS; it += NGW) {
            int r = it;
            if (r < I_IN) { transpose_item<true>(a->in[10], DM, NQKV, (unsigned char*)WIN, 0, nullptr, scr, r, lane); continue; } r -= I_IN;
            if (r < I_IN) { transpose_item<true>(a->in[14], DM, NQKV, (unsigned char*)WIN + (size_t)NQKV * DM, 0, nullptr, scr, r, lane); continue; } r -= I_IN;
            if (r < I_OUT) { transpose_item<true>(a->in[11], DM, DM, (unsigned char*)WOUT, 0, nullptr, scr, r, lane); continue; } r -= I_OUT;
            if (r < I_OUT) { transpose_item<true>(a->in[15], DM, DM, (unsigned char*)WOUT + (size_t)DM * DM, 0, a->in[22], scr, r, lane); continue; } r -= I_OUT;
            if (r < 32 * I_E) { const int le = r >> 10, ri = r & 1023; transpose_item<true>(a->in[25] + (size_t)le * DM * FF, DM, FF, (unsigned char*)WGU + (size_t)le * DM * DM, 1, nullptr, scr, ri, lane); continue; } r -= 32 * I_E;
            if (r < 32 * I_E) { const int le = r >> 10, ri = r & 1023; transpose_item<true>(a->in[26] + (size_t)le * DM * FF, DM, FF, (unsigned char*)WGU + (size_t)le * DM * DM, 2, nullptr, scr, ri, lane); continue; } r -= 32 * I_E;
            { const int le = r >> 10, ri = r & 1023; transpose_item<true>(a->in[27] + (size_t)le * FF * DM, FF, DM, (unsigned char*)WD + (size_t)le * DM * FF, 0, nullptr, scr, ri, lane); }
        }
    }
}

__device__ __forceinline__ void phase_h0(KArgs a, LAS unsigned char* lds, int tid, int lane, int wave) {
    unsigned char* H = (unsigned char*)(a->ws + WS_H);
    const int bx = blockIdx.x, b = bx >> 4; LAS float* L = (LAS float*)lds;
    for (int k = tid; k < DM; k += 512) { L[k] = mod_ptr(a, 0, b, false, 1)[k] + 1.0f; L[DM + k] = mod_ptr(a, 0, b, false, 0)[k]; L[2 * DM + k] = mod_ptr(a, 0, b, true, 1)[k] + 1.0f; L[3 * DM + k] = mod_ptr(a, 0, b, true, 0)[k]; }
    __syncthreads();
    const unsigned l16 = lane * 16, l4 = lane * 4;
    for (int i = wave; i < 144; i += 8) {
        const int row = bx * 144 + i, p = row - b * PB; const bool isctx = p < CTXL;
        const float* x = res_in0(a, b, p); unsigned char* hp = H + (size_t)row * DM; asm volatile("" : "+s"(x), "+s"(hp));
        const LAS unsigned char* V = lds + (isctx ? 2 * DM * 4 : 0);
#pragma unroll
        for (int j = 0; j < 8; ++j) { const f32x4 xv = *(const GAS f32x4*)((const GAS char*)x + l16 + j * 1024), s1 = *(const LAS f32x4*)(V + l16 + j * 1024), s0 = *(const LAS f32x4*)(V + DM * 4 + l16 + j * 1024);
            const f32x4 h = xv * s1 + s0; *(GAS unsigned*)((GAS unsigned char*)hp + l4 + j * 256) = cvt4_fp8(h[0], h[1], h[2], h[3]); }
    }
    __syncthreads();
}

__device__ __forceinline__ void phase_prep(KArgs a, int lane, int gwv, int ngw) {
    const bf16_t* RAW = (const bf16_t*)(a->ws + WS_QKV); unsigned char* Q8 = (unsigned char*)(a->ws + WS_Q8); unsigned char* QN8 = (unsigned char*)(a->ws + WS_QN); const float* CS = (const float*)(a->ws + WS_CS); unsigned char* K8 = (unsigned char*)(a->ws + WS_K8);
    const f32x2 gq = *(const f32x2*)(a->in[16] + 2 * lane), gk = *(const f32x2*)(a->in[17] + 2 * lane);
    for (int row = gwv; row < MROWS; row += ngw) {
        const int b = row / PB, p = row - b * PB; const bool isctx = p < CTXL;
        f32x2 cs = (f32x2){1.f, 0.f}; if (!isctx) cs = *(const f32x2*)(CS + ((size_t)(p - CTXL) * 64 + lane) * 2);
        for (int h = (isctx ? 8 : 0); h < 10; ++h) {
            const unsigned w = *((const unsigned*)(RAW + (size_t)row * 1280 + h * HD) + lane);
            const float x0 = bf_lo(w), x1 = bf_hi(w); const float ss = wave_sum(x0 * x0 + x1 * x1);
            const float rstd = 1.0f / sqrtf(ss * (1.0f / 128.0f) + 1e-6f); const f32x2 g = (h < 8) ? gq : gk;
            const float y0 = x0 * rstd * g.x, y1 = x1 * rstd * g.y;
            const float r0 = y0 * cs.x - y1 * cs.y, r1 = y0 * cs.y + y1 * cs.x;
            if (h < 8) *((unsigned short*)(Q8 + (size_t)row * NQKV + h * HD) + lane) = (unsigned short)__builtin_amdgcn_cvt_pk_fp8_f32(y0, y1, 0, false);
            else *((unsigned short*)(K8 + (size_t)row * 1280 + (h - 8) * HD) + lane) = (unsigned short)__builtin_amdgcn_cvt_pk_fp8_f32(r0, r1, 0, false);
        }
    }
}

__device__ __forceinline__ void phase_combine(KArgs a, int lane, int gwv, int ngw) {
    const bf16_t* OD = (const bf16_t*)(a->ws + WS_H); unsigned char* O = (unsigned char*)(a->ws + WS_O);
    float lam;
    { const f32x2 q1 = *(const f32x2*)(a->in[18] + 2 * lane), k1 = *(const f32x2*)(a->in[19] + 2 * lane), q2 = *(const f32x2*)(a->in[20] + 2 * lane), k2 = *(const f32x2*)(a->in[21] + 2 * lane);
      const float d1 = wave_sum(q1.x * k1.x + q1.y * k1.y), d2 = wave_sum(q2.x * k2.x + q2.y * k2.y); lam = expf(d1) - expf(d2) + LAMBDA_INIT1; }
    for (int idx = gwv; idx < NB * SEQ * 4; idx += ngw) {
        const int h = idx & 3, lr = idx >> 2; const int b = lr / SEQ, t = lr - b * SEQ; const int row = b * PB + CTXL + t;
        const u32x2 w0 = *(const u32x2*)(OD + (size_t)row * 1024 + h * 256 + 4 * lane), w1 = *(const u32x2*)(OD + (size_t)MROWS * 1024 + (size_t)row * 1024 + h * 256 + 4 * lane);
        const float d0 = bf_lo(w0.x) - lam * bf_lo(w1.x), d1 = bf_hi(w0.x) - lam * bf_hi(w1.x), d2 = bf_lo(w0.y) - lam * bf_lo(w1.y), d3 = bf_hi(w0.y) - lam * bf_hi(w1.y);
        const float ss = wave_sum(d0 * d0 + d1 * d1 + d2 * d2 + d3 * d3); const float rstd = 1.0f / sqrtf(ss * (1.0f / 256.0f) + 1e-6f);
        const float rs = rstd * att_OSCALE;
        *(unsigned*)(O + (size_t)row * DM + 1024 + h * 256 + 4 * lane) = cvt4_fp8(d0 * rs, d1 * rs, d2 * rs, d3 * rs);
    }
}
#define UNI(p) asm volatile("" : "+s"(p))
#define LD4F(p, j) (*(const GAS f32x4*)((const GAS char*)(p) + l16 + (j) * 1024))
#define LD4H(p, j) (*(const GAS u32x2*)((const GAS char*)(p) + l8 + (j) * 512))
#define LD4B(p, j) (*(const GAS unsigned*)((const GAS char*)(p) + l4 + (j) * 256))
__device__ __forceinline__ int ln_row(int layer, int n) { return layer == 0 ? n : (n >> 11) * PB + CTXL + (n & 2047); }
__device__ __forceinline__ void phase_ln1(KArgs a, int layer, LAS unsigned char* lds, int tid, int lane, int gwv, int ngw, bool dry = false) {
    LAS float* WT = (LAS float*)lds;
    for (int k = tid; k < DM; k += 512) { const f32x4* wr = (const f32x4*)(a->in[23] + (size_t)k * 16);
#pragma unroll
        for (int c = 0; c < 4; ++c) { const f32x4 w = wr[c]; WT[(4 * c + 0) * DM + k] = w[0]; WT[(4 * c + 1) * DM + k] = w[1]; WT[(4 * c + 2) * DM + k] = w[2]; WT[(4 * c + 3) * DM + k] = w[3]; } }
    const int wg_ = gwv >> 3; const bool stc = (layer == 0) && ((wg_ & 15) < 2); const int sb_ = wg_ >> 4;
    LAS float* A2 = (LAS float*)(lds + RING_BYTES); LAS float* B2 = A2 + DM; LAS bf16_t* G1h = (LAS bf16_t*)(lds + RING_BYTES + 16384); LAS bf16_t* LGh = G1h + DM; LAS bf16_t* LBh = LGh + DM;
    for (int k = tid; k < DM; k += 512) { const float lg = a->in[6][layer * DM + k], lb = a->in[7][layer * DM + k], s2 = mod_ptr(a, layer, sb_, stc, 4)[k] + 1.0f, sh = mod_ptr(a, layer, sb_, stc, 3)[k];
        A2[k] = lg * s2; B2[k] = lb * s2 + sh; const unsigned w = cvt_pk_bf16(mod_ptr(a, layer, sb_, stc, 2)[k], lg); G1h[k] = (bf16_t)(w & 0xffffu); LGh[k] = (bf16_t)(w >> 16); LBh[k] = (bf16_t)(cvt_pk_bf16(lb, lb) & 0xffffu); }
    LAS unsigned* lcnt = (LAS unsigned*)(lds + RING_BYTES + 16384 + 12288); LAS unsigned* nent = lcnt + 16; LAS unsigned* gbase = lcnt + 32; LAS unsigned* ent = lcnt + 64;
    if (tid < 17) lcnt[tid] = 0u;
    __syncthreads();
    const unsigned l16 = lane * 16, l8 = lane * 8, l4 = lane * 4;
    float* GW = (float*)(a->ws + WS_GW); int* LIST = (int*)(a->ws + WS_LIST); int* PPOS = (int*)(a->ws + WS_PPOS); unsigned* CNT = (unsigned*)(a->ws + WS_CTL) + CW_CNT + layer * 16 * 64;
    const int NV = layer == 0 ? MROWS : NB * SEQ;
    const int my_e = (lane >> 1) & 15, my_g = my_e >> 2, my_i = my_e & 3;
    const float my_rb = a->in[24][my_e];
    const int npw = NV / 2 / (ngw >> 3), wv = gwv & 7, pr0 = (gwv >> 3) * npw;
    for (int pi = wv; pi < npw; pi += 8) { const int pr = pr0 + pi;
        f32x4 v[2][8]; int rows[2];
        const int row0 = ln_row(layer, 2 * pr); rows[0] = row0; rows[1] = row0 + 1;
        const int b = row0 / PB, p = row0 - b * PB; const bool isctx = p < CTXL;
        const float* g1 = mod_ptr(a, layer, b, isctx, 2); const float* sh2 = mod_ptr(a, layer, b, isctx, 3); const float* sc2 = mod_ptr(a, layer, b, isctx, 4);
        const float* lng = a->in[6] + layer * DM; const float* lnb = a->in[7] + layer * DM; UNI(lng); UNI(lnb);
        const float* x0 = res_in0(a, b, p); const float* x1p = res_in0(a, b, p + 1); bf16_t* xb0 = res_bf(a, b, p); bf16_t* xb1 = res_bf(a, b, p + 1);
        const unsigned char* y0 = (const unsigned char*)(a->ws + WS_QKV) + (size_t)row0 * DM; const unsigned char* y1 = y0 + DM;
        unsigned char* h80 = (unsigned char*)(a->ws + WS_H) + (size_t)row0 * DM; unsigned char* h81 = h80 + DM;
        bf16_t* xo0 = xb0; bf16_t* xo1 = xb1;
        if (dry) { xo0 = (bf16_t*)(a->ws + WS_QN) + (size_t)row0 * DM; xo1 = xo0 + DM; h80 = (unsigned char*)(a->ws + WS_QN + 160 * MiB) + (size_t)row0 * DM; h81 = h80 + DM; }
        UNI(g1); UNI(sh2); UNI(sc2); UNI(x0); UNI(x1p); UNI(xb0); UNI(xb1); UNI(y0); UNI(y1); UNI(h80); UNI(h81); UNI(xo0); UNI(xo1);
        float s0 = 0.f, s1 = 0.f;
        const bool fast = (isctx == stc);
#pragma unroll
        for (int j = 0; j < 8; ++j) { f32x4 gv; if (fast) { const u32x2 gw_ = *(const LAS u32x2*)((const LAS unsigned char*)G1h + l8 + j * 512); gv[0] = bf_lo(gw_.x); gv[1] = bf_hi(gw_.x); gv[2] = bf_lo(gw_.y); gv[3] = bf_hi(gw_.y); } else gv = LD4F(g1, j);
#pragma unroll
            for (int q = 0; q < 2; ++q) { f32x4 xv; if (layer == 0) xv = LD4F(q ? x1p : x0, j); else { const u32x2 xw = LD4H(q ? xb1 : xb0, j); xv[0] = bf_lo(xw.x); xv[1] = bf_hi(xw.x); xv[2] = bf_lo(xw.y); xv[3] = bf_hi(xw.y); }
                const f32x4 yv = fp8x4_to_f32(LD4B(q ? y1 : y0, j)) * (1.0f / Y8SCALE);
                v[q][j] = xv * ALPHA + gv * yv; const float ss = (v[q][j][0] + v[q][j][1]) + (v[q][j][2] + v[q][j][3]); if (q) s1 += ss; else s0 += ss; } }
        const float mean0 = wave_sum(s0) * (1.0f / DM), mean1 = wave_sum(s1) * (1.0f / DM); float q0 = 0.f, q1 = 0.f;
#pragma unroll
        for (int j = 0; j < 8; ++j) { v[0][j] = v[0][j] - mean0; q0 += (v[0][j][0] * v[0][j][0] + v[0][j][1] * v[0][j][1]) + (v[0][j][2] * v[0][j][2] + v[0][j][3] * v[0][j][3]);
            v[1][j] = v[1][j] - mean1; q1 += (v[1][j][0] * v[1][j][0] + v[1][j][1] * v[1][j][1]) + (v[1][j][2] * v[1][j][2] + v[1][j][3] * v[1][j][3]); }
        const float rstd0 = 1.0f / sqrtf(wave_sum(q0) * (1.0f / DM) + 1e-5f), rstd1 = 1.0f / sqrtf(wave_sum(q1) * (1.0f / DM) + 1e-5f);
#pragma unroll
        for (int j = 0; j < 8; ++j) { f32x4 lg4, lb4, a4, b4;
            if (fast) { const u32x2 gw_ = *(const LAS u32x2*)((const LAS unsigned char*)LGh + l8 + j * 512), bw_ = *(const LAS u32x2*)((const LAS unsigned char*)LBh + l8 + j * 512);
                lg4[0] = bf_lo(gw_.x); lg4[1] = bf_hi(gw_.x); lg4[2] = bf_lo(gw_.y); lg4[3] = bf_hi(gw_.y); lb4[0] = bf_lo(bw_.x); lb4[1] = bf_hi(bw_.x); lb4[2] = bf_lo(bw_.y); lb4[3] = bf_hi(bw_.y);
                a4 = *(const LAS f32x4*)((const LAS unsigned char*)A2 + l16 + j * 1024); b4 = *(const LAS f32x4*)((const LAS unsigned char*)B2 + l16 + j * 1024); }
            else { lg4 = LD4F(lng, j); lb4 = LD4F(lnb, j); const f32x4 s4 = LD4F(sc2, j) + 1.0f; a4 = lg4 * s4; b4 = lb4 * s4 + LD4F(sh2, j); }
#pragma unroll
            for (int q = 0; q < 2; ++q) { const f32x4 nn = v[q][j] * (q ? rstd1 : rstd0); const f32x4 x1 = nn * lg4 + lb4;
                { u32x2 w; w.x = cvt_pk_bf16(x1[0], x1[1]); w.y = cvt_pk_bf16(x1[2], x1[3]); *(GAS u32x2*)((GAS char*)(q ? xo1 : xo0) + l8 + j * 512) = w; }
                const f32x4 h2 = nn * a4 + b4; v[q][j] = h2;
                *(GAS unsigned*)((GAS unsigned char*)(q ? h81 : h80) + l4 + j * 256) = cvt4_fp8(h2[0], h2[1], h2[2], h2[3]); } }
        if (LN1_DRYVAR >= 1 && dry) continue;
        float t[32];
#pragma unroll
        for (int e = 0; e < 16; ++e) { float t0 = 0.f, t1 = 0.f;
#pragma unroll
            for (int j = 0; j < 8; ++j) { const f32x4 w4 = *(const LAS f32x4*)(WT + e * DM + 4 * lane + 256 * j);
                t0 += (v[0][j][0] * w4[0] + v[0][j][1] * w4[1]) + (v[0][j][2] * w4[2] + v[0][j][3] * w4[3]);
                t1 += (v[1][j][0] * w4[0] + v[1][j][1] * w4[1]) + (v[1][j][2] * w4[2] + v[1][j][3] * w4[3]); }
            t[e] = t0; t[16 + e] = t1; }
#define RSTEP(N, BIT, OFF) _Pragma("unroll") for (int i = 0; i < N; ++i) { const bool up = (lane & BIT) != 0; const float send = up ? t[i] : t[N + i], keep = up ? t[N + i] : t[i]; t[i] = keep + __shfl_xor(send, OFF); }
        RSTEP(16, 32, 32) RSTEP(8, 16, 16) RSTEP(4, 8, 8) RSTEP(2, 4, 4) RSTEP(1, 2, 2)
#undef RSTEP
        const float lg = t[0] + __shfl_xor(t[0], 1);
        const float sc = 1.0f / (1.0f + __expf(-lg)), bi = sc + my_rb;
        const float b1 = __shfl_xor(bi, 2), b2 = __shfl_xor(bi, 4), b3 = __shfl_xor(bi, 6);
        const float h1 = fmaxf(bi, b1), l1 = fminf(bi, b1), h2m = fmaxf(b2, b3), l2 = fminf(b2, b3);
        const float gs = fmaxf(h1, h2m) + fmaxf(fminf(h1, h2m), fmaxf(l1, l2));
        const int rank = ((b1 > bi) || (b1 == bi && (my_i ^ 1) < my_i)) + ((b2 > bi) || (b2 == bi && (my_i ^ 2) < my_i)) + ((b3 > bi) || (b3 == bi && (my_i ^ 3) < my_i));
        const float g1s = __shfl_xor(gs, 8), g2s = __shfl_xor(gs, 16), g3s = __shfl_xor(gs, 24);
        const bool best = !((g1s > gs) || (g1s == gs && (my_g ^ 1) < my_g)) && !((g2s > gs) || (g2s == gs && (my_g ^ 2) < my_g)) && !((g3s > gs) || (g3s == gs && (my_g ^ 3) < my_g));
        const float c = (rank < 2) ? sc : 0.f;
        const float csum = c + __shfl_xor(c, 2) + __shfl_xor(c, 4) + __shfl_xor(c, 6);
        if (best && rank < 2 && (lane & 1) == 0 && !dry) {
            const int row = (lane & 32) ? rows[1] : rows[0]; const int pair = 2 * row + rank;
            const unsigned lp = __hip_atomic_fetch_add(lcnt + my_e, 1u, __ATOMIC_RELAXED, __HIP_MEMORY_SCOPE_WORKGROUP);
            const unsigned slot = __hip_atomic_fetch_add(nent, 1u, __ATOMIC_RELAXED, __HIP_MEMORY_SCOPE_WORKGROUP);
            ent[slot] = (unsigned)pair | ((unsigned)my_e << 17) | (lp << 21);
            GW[pair] = sc / csum;
        }
    }
    __syncthreads();
    if (tid < 16) { const unsigned n = lcnt[tid]; gbase[tid] = n ? __hip_atomic_fetch_add(CNT + tid * 64, n, __ATOMIC_RELAXED, __HIP_MEMORY_SCOPE_AGENT) : 0u; }
    __syncthreads();
    { const unsigned ne = nent[0]; for (unsigned i = tid; i < ne; i += 512) { const unsigned w = ent[i]; const unsigned e = (w >> 17) & 15u; const unsigned pos = gbase[e] + (w >> 21); LIST[(size_t)e * LCAP + pos] = (int)(w & 0x1FFFFu); PPOS[w & 0x1FFFFu] = (int)((e << 20) | pos); } }
}

__device__ __forceinline__ void phase_ln2(KArgs a, int layer, LAS unsigned char* lds, int tid, int lane, int gwv, int ngw, bool dry = false) {
    const unsigned l16 = lane * 16, l8 = lane * 8, l4 = lane * 4;
    const int NV = layer == 0 ? MROWS : NB * SEQ;
    const int npw = NV / 2 / (ngw >> 3), wv = gwv & 7, wg = gwv >> 3, pr0 = wg * npw, b = wg >> 4;
    LAS float* L = (LAS float*)lds;
    for (int k = tid; k < DM; k += 512) { L[k] = a->in[8][layer * DM + k]; L[DM + k] = a->in[9][layer * DM + k];
        L[2 * DM + k] = mod_ptr(a, layer, b, false, 5)[k]; L[3 * DM + k] = mod_ptr(a, 1, b, false, 1)[k] + 1.0f; L[4 * DM + k] = mod_ptr(a, 1, b, false, 0)[k];
        L[5 * DM + k] = mod_ptr(a, layer, b, true, 5)[k]; L[6 * DM + k] = mod_ptr(a, 1, b, true, 1)[k] + 1.0f; L[7 * DM + k] = mod_ptr(a, 1, b, true, 0)[k]; }
    LAS int* TBE = (LAS int*)(lds + 8 * DM * 4);
    if (tid == 0) { int base = 0; for (int e = 0; e < 16; ++e) { TBE[e] = base * 256; base += ((int)__hip_atomic_load((unsigned*)(a->ws + WS_CTL) + CW_CNT + (layer * 16 + e) * 64, __ATOMIC_RELAXED, __HIP_MEMORY_SCOPE_AGENT) + 255) >> 8; } }
    __syncthreads();
#define LV(idx, j) (*(const LAS f32x4*)(lds + (idx) * (DM * 4) + l16 + (j) * 1024))
    for (int pi = wv; pi < npw; pi += 8) { const int pr = pr0 + pi;
        const int row0 = ln_row(layer, 2 * pr);
        const int p = row0 - b * PB; const bool isctx = p < CTXL; const int vo = isctx ? 3 : 0;
        bf16_t* xo0 = res_bf(a, b, p); bf16_t* xo1 = res_bf(a, b, p + 1);
        const u32x4 pp4 = *(const u32x4*)((const int*)(a->ws + WS_PPOS) + 2 * row0); const f32x4 gw4 = *(const f32x4*)((const float*)(a->ws + WS_GW) + 2 * row0) * (1.0f / Y8SCALE);
        const unsigned char* DNS = (const unsigned char*)(a->ws + WS_QKV);
        const int sl0 = __builtin_amdgcn_readfirstlane(TBE[pp4.x >> 20] + (int)(pp4.x & 0xFFFFFu)), sl1 = __builtin_amdgcn_readfirstlane(TBE[pp4.y >> 20] + (int)(pp4.y & 0xFFFFFu));
        const int sl2 = __builtin_amdgcn_readfirstlane(TBE[pp4.z >> 20] + (int)(pp4.z & 0xFFFFFu)), sl3 = __builtin_amdgcn_readfirstlane(TBE[pp4.w >> 20] + (int)(pp4.w & 0xFFFFFu));
        const unsigned char* dn0 = DNS + (size_t)sl0 * DM; const unsigned char* dn1 = DNS + (size_t)sl1 * DM; const unsigned char* dn2 = DNS + (size_t)sl2 * DM; const unsigned char* dn3 = DNS + (size_t)sl3 * DM;
        unsigned char* hp0 = (unsigned char*)(a->ws + WS_H) + (size_t)row0 * DM; unsigned char* hp1 = hp0 + DM;
        bf16_t* xw0 = xo0; bf16_t* xw1 = xo1;
        if (dry) { xw0 = (bf16_t*)(a->ws + WS_QN) + (size_t)row0 * 2 * DM; xw1 = xw0 + 2 * DM; hp0 = (unsigned char*)(a->ws + WS_H) + (size_t)MROWS * DM + (size_t)row0 * DM; hp1 = hp0 + DM; }
        UNI(xo0); UNI(xo1); UNI(hp0); UNI(hp1); UNI(xw0); UNI(xw1);
        f32x4 v[2][8]; float s0 = 0.f, s1 = 0.f;
#pragma unroll
        for (int j = 0; j < 8; ++j) { const f32x4 gv = LV(2 + vo, j);
#pragma unroll
            for (int q = 0; q < 2; ++q) { const u32x2 xw = LD4H(q ? xo1 : xo0, j); f32x4 xv; xv[0] = bf_lo(xw.x); xv[1] = bf_hi(xw.x); xv[2] = bf_lo(xw.y); xv[3] = bf_hi(xw.y);
                const f32x4 f = fp8x4_to_f32(LD4B(q ? dn2 : dn0, j)) * (q ? gw4[2] : gw4[0]) + fp8x4_to_f32(LD4B(q ? dn3 : dn1, j)) * (q ? gw4[3] : gw4[1]);
                v[q][j] = xv * ALPHA + gv * f; const float ss = (v[q][j][0] + v[q][j][1]) + (v[q][j][2] + v[q][j][3]); if (q) s1 += ss; else s0 += ss; } }
        const float mean0 = wave_sum(s0) * (1.0f / DM), mean1 = wave_sum(s1) * (1.0f / DM); float q0 = 0.f, q1 = 0.f;
#pragma unroll
        for (int j = 0; j < 8; ++j) { v[0][j] = v[0][j] - mean0; q0 += (v[0][j][0] * v[0][j][0] + v[0][j][1] * v[0][j][1]) + (v[0][j][2] * v[0][j][2] + v[0][j][3] * v[0][j][3]);
            v[1][j] = v[1][j] - mean1; q1 += (v[1][j][0] * v[1][j][0] + v[1][j][1] * v[1][j][1]) + (v[1][j][2] * v[1][j][2] + v[1][j][3] * v[1][j][3]); }
        const float rstd0 = 1.0f / sqrtf(wave_sum(q0) * (1.0f / DM) + 1e-5f), rstd1 = 1.0f / sqrtf(wave_sum(q1) * (1.0f / DM) + 1e-5f);
#pragma unroll
        for (int j = 0; j < 8; ++j) { const f32x4 lg4 = LV(0, j), lb4 = LV(1, j); f32x4 sc4 = lg4, sh4 = lb4; if (layer == 0) { sc4 = LV(3 + vo, j); sh4 = LV(4 + vo, j); }
#pragma unroll
            for (int q = 0; q < 2; ++q) { const f32x4 x2 = v[q][j] * (q ? rstd1 : rstd0) * lg4 + lb4;
                if (layer == 1) *(GAS f32x4*)((GAS char*)(q ? xw1 : xw0) + l16 + j * 1024) = x2;
                else { u32x2 w; w.x = cvt_pk_bf16(x2[0], x2[1]); w.y = cvt_pk_bf16(x2[2], x2[3]); *(GAS u32x2*)((GAS char*)(q ? xw1 : xw0) + l8 + j * 512) = w;
                    const f32x4 h = x2 * sc4 + sh4; *(GAS unsigned*)((GAS char*)(q ? hp1 : hp0) + l4 + j * 256) = cvt4_fp8(h[0], h[1], h[2], h[3]); } } }
    }
#undef LV
    __syncthreads();
}
#undef LD4F
#undef LD4H
#undef LD4B
#undef UNI

__device__ __forceinline__ float dot128(const LAS float* q, const bf16_t* kp) {
    float s = 0.f;
#pragma unroll
    for (int c = 0; c < 16; ++c) { const u32x4 kv = *(const u32x4*)(kp + 8 * c); const f32x4 qa = *(const LAS f32x4*)(q + 8 * c), qb = *(const LAS f32x4*)(q + 8 * c + 4);
        s += (qa[0] * bf_lo(kv.x) + qa[1] * bf_hi(kv.x)) + (qa[2] * bf_lo(kv.y) + qa[3] * bf_hi(kv.y)) + (qb[0] * bf_lo(kv.z) + qb[1] * bf_hi(kv.z)) + (qb[2] * bf_lo(kv.w) + qb[3] * bf_hi(kv.w)); }
    return s;
}
__device__ __forceinline__ int naive_local_row(int mode, int b, int idx, int lo, int r0, int c0) {
    if (mode == 0) return b * PB + CTXL + lo + idx;
    if (mode == 1) return b * PB + CTXL + (r0 + (idx >> 4)) * GRIDW + c0 + (idx & 15);
    return b * PB + CTXL + idx;
}
__device__ __forceinline__ void naive_attn_task(KArgs a, int layer, int task, LAS float* wl, int lane) {
    const bf16_t* QKV = (const bf16_t*)(a->ws + WS_QKV); const bf16_t* QN = (const bf16_t*)(a->ws + WS_QN); bf16_t* O = (bf16_t*)(a->ws + WS_O); bf16_t* OD = (bf16_t*)(a->ws + WS_H);
    constexpr int NL = NB * 8 * SEQ, NX = NB * 8 * CTXL;
    int mode, idx;
    if (layer == 0) { if (task < NL) { mode = 0; idx = task; } else if (task < 2 * NL) { mode = 1; idx = task - NL; } else if (task < 2 * NL + NX) { mode = 2; idx = task - 2 * NL; } else { mode = 3; idx = task - 2 * NL - NX; } }
    else { if (task < NL) { mode = 4; idx = task; } else { mode = 5; idx = task - NL; } }
    const bool ctxq = (mode == 2 || mode == 3); const int nq = ctxq ? CTXL : SEQ;
    const int qi = idx % nq, h = (idx / nq) & 7, b = idx / (nq * 8);
    const int qrow = b * PB + (ctxq ? qi : CTXL + qi);
    const bool bfam = (mode == 1 || mode == 3);
    const int qcol = (bfam || mode == 5) ? 1536 + h * HD : h * HD;
    const int kcol = bfam ? 2560 + h * HD : (mode == 5 ? 2560 + h * HD : 1024 + (h >> 2) * HD);
    const int vcol = bfam ? 3584 + h * HD : (mode == 5 ? 3584 + (h >> 1) * 256 : 1280 + (h >> 2) * HD);
    LAS float* sc = wl; LAS float* qr = wl + 2304; LAS float* qn = wl + 2304 + 128;
    { const unsigned w = *((const unsigned*)(QKV + (size_t)qrow * NQKV + qcol) + lane); qr[2 * lane] = bf_lo(w); qr[2 * lane + 1] = bf_hi(w);
      unsigned w2 = w;
      if (mode == 0 || mode == 4) w2 = *((const unsigned*)(QN + (size_t)qrow * DM + h * HD) + lane);
      if (mode == 5) w2 = *((const unsigned*)(QN + (size_t)qrow * DM + 1024 + h * HD) + lane);
      qn[2 * lane] = bf_lo(w2); qn[2 * lane + 1] = bf_hi(w2); }
    LDS_WAIT();
    int nloc = 0, lo = 0, r0 = 0, c0 = 0; const int rq = qi >> 6, cq = qi & 63;
    if (mode == 0) { lo = max(0, qi - 128); const int hi = min(SEQ - 1, qi + 128); nloc = hi - lo + 1; }
    else if (mode == 1) { r0 = min(max(rq - 4, 0), 24); c0 = min(max(cq - 8, 0), 48); nloc = 128; }
    else if (mode >= 4) nloc = SEQ;
    float mx = -1e30f;
    for (int j = lane; j < CTXL; j += 64) { const float s = dot128(qn, QKV + (size_t)(b * PB + j) * NQKV + kcol) * SM_SCALE; sc[j] = s; mx = fmaxf(mx, s); }
    for (int j = lane; j < nloc; j += 64) { const int kr = naive_local_row(mode, b, j, lo, r0, c0);
        float s = dot128(qr, QKV + (size_t)kr * NQKV + kcol) * SM_SCALE;
        if (mode == 1) { const int krr = r0 + (j >> 4), kcc = c0 + (j & 15); s += a->in[13][h * 465 + (krr - rq + 7) * 31 + (kcc - cq + 15)]; }
        sc[CTXL + j] = s; mx = fmaxf(mx, s); }
    mx = wave_max(mx);
    const bool sink = (mode == 0 || mode == 2); const float sk = sink ? a->in[12][h] : 0.f;
    if (sink) mx = fmaxf(mx, sk);
    float sum = 0.f; const int ntot = CTXL + nloc;
    for (int j = lane; j < ntot; j += 64) { const float pp = __expf(sc[j] - mx); sc[j] = pp; sum += pp; }
    sum = wave_sum(sum); if (sink) sum += __expf(sk - mx);
    LDS_WAIT();
    const float inv = 1.0f / sum;
    if (mode != 5) {
        float a0 = 0.f, a1 = 0.f;
        for (int j = 0; j < ntot; ++j) { const int kr = (j < CTXL) ? b * PB + j : naive_local_row(mode, b, j - CTXL, lo, r0, c0);
            const float pp = sc[j]; const unsigned w = *((const unsigned*)(QKV + (size_t)kr * NQKV + vcol) + lane); a0 += pp * bf_lo(w); a1 += pp * bf_hi(w); }
        const int ocol = bfam ? 1024 + h * HD : h * HD;
        *((unsigned*)(O + (size_t)qrow * DM + ocol) + lane) = cvt_pk_bf16(a0 * inv, a1 * inv);
    } else {
        float a0 = 0.f, a1 = 0.f, a2 = 0.f, a3 = 0.f;
        for (int j = 0; j < ntot; ++j) { const int kr = (j < CTXL) ? b * PB + j : b * PB + j;
            const float pp = sc[j]; const u32x2 w = *((const u32x2*)(QKV + (size_t)kr * NQKV + vcol) + lane); a0 += pp * bf_lo(w.x); a1 += pp * bf_hi(w.x); a2 += pp * bf_lo(w.y); a3 += pp * bf_hi(w.y); }
        u32x2 o; o.x = cvt_pk_bf16(a0 * inv, a1 * inv); o.y = cvt_pk_bf16(a2 * inv, a3 * inv);
        *((u32x2*)(OD + (size_t)(h & 1) * MROWS * 1024 + (size_t)qrow * 1024 + (h >> 1) * 256) + lane) = o;
    }
    LDS_WAIT();
}
__device__ __noinline__ void phase_attn_naive(KArgs a, int layer, LAS unsigned char* lds, int lane, int wave, int gwv, int ngw) {
    LAS float* wl = (LAS float*)(lds + wave * 10240);
    const int ntask = (layer == 0) ? 2 * NB * 8 * SEQ + 2 * NB * 8 * CTXL : 2 * NB * 8 * SEQ;
    for (int t = gwv; t < ntask; t += ngw) naive_attn_task(a, layer, t, wl, lane);
}
namespace att {
constexpr int LDK8 = 1280, LDV8 = 1280;
constexpr int SHM_V = 64 * 128 * 2, SHM_K = 64 * 128 * 2;
constexpr int OFF_V = 0, OFF_K = 2 * SHM_V, OFF_WS = 2 * SHM_V + 2 * SHM_K, OFF_BT = OFF_WS + 8 * 256, ATT_LDS = OFF_BT + 2048;
constexpr float THR = 6.f;
constexpr float NEGM = -1e30f;
constexpr float OSCALE = att_OSCALE;
using s16x4 = __attribute__((ext_vector_type(4))) short;
#define KSWZ(row, colB) ((row) * 256 + ((colB) ^ (((row) & 7) << 4)))
#define SBAR() __builtin_amdgcn_sched_barrier(0)
__device__ __forceinline__ int crow(int r, int hi) { return (r & 3) + 8 * (r >> 2) + 4 * hi; }

__device__ __forceinline__ void partialSM(f32x16& p0, f32x16& p1, float& m_reg, float& mn, float& alpha) {
  constexpr float C = SM_SCALE * 1.4426950408889634f;
  float pmax = p0[0];
#pragma unroll
  for (int r = 1; r < 16; ++r) pmax = fmaxf(pmax, p0[r]);
#pragma unroll
  for (int r = 0; r < 16; ++r) pmax = fmaxf(pmax, p1[r]);
  { auto rr = __builtin_amdgcn_permlane32_swap(__float_as_uint(pmax), __float_as_uint(pmax), false, false);
    pmax = fmaxf(__uint_as_float(rr[0]), __uint_as_float(rr[1])); }
  if (__builtin_expect(__all(pmax - m_reg <= THR / SM_SCALE), 1)) { mn = m_reg; alpha = 1.f; }
  else { mn = fmaxf(m_reg, pmax); alpha = __builtin_amdgcn_exp2f((m_reg - mn) * C); m_reg = mn; }
  const float mnC = -mn * C;
  const f32x2 C2 = (f32x2){C, C}, M2 = (f32x2){mnC, mnC};
#pragma unroll
  for (int r = 0; r < 16; r += 2) { const f32x2 t = __builtin_elementwise_fma((f32x2){p0[r], p0[r + 1]}, C2, M2); p0[r] = t.x; p0[r + 1] = t.y; }
#pragma unroll
  for (int r = 0; r < 16; r += 2) { const f32x2 t = __builtin_elementwise_fma((f32x2){p1[r], p1[r + 1]}, C2, M2); p1[r] = t.x; p1[r + 1] = t.y; }
#pragma unroll
  for (int r = 0; r < 16; ++r) p0[r] = __builtin_amdgcn_exp2f(p0[r]);
}
__device__ __forceinline__ void finishSM(f32x16& p0, f32x16& p1, float alpha, float& l_reg, bf16x8& pa0, bf16x8& pa1, bf16x8& pa2, bf16x8& pa3) {
#pragma unroll
  for (int r = 0; r < 16; ++r) p1[r] = __builtin_amdgcn_exp2f(p1[r]);
  float ps = 0;
#pragma unroll
  for (int r = 0; r < 16; ++r) ps += p0[r];
#pragma unroll
  for (int r = 0; r < 16; ++r) ps += p1[r];
  { auto rr = __builtin_amdgcn_permlane32_swap(__float_as_uint(ps), __float_as_uint(ps), false, false);
    ps = __uint_as_float(rr[0]) + __uint_as_float(rr[1]); }
  l_reg = l_reg * alpha + ps;
#define PK4(P, BASE, OUT) do { unsigned a0 = cvt_pk_bf16(P[BASE + 0], P[BASE + 1]), a1 = cvt_pk_bf16(P[BASE + 2], P[BASE + 3]);   \
    unsigned b0 = cvt_pk_bf16(P[BASE + 4], P[BASE + 5]), b1 = cvt_pk_bf16(P[BASE + 6], P[BASE + 7]);                              \
    auto r0 = __builtin_amdgcn_permlane32_swap(a0, b0, false, false); auto r1 = __builtin_amdgcn_permlane32_swap(a1, b1, false, false); \
    u32x4 w = {r0[0], r1[0], r0[1], r1[1]}; OUT = __builtin_bit_cast(bf16x8, w); } while (0)
  PK4(p0, 0, pa0); PK4(p0, 8, pa1); PK4(p1, 0, pa2); PK4(p1, 8, pa3);
#undef PK4
}
__device__ __forceinline__ void qkt(f32x16& p0, f32x16& p1, const LAS unsigned char* Ks, const bf16x8* qr, int r32, int hi) {
  p0 = f32x16{}; p1 = f32x16{};
#pragma unroll
  for (int d0 = 0; d0 < 8; ++d0) { const int cb = (d0 * 16 + hi * 8) * 2;
    const bf16x8 b0 = *(const LAS bf16x8*)(Ks + KSWZ(r32, cb));
    const bf16x8 b1 = *(const LAS bf16x8*)(Ks + KSWZ(32 + r32, cb));
    p0 = __builtin_amdgcn_mfma_f32_32x32x16_bf16(b0, qr[d0], p0, 0, 0, 0);
    p1 = __builtin_amdgcn_mfma_f32_32x32x16_bf16(b1, qr[d0], p1, 0, 0, 0); }
}
typedef int v8i_t __attribute__((ext_vector_type(8)));
typedef int v4i_t __attribute__((ext_vector_type(4)));
#define K8SWZ(row, cb) ((row) * 128 + (((((cb) >> 4) ^ (((row) >> 1) & 7))) << 4) + ((cb) & 15))
__device__ __forceinline__ void qkt8(f32x16& p0, f32x16& p1, const LAS unsigned char* Ks, const v8i_t* qr8, int r32, int hi) {
  p0 = f32x16{}; p1 = f32x16{};
#pragma unroll
  for (int s = 0; s < 2; ++s) { const int cb = 64 * s + 32 * hi;
    const v8i_t a0 = __builtin_shufflevector(*(const LAS v4i_t*)(Ks + K8SWZ(r32, cb)), *(const LAS v4i_t*)(Ks + K8SWZ(r32, cb + 16)), 0, 1, 2, 3, 4, 5, 6, 7);
    const v8i_t a1 = __builtin_shufflevector(*(const LAS v4i_t*)(Ks + K8SWZ(32 + r32, cb)), *(const LAS v4i_t*)(Ks + K8SWZ(32 + r32, cb + 16)), 0, 1, 2, 3, 4, 5, 6, 7);
    p0 = __builtin_amdgcn_mfma_scale_f32_32x32x64_f8f6f4(a0, qr8[s], p0, 0, 0, 0, 0, 0, 0);
    p1 = __builtin_amdgcn_mfma_scale_f32_32x32x64_f8f6f4(a1, qr8[s], p1, 0, 0, 0, 0, 0, 0); }
}
__device__ __forceinline__ int v_st(int k, int c) { const int kk = (k & ~0xC) | ((k & 4) << 1) | ((k & 8) >> 1); return ((kk >> 3) * 4 + (c >> 5)) * 512 + ((kk & 7) * 32 + (c & 31)) * 2; }
__device__ __forceinline__ int v_rd_base(int lane) { return ((lane & 3) << 3) | (((lane >> 2) & 3) << 6) | (((lane >> 4) & 1) << 5) | (((lane >> 5) & 1) << 8); }
constexpr int v_rd_off(int d0, int ks, int half) { return d0 * 512 + ks * 4096 + half * 2048; }
template <int OFF> __device__ __forceinline__ s16x4 tr_read(int vb) {
  s16x4 r; asm volatile("ds_read_b64_tr_b16 %0, %1 offset:%2" : "=&v"(r) : "v"(vb), "i"(OFF) : "memory"); return r;
}
template <int D0> __device__ __forceinline__ void pv_one(f32x16& od, int vb, bf16x8 pa0, bf16x8 pa1, bf16x8 pa2, bf16x8 pa3) {
  const s16x4 l0 = tr_read<v_rd_off(D0, 0, 0)>(vb), h0 = tr_read<v_rd_off(D0, 0, 1)>(vb), l1 = tr_read<v_rd_off(D0, 1, 0)>(vb), h1 = tr_read<v_rd_off(D0, 1, 1)>(vb);
  const s16x4 l2 = tr_read<v_rd_off(D0, 2, 0)>(vb), h2 = tr_read<v_rd_off(D0, 2, 1)>(vb), l3 = tr_read<v_rd_off(D0, 3, 0)>(vb), h3 = tr_read<v_rd_off(D0, 3, 1)>(vb);
  asm volatile("s_waitcnt lgkmcnt(0)" ::: "memory"); SBAR();
#define PK(L, H) (bf16x8){L[0], L[1], L[2], L[3], H[0], H[1], H[2], H[3]}
  od = __builtin_amdgcn_mfma_f32_32x32x16_bf16(pa0, PK(l0, h0), od, 0, 0, 0);
  od = __builtin_amdgcn_mfma_f32_32x32x16_bf16(pa1, PK(l1, h1), od, 0, 0, 0);
  od = __builtin_amdgcn_mfma_f32_32x32x16_bf16(pa2, PK(l2, h2), od, 0, 0, 0);
  od = __builtin_amdgcn_mfma_f32_32x32x16_bf16(pa3, PK(l3, h3), od, 0, 0, 0);
#undef PK
}
__device__ __forceinline__ void pv_d0(f32x16* o, int vb, bf16x8 pa0, bf16x8 pa1, bf16x8 pa2, bf16x8 pa3) {
  pv_one<0>(o[0], vb, pa0, pa1, pa2, pa3); pv_one<1>(o[1], vb, pa0, pa1, pa2, pa3); pv_one<2>(o[2], vb, pa0, pa1, pa2, pa3); pv_one<3>(o[3], vb, pa0, pa1, pa2, pa3);
}


__device__ __forceinline__ void finishSM8(f32x16& p0, f32x16& p1, float alpha, float& l_reg, v8i_t& pa) {
#pragma unroll
  for (int r = 0; r < 16; ++r) p1[r] = __builtin_amdgcn_exp2f(p1[r]);
  f32x2 ps2 = (f32x2){0.f, 0.f};
#pragma unroll
  for (int r = 0; r < 16; r += 2) ps2 += (f32x2){p0[r], p0[r + 1]} + (f32x2){p1[r], p1[r + 1]};
  float ps = ps2.x + ps2.y;
  { auto rr = __builtin_amdgcn_permlane32_swap(__float_as_uint(ps), __float_as_uint(ps), false, false);
    ps = __uint_as_float(rr[0]) + __uint_as_float(rr[1]); }
  l_reg = l_reg * alpha + ps;
  pa = (v8i_t){(int)cvt4_fp8(p0[0], p0[1], p0[2], p0[3]), (int)cvt4_fp8(p0[4], p0[5], p0[6], p0[7]), (int)cvt4_fp8(p0[8], p0[9], p0[10], p0[11]), (int)cvt4_fp8(p0[12], p0[13], p0[14], p0[15]),
               (int)cvt4_fp8(p1[0], p1[1], p1[2], p1[3]), (int)cvt4_fp8(p1[4], p1[5], p1[6], p1[7]), (int)cvt4_fp8(p1[8], p1[9], p1[10], p1[11]), (int)cvt4_fp8(p1[12], p1[13], p1[14], p1[15])};
}
template <int ND = 4>
__device__ __forceinline__ void pv8(f32x16* o, const LAS unsigned char* vlo, const LAS unsigned char* vhi, v8i_t pa) {
#pragma unroll
  for (int d0 = 0; d0 < ND; ++d0) {
    const v8i_t vb = __builtin_shufflevector(*(const LAS v4i_t*)(vlo + d0 * 2048), *(const LAS v4i_t*)(vhi + d0 * 2048), 0, 1, 2, 3, 4, 5, 6, 7);
    o[d0] = __builtin_amdgcn_mfma_scale_f32_32x32x64_f8f6f4(pa, vb, o[d0], 0, 0, 0, 0, 0, 0); }
}

struct UnitP {
  const unsigned char* Qn; const unsigned char* Qr; int ldqn, ldqr;
  const unsigned char* K; const unsigned char* V;
  int ctx_row0, loc_row0, nloc, NT;
  bf16_t* O; int ldo; int o8;
  float sink; int has_sink;
  int qpos0, kpos0;
  int R, rlo;
  int rot; const float* CS;
};
template <int MODE>
__device__ __forceinline__ void attn_unit(const UnitP& U, LAS unsigned char* lds, const int wid) {
  const int lane = lane_id(), tid = wid * 64 + lane, r32 = lane & 31, hi = lane >> 5;
  LAS unsigned char* V_lds = lds + OFF_V; LAS unsigned char* K_lds = lds + OFF_K;
  LAS float* wsf = (LAS float*)(lds + OFF_WS) + wid * 64; LAS float* li_l = wsf; LAS float* al_l = wsf + 32;
  const LAS float* bt = (const LAS float*)(lds + OFF_BT);
  float m_reg = -1e30f, l_reg = 0; f32x16 o[4] = {}; v8i_t qr8[2];
#define QLOAD(Qp, ldq) do { const unsigned char* Qw_ = (Qp) + (size_t)(wid * 32 + r32) * (ldq) + hi * 32; \
    _Pragma("unroll") for (int s_ = 0; s_ < 2; ++s_) qr8[s_] = __builtin_shufflevector(*(const v4i_t*)(Qw_ + s_ * 64), *(const v4i_t*)(Qw_ + s_ * 64 + 16), 0, 1, 2, 3, 4, 5, 6, 7); } while (0)
  QLOAD(U.Qn, U.ldqn);
  const int sr = tid >> 4, sc = (tid & 15) * 8;
  const int cgq = tid >> 4, kg = tid & 15;
  const int vwr = (4 * cgq) * 64 + ((((2 * (kg & 1) + (kg >> 3)) ^ (cgq & 3))) << 4) + ((kg & 7) >> 1) * 4;
  const int vsw = (r32 >> 2) & 3;
  const LAS unsigned char* vlo0 = V_lds + r32 * 64 + (((2 * hi) ^ vsw) << 4); const LAS unsigned char* vhi0 = V_lds + r32 * 64 + (((2 * hi + 1) ^ vsw) << 4);
  const unsigned char* Kh = U.K; const unsigned char* Vh = U.V;
  constexpr int SD = 2;
  u32x4 vsa, vsb; u32x2 ks0a, ks1a, ks0b, ks1b;
#define TROW(j) ((j) < 4 ? U.ctx_row0 + 64 * (j) : U.loc_row0 + 64 * (((j) - 4) < U.nloc ? ((j) - 4) : U.nloc - 1))
#define SLOAD_A(j) do { const size_t v_ = (size_t)(TROW(j) + 4 * kg) * LDV8 + 4 * cgq; vsa.x = *(const unsigned*)(Vh + v_); vsa.y = *(const unsigned*)(Vh + v_ + LDV8); vsa.z = *(const unsigned*)(Vh + v_ + 2 * LDV8); vsa.w = *(const unsigned*)(Vh + v_ + 3 * LDV8); const size_t k_ = (size_t)(TROW(j) + sr) * LDK8 + sc; ks0a = *(const u32x2*)(Kh + k_); ks1a = *(const u32x2*)(Kh + k_ + (size_t)32 * LDK8); } while (0)
#define SLOAD_B(j) do { const size_t v_ = (size_t)(TROW(j) + 4 * kg) * LDV8 + 4 * cgq; vsb.x = *(const unsigned*)(Vh + v_); vsb.y = *(const unsigned*)(Vh + v_ + LDV8); vsb.z = *(const unsigned*)(Vh + v_ + 2 * LDV8); vsb.w = *(const unsigned*)(Vh + v_ + 3 * LDV8); const size_t k_ = (size_t)(TROW(j) + sr) * LDK8 + sc; ks0b = *(const u32x2*)(Kh + k_); ks1b = *(const u32x2*)(Kh + k_ + (size_t)32 * LDK8); } while (0)
#define SWRITE_A(b) do { { const unsigned t0_ = __builtin_amdgcn_perm(vsa.y, vsa.x, 0x05010400u), t1_ = __builtin_amdgcn_perm(vsa.y, vsa.x, 0x07030602u), t2_ = __builtin_amdgcn_perm(vsa.w, vsa.z, 0x05010400u), t3_ = __builtin_amdgcn_perm(vsa.w, vsa.z, 0x07030602u); \
      LAS unsigned char* vp_ = V_lds + (b) * SHM_V + vwr; *(LAS unsigned*)(vp_) = __builtin_amdgcn_perm(t2_, t0_, 0x05040100u); *(LAS unsigned*)(vp_ + 64) = __builtin_amdgcn_perm(t2_, t0_, 0x07060302u); \
      *(LAS unsigned*)(vp_ + 128) = __builtin_amdgcn_perm(t3_, t1_, 0x05040100u); *(LAS unsigned*)(vp_ + 192) = __builtin_amdgcn_perm(t3_, t1_, 0x07060302u); } \
    *(LAS u32x2*)(K_lds + (b) * SHM_K + K8SWZ(sr, sc)) = ks0a; *(LAS u32x2*)(K_lds + (b) * SHM_K + K8SWZ(32 + sr, sc)) = ks1a; } while (0)
#define SWRITE_B(b) do { { const unsigned t0_ = __builtin_amdgcn_perm(vsb.y, vsb.x, 0x05010400u), t1_ = __builtin_amdgcn_perm(vsb.y, vsb.x, 0x07030602u), t2_ = __builtin_amdgcn_perm(vsb.w, vsb.z, 0x05010400u), t3_ = __builtin_amdgcn_perm(vsb.w, vsb.z, 0x07030602u); \
      LAS unsigned char* vp_ = V_lds + (b) * SHM_V + vwr; *(LAS unsigned*)(vp_) = __builtin_amdgcn_perm(t2_, t0_, 0x05040100u); *(LAS unsigned*)(vp_ + 64) = __builtin_amdgcn_perm(t2_, t0_, 0x07060302u); \
      *(LAS unsigned*)(vp_ + 128) = __builtin_amdgcn_perm(t3_, t1_, 0x05040100u); *(LAS unsigned*)(vp_ + 192) = __builtin_amdgcn_perm(t3_, t1_, 0x07060302u); } \
    *(LAS u32x2*)(K_lds + (b) * SHM_K + K8SWZ(sr, sc)) = ks0b; *(LAS u32x2*)(K_lds + (b) * SHM_K + K8SWZ(32 + sr, sc)) = ks1b; } while (0)
#define SLOAD_E(j) SLOAD_A(j)
#define SWRITE_E(b) SWRITE_A(b)
#define SLOAD_O(j) do { if constexpr (SD == 2) SLOAD_B(j); else SLOAD_A(j); } while (0)
#define SWRITE_O(b) do { if constexpr (SD == 2) SWRITE_B(b); else SWRITE_A(b); } while (0)
#define SWAIT() do { if constexpr (SD == 2) asm volatile("s_waitcnt vmcnt(6)" ::: "memory"); else asm volatile("s_waitcnt vmcnt(0)" ::: "memory"); } while (0)
#define RESC(a) do { if (__any((a) < 1.f)) { if (hi == 0) al_l[r32] = (a); asm volatile("s_waitcnt lgkmcnt(0)" ::: "memory"); \
    _Pragma("unroll") for (int d = 0; d < 4; ++d) _Pragma("unroll") for (int r = 0; r < 16; ++r) o[d][r] *= al_l[crow(r, hi)]; } } while (0)
  const int qrow_l = wid * 32 + r32;
  unsigned boff[8];
  if constexpr (MODE == 1) { const int cq = 32 * (wid & 1) + r32; int c0 = cq - 8; c0 = c0 < 0 ? 0 : (c0 > 48 ? 48 : c0);
#pragma unroll
    for (int g = 0; g < 8; ++g) { unsigned w = 0;
#pragma unroll
      for (int q = 0; q < 4; ++q) { const int r = (g & 3) * 4 + q; const int kc = 4 * hi + (r & 3) + 8 * (r >> 2) + 32 * (g >> 2);
        const unsigned byte = ((unsigned)(kc - c0) < 16u) ? (unsigned)(kc - cq + 15) : 31u; w |= byte << (8 * q); }
      boff[g] = w; } }
#define MASK(P0, P1, j) do { if ((j) >= 4) { const int jl_ = (j) - 4; \
    if constexpr (MODE == 0) { const int d0_ = U.kpos0 + 64 * jl_ + 4 * hi - (U.qpos0 + qrow_l); const int dw_ = U.kpos0 + 64 * jl_ - (U.qpos0 + wid * 32); \
      if (dw_ - 31 < -128 || dw_ + 63 > 128) _Pragma("unroll") for (int r = 0; r < 16; ++r) { const int d_ = d0_ + (r & 3) + 8 * (r >> 2); \
        if (d_ < -128 || d_ > 128) P0[r] = NEGM; if (d_ + 32 < -128 || d_ + 32 > 128) P1[r] = NEGM; } } \
    if constexpr (MODE == 1) { const int kr_ = U.rlo + jl_; const int rq_ = U.R + (wid >> 1); \
      int r0_ = rq_ - 4; r0_ = r0_ < 0 ? 0 : (r0_ > 24 ? 24 : r0_); \
      const bool rowok_ = (jl_ < U.nloc) && kr_ >= r0_ && kr_ <= r0_ + 7; \
      const LAS unsigned char* tb_ = (const LAS unsigned char*)bt + (rowok_ ? (kr_ - rq_ + 7) : 15) * 128; \
      _Pragma("unroll") for (int g = 0; g < 4; ++g) { SBAR(); \
        _Pragma("unroll") for (int q = 0; q < 4; ++q) { const int r = 4 * g + q; \
          const unsigned o0_ = __builtin_amdgcn_ubfe(boff[g], 8 * q, 8), o1_ = __builtin_amdgcn_ubfe(boff[4 + g], 8 * q, 8); \
          P0[r] += *(const LAS float*)(tb_ + o0_ * 4); P1[r] += *(const LAS float*)(tb_ + o1_ * 4); } \
        asm volatile("s_waitcnt lgkmcnt(0)" ::: "memory"); SBAR(); } } } } while (0)
#define QSWITCH(j) do { if ((j) == 4 && U.rot) { const float* cs_ = U.CS + ((size_t)(U.qpos0 + wid * 32 + r32) * 64 + 16 * hi) * 2; \
    _Pragma("unroll") for (int s_ = 0; s_ < 2; ++s_) _Pragma("unroll") for (int d_ = 0; d_ < 8; ++d_) { const f32x4 c4_ = *(const f32x4*)(cs_ + (32 * s_ + 2 * d_) * 2);   \
      const int w_ = qr8[s_][d_]; const f32x2 a_ = __builtin_amdgcn_cvt_pk_f32_fp8(w_, false), b_ = __builtin_amdgcn_cvt_pk_f32_fp8(w_, true); \
      int o_ = __builtin_amdgcn_cvt_pk_fp8_f32(a_.x * c4_[0] - a_.y * c4_[1], a_.x * c4_[1] + a_.y * c4_[0], 0, false); \
      o_ = __builtin_amdgcn_cvt_pk_fp8_f32(b_.x * c4_[2] - b_.y * c4_[3], b_.x * c4_[3] + b_.y * c4_[2], o_, true); qr8[s_][d_] = o_; } } } while (0)
  f32x16 pA0, pA1, pB0, pB1; float mnA, mnB, alA, alB; v8i_t pa; const int NT = U.NT;
  SLOAD_E(0); asm volatile("s_waitcnt vmcnt(0)" ::: "memory"); SWRITE_E(0); __syncthreads();
  qkt8(pA0, pA1, K_lds, qr8, r32, hi); partialSM(pA0, pA1, m_reg, mnA, alA);
  SLOAD_O(1); if constexpr (SD == 2) { if (2 < NT) SLOAD_E(2); }
  SWAIT(); SWRITE_O(1); __syncthreads();
  for (int j = 1; j + 1 < NT; j += 2) {
    QSWITCH(j);
    SBAR(); qkt8(pB0, pB1, K_lds + SHM_K, qr8, r32, hi); MASK(pB0, pB1, j);
    finishSM8(pA0, pA1, alA, l_reg, pa); SBAR();
    if constexpr (SD == 2) SLOAD_O(j + 2); else SLOAD_E(j + 1);
    SBAR();
    pv8(o, vlo0, vhi0, pa); partialSM(pB0, pB1, m_reg, mnB, alB);
    __syncthreads(); SWAIT(); SWRITE_E(0);
    RESC(alB); __syncthreads();
    QSWITCH(j + 1);
    SBAR(); qkt8(pA0, pA1, K_lds, qr8, r32, hi); MASK(pA0, pA1, j + 1);
    finishSM8(pB0, pB1, alB, l_reg, pa); SBAR();
    if constexpr (SD == 2) { if (j + 3 < NT) SLOAD_E(j + 3); } else SLOAD_O(j + 2);
    SBAR();
    pv8(o, vlo0 + SHM_V, vhi0 + SHM_V, pa); partialSM(pA0, pA1, m_reg, mnA, alA);
    __syncthreads(); SWAIT(); SWRITE_O(1);
    RESC(alA); __syncthreads();
  }
  QSWITCH(NT - 1);
  SBAR(); qkt8(pB0, pB1, K_lds + SHM_K, qr8, r32, hi); MASK(pB0, pB1, NT - 1);
  finishSM8(pA0, pA1, alA, l_reg, pa); SBAR();
  pv8(o, vlo0, vhi0, pa); partialSM(pB0, pB1, m_reg, mnB, alB);
  __syncthreads(); RESC(alB);
  finishSM8(pB0, pB1, alB, l_reg, pa); SBAR();
  pv8(o, vlo0 + SHM_V, vhi0 + SHM_V, pa);
  if (U.has_sink) l_reg += __builtin_amdgcn_exp2f(U.sink * 1.4426950408889634f - m_reg * (SM_SCALE * 1.4426950408889634f));
  if (hi == 0) li_l[r32] = l_reg; asm volatile("s_waitcnt lgkmcnt(0)" ::: "memory");
  if (U.o8) {
    LAS unsigned char* st = K_lds + wid * 4096;
#pragma unroll
    for (int r = 0; r < 16; ++r) {
      const float rl = __builtin_amdgcn_rcpf(li_l[crow(r, hi)]) * OSCALE; const int orow = crow(r, hi);
#pragma unroll
      for (int d0 = 0; d0 < 4; ++d0) { const float x = o[d0][r] * rl; st[orow * 128 + d0 * 32 + r32] = (unsigned char)__builtin_amdgcn_cvt_pk_fp8_f32(x, x, 0, false); }
    }
    asm volatile("s_waitcnt lgkmcnt(0)" ::: "memory");
    unsigned char* Ob8 = (unsigned char*)U.O; int ld8 = U.ldo; asm volatile("" : "+s"(Ob8), "+s"(ld8));
#pragma unroll
    for (int i4 = 0; i4 < 4; ++i4) { const int chunk = i4 * 64 + lane; const int row = chunk >> 3, cb = chunk & 7;
      *(GAS u32x4*)((GAS unsigned char*)Ob8 + (size_t)(wid * 32 + row) * ld8 + cb * 16) = *(const LAS u32x4*)(st + chunk * 16); }
  } else {
  bf16_t* Ob_ = U.O; int ldo_ = U.ldo; asm volatile("" : "+s"(Ob_), "+s"(ldo_));
  bf16_t* Ow = Ob_ + (size_t)(wid * 32) * ldo_;
  const bool odd = (lane & 1) != 0;
#pragma unroll
  for (int r = 0; r < 16; r += 2) {
    const float rl0 = __builtin_amdgcn_rcpf(li_l[crow(r, hi)]), rl1 = __builtin_amdgcn_rcpf(li_l[crow(r + 1, hi)]);
    const int orow = crow(odd ? r + 1 : r, hi);
#pragma unroll
    for (int d0 = 0; d0 < 4; ++d0) {
      const float x0 = o[d0][r] * rl0, x1 = o[d0][r + 1] * rl1;
      const float mine = odd ? x1 : x0, give = odd ? x0 : x1;
      const float got = __shfl_xor(give, 1);
      const unsigned w = cvt_pk_bf16(odd ? got : mine, odd ? mine : got);
      *(GAS unsigned*)((GAS bf16_t*)Ow + (size_t)orow * ldo_ + d0 * 32 + (r32 & ~1)) = w;
    }
  }
  }
  __syncthreads();
#undef TROW
#undef SLOAD_A
#undef SLOAD_B
#undef SWRITE_A
#undef SWRITE_B
#undef SWAIT
#undef SLOAD_E
#undef SLOAD_O
#undef SWRITE_E
#undef SWRITE_O
#undef RESC
#undef MASK
#undef QSWITCH
#undef QLOAD
}
template <int MODE, int NV = 1>
__device__ __forceinline__ void attn_unit_simple(const UnitP& U, LAS unsigned char* lds, const int wid) {
  const int lane = lane_id(), tid = wid * 64 + lane, r32 = lane & 31, hi = lane >> 5;
  LAS unsigned char* V_lds = lds + OFF_V; LAS unsigned char* K_lds = lds + OFF_K;
  LAS float* wsf = (LAS float*)(lds + OFF_WS) + wid * 64; LAS float* li_l = wsf; LAS float* al_l = wsf + 32;
  const LAS float* bt = (const LAS float*)(lds + OFF_BT);
  float m_reg = -1e30f, l_reg = 0; f32x16 o[4 * NV] = {}; v8i_t qr8[2];
#define QLOAD(Qp, ldq) do { const unsigned char* Qw_ = (Qp) + (size_t)(wid * 32 + r32) * (ldq) + hi * 32; \
    _Pragma("unroll") for (int s_ = 0; s_ < 2; ++s_) qr8[s_] = __builtin_shufflevector(*(const v4i_t*)(Qw_ + s_ * 64), *(const v4i_t*)(Qw_ + s_ * 64 + 16), 0, 1, 2, 3, 4, 5, 6, 7); } while (0)
  QLOAD(U.Qn, U.ldqn);
  const int sr = tid >> 4, sc = (tid & 15) * 8;
  const int cgq = tid >> 4, kg = tid & 15;
  const int vwr = (4 * cgq) * 64 + ((((2 * (kg & 1) + (kg >> 3)) ^ (cgq & 3))) << 4) + ((kg & 7) >> 1) * 4;
  const int vsw = (r32 >> 2) & 3;
  const LAS unsigned char* vlo0 = V_lds + r32 * 64 + (((2 * hi) ^ vsw) << 4); const LAS unsigned char* vhi0 = V_lds + r32 * 64 + (((2 * hi + 1) ^ vsw) << 4);
  const unsigned char* Kh = U.K; const unsigned char* Vh = U.V;
  constexpr int SD = 1;
  u32x4 vsa, vsb, vsa2; u32x2 ks0a, ks1a, ks0b, ks1b;
#define TROW(j) ((j) < 4 ? U.ctx_row0 + 64 * (j) : U.loc_row0 + 64 * (((j) - 4) < U.nloc ? ((j) - 4) : U.nloc - 1))
#define SLOAD_A(j) do { const size_t v_ = (size_t)(TROW(j) + 4 * kg) * LDV8 + 4 * cgq; vsa.x = *(const unsigned*)(Vh + v_); vsa.y = *(const unsigned*)(Vh + v_ + LDV8); vsa.z = *(const unsigned*)(Vh + v_ + 2 * LDV8); vsa.w = *(const unsigned*)(Vh + v_ + 3 * LDV8); if constexpr (NV == 2) { vsa2.x = *(const unsigned*)(Vh + v_ + 128); vsa2.y = *(const unsigned*)(Vh + v_ + LDV8 + 128); vsa2.z = *(const unsigned*)(Vh + v_ + 2 * LDV8 + 128); vsa2.w = *(const unsigned*)(Vh + v_ + 3 * LDV8 + 128); } const size_t k_ = (size_t)(TROW(j) + sr) * LDK8 + sc; ks0a = *(const u32x2*)(Kh + k_); ks1a = *(const u32x2*)(Kh + k_ + (size_t)32 * LDK8); } while (0)
#define SLOAD_B(j) do { const size_t v_ = (size_t)(TROW(j) + 4 * kg) * LDV8 + 4 * cgq; vsb.x = *(const unsigned*)(Vh + v_); vsb.y = *(const unsigned*)(Vh + v_ + LDV8); vsb.z = *(const unsigned*)(Vh + v_ + 2 * LDV8); vsb.w = *(const unsigned*)(Vh + v_ + 3 * LDV8); const size_t k_ = (size_t)(TROW(j) + sr) * LDK8 + sc; ks0b = *(const u32x2*)(Kh + k_); ks1b = *(const u32x2*)(Kh + k_ + (size_t)32 * LDK8); } while (0)
#define SWRITE_A(b) do { { const unsigned t0_ = __builtin_amdgcn_perm(vsa.y, vsa.x, 0x05010400u), t1_ = __builtin_amdgcn_perm(vsa.y, vsa.x, 0x07030602u), t2_ = __builtin_amdgcn_perm(vsa.w, vsa.z, 0x05010400u), t3_ = __builtin_amdgcn_perm(vsa.w, vsa.z, 0x07030602u); \
      LAS unsigned char* vp_ = V_lds + (b) * SHM_V + vwr; *(LAS unsigned*)(vp_) = __builtin_amdgcn_perm(t2_, t0_, 0x05040100u); *(LAS unsigned*)(vp_ + 64) = __builtin_amdgcn_perm(t2_, t0_, 0x07060302u); \
      *(LAS unsigned*)(vp_ + 128) = __builtin_amdgcn_perm(t3_, t1_, 0x05040100u); *(LAS unsigned*)(vp_ + 192) = __builtin_amdgcn_perm(t3_, t1_, 0x07060302u); } \
    if constexpr (NV == 2) { const unsigned t0_ = __builtin_amdgcn_perm(vsa2.y, vsa2.x, 0x05010400u), t1_ = __builtin_amdgcn_perm(vsa2.y, vsa2.x, 0x07030602u), t2_ = __builtin_amdgcn_perm(vsa2.w, vsa2.z, 0x05010400u), t3_ = __builtin_amdgcn_perm(vsa2.w, vsa2.z, 0x07030602u); \
      LAS unsigned char* vp_ = V_lds + (b) * SHM_V + vwr + 8192; *(LAS unsigned*)(vp_) = __builtin_amdgcn_perm(t2_, t0_, 0x05040100u); *(LAS unsigned*)(vp_ + 64) = __builtin_amdgcn_perm(t2_, t0_, 0x07060302u); \
      *(LAS unsigned*)(vp_ + 128) = __builtin_amdgcn_perm(t3_, t1_, 0x05040100u); *(LAS unsigned*)(vp_ + 192) = __builtin_amdgcn_perm(t3_, t1_, 0x07060302u); } \
    *(LAS u32x2*)(K_lds + (b) * SHM_K + K8SWZ(sr, sc)) = ks0a; *(LAS u32x2*)(K_lds + (b) * SHM_K + K8SWZ(32 + sr, sc)) = ks1a; } while (0)
#define SWRITE_B(b) do { { const unsigned t0_ = __builtin_amdgcn_perm(vsb.y, vsb.x, 0x05010400u), t1_ = __builtin_amdgcn_perm(vsb.y, vsb.x, 0x07030602u), t2_ = __builtin_amdgcn_perm(vsb.w, vsb.z, 0x05010400u), t3_ = __builtin_amdgcn_perm(vsb.w, vsb.z, 0x07030602u); \
      LAS unsigned char* vp_ = V_lds + (b) * SHM_V + vwr; *(LAS unsigned*)(vp_) = __builtin_amdgcn_perm(t2_, t0_, 0x05040100u); *(LAS unsigned*)(vp_ + 64) = __builtin_amdgcn_perm(t2_, t0_, 0x07060302u); \
      *(LAS unsigned*)(vp_ + 128) = __builtin_amdgcn_perm(t3_, t1_, 0x05040100u); *(LAS unsigned*)(vp_ + 192) = __builtin_amdgcn_perm(t3_, t1_, 0x07060302u); } \
    *(LAS u32x2*)(K_lds + (b) * SHM_K + K8SWZ(sr, sc)) = ks0b; *(LAS u32x2*)(K_lds + (b) * SHM_K + K8SWZ(32 + sr, sc)) = ks1b; } while (0)
#define SLOAD_E(j) SLOAD_A(j)
#define SWRITE_E(b) SWRITE_A(b)
#define SLOAD_O(j) do { if constexpr (SD == 2) SLOAD_B(j); else SLOAD_A(j); } while (0)
#define SWRITE_O(b) do { if constexpr (SD == 2) SWRITE_B(b); else SWRITE_A(b); } while (0)
#define SWAIT() do { if constexpr (SD == 2) asm volatile("s_waitcnt vmcnt(6)" ::: "memory"); else asm volatile("s_waitcnt vmcnt(0)" ::: "memory"); } while (0)
#define RESC(a) do { if (__any((a) < 1.f)) { if (hi == 0) al_l[r32] = (a); asm volatile("s_waitcnt lgkmcnt(0)" ::: "memory"); \
    _Pragma("unroll") for (int d = 0; d < 4 * NV; ++d) _Pragma("unroll") for (int r = 0; r < 16; ++r) o[d][r] *= al_l[crow(r, hi)]; } } while (0)
  const int qrow_l = wid * 32 + r32;
  unsigned boff[8];
  if constexpr (MODE == 1) { const int cq = 32 * (wid & 1) + r32; int c0 = cq - 8; c0 = c0 < 0 ? 0 : (c0 > 48 ? 48 : c0);
#pragma unroll
    for (int g = 0; g < 8; ++g) { unsigned w = 0;
#pragma unroll
      for (int q = 0; q < 4; ++q) { const int r = (g & 3) * 4 + q; const int kc = 4 * hi + (r & 3) + 8 * (r >> 2) + 32 * (g >> 2);
        const unsigned byte = ((unsigned)(kc - c0) < 16u) ? (unsigned)(kc - cq + 15) : 31u; w |= byte << (8 * q); }
      boff[g] = w; } }
#define MASK(P0, P1, j) do { if ((j) >= 4) { const int jl_ = (j) - 4; \
    if constexpr (MODE == 0) { const int d0_ = U.kpos0 + 64 * jl_ + 4 * hi - (U.qpos0 + qrow_l); const int dw_ = U.kpos0 + 64 * jl_ - (U.qpos0 + wid * 32); \
      if (dw_ - 31 < -128 || dw_ + 63 > 128) _Pragma("unroll") for (int r = 0; r < 16; ++r) { const int d_ = d0_ + (r & 3) + 8 * (r >> 2); \
        if (d_ < -128 || d_ > 128) P0[r] = NEGM; if (d_ + 32 < -128 || d_ + 32 > 128) P1[r] = NEGM; } } \
    if constexpr (MODE == 1) { const int kr_ = U.rlo + jl_; const int rq_ = U.R + (wid >> 1); \
      int r0_ = rq_ - 4; r0_ = r0_ < 0 ? 0 : (r0_ > 24 ? 24 : r0_); \
      const bool rowok_ = (jl_ < U.nloc) && kr_ >= r0_ && kr_ <= r0_ + 7; \
      const LAS unsigned char* tb_ = (const LAS unsigned char*)bt + (rowok_ ? (kr_ - rq_ + 7) : 15) * 128; \
      _Pragma("unroll") for (int g = 0; g < 4; ++g) { SBAR(); \
        _Pragma("unroll") for (int q = 0; q < 4; ++q) { const int r = 4 * g + q; \
          const unsigned o0_ = __builtin_amdgcn_ubfe(boff[g], 8 * q, 8), o1_ = __builtin_amdgcn_ubfe(boff[4 + g], 8 * q, 8); \
          P0[r] += *(const LAS float*)(tb_ + o0_ * 4); P1[r] += *(const LAS float*)(tb_ + o1_ * 4); } \
        asm volatile("s_waitcnt lgkmcnt(0)" ::: "memory"); SBAR(); } } } } while (0)
#define QSWITCH(j) do { if ((j) == 4 && U.rot) { const float* cs_ = U.CS + ((size_t)(U.qpos0 + wid * 32 + r32) * 64 + 16 * hi) * 2; \
    _Pragma("unroll") for (int s_ = 0; s_ < 2; ++s_) _Pragma("unroll") for (int d_ = 0; d_ < 8; ++d_) { const f32x4 c4_ = *(const f32x4*)(cs_ + (32 * s_ + 2 * d_) * 2);   \
      const int w_ = qr8[s_][d_]; const f32x2 a_ = __builtin_amdgcn_cvt_pk_f32_fp8(w_, false), b_ = __builtin_amdgcn_cvt_pk_f32_fp8(w_, true); \
      int o_ = __builtin_amdgcn_cvt_pk_fp8_f32(a_.x * c4_[0] - a_.y * c4_[1], a_.x * c4_[1] + a_.y * c4_[0], 0, false); \
      o_ = __builtin_amdgcn_cvt_pk_fp8_f32(b_.x * c4_[2] - b_.y * c4_[3], b_.x * c4_[3] + b_.y * c4_[2], o_, true); qr8[s_][d_] = o_; } } } while (0)
  f32x16 p0, p1; float mn, al; v8i_t pa; const int NT = U.NT;
  SLOAD_A(0);
  for (int j = 0; j < NT; ++j) {
    const int buf = j & 1;
    asm volatile("s_waitcnt vmcnt(0)" ::: "memory"); SWRITE_A(buf);
    if (j + 1 < NT) SLOAD_A(j + 1);
    __syncthreads();
    QSWITCH(j);
    bool live = true;
    if constexpr (MODE == 1) { if (j >= 4) { const int jl = j - 4, kr = U.rlo + jl, rq = U.R + (wid >> 1); int r0 = rq - 4; r0 = r0 < 0 ? 0 : (r0 > 24 ? 24 : r0); live = (jl < U.nloc) && kr >= r0 && kr <= r0 + 7; } }
    if (live) {
      qkt8(p0, p1, K_lds + buf * SHM_K, qr8, r32, hi); MASK(p0, p1, j);
      partialSM(p0, p1, m_reg, mn, al);
      finishSM8(p0, p1, al, l_reg, pa);
      RESC(al);
      pv8<4 * NV>(o, vlo0 + buf * SHM_V, vhi0 + buf * SHM_V, pa);
    }
  }
  if (U.has_sink) l_reg += __builtin_amdgcn_exp2f(U.sink * 1.4426950408889634f - m_reg * (SM_SCALE * 1.4426950408889634f));
  if (hi == 0) li_l[r32] = l_reg; asm volatile("s_waitcnt lgkmcnt(0)" ::: "memory");
  if (NV == 1 && U.o8) {
    __syncthreads();
    LAS unsigned char* st = K_lds + wid * 4096;
#pragma unroll
    for (int r = 0; r < 16; ++r) {
      const float rl = __builtin_amdgcn_rcpf(li_l[crow(r, hi)]) * OSCALE; const int orow = crow(r, hi);
#pragma unroll
      for (int d0 = 0; d0 < 4; ++d0) { const float x = o[d0 < 4 * NV ? d0 : 0][r] * rl; st[orow * 128 + d0 * 32 + r32] = (unsigned char)__builtin_amdgcn_cvt_pk_fp8_f32(x, x, 0, false); }
    }
    asm volatile("s_waitcnt lgkmcnt(0)" ::: "memory");
    unsigned char* Ob8 = (unsigned char*)U.O; int ld8 = U.ldo; asm volatile("" : "+s"(Ob8), "+s"(ld8));
#pragma unroll
    for (int i4 = 0; i4 < 4; ++i4) { const int chunk = i4 * 64 + lane; const int row = chunk >> 3, cb = chunk & 7;
      *(GAS u32x4*)((GAS unsigned char*)Ob8 + (size_t)(wid * 32 + row) * ld8 + cb * 16) = *(const LAS u32x4*)(st + chunk * 16); }
  } else {
  bf16_t* Ob_ = U.O; int ldo_ = U.ldo; asm volatile("" : "+s"(Ob_), "+s"(ldo_));
  bf16_t* Ow = Ob_ + (size_t)(wid * 32) * ldo_;
  const bool odd = (lane & 1) != 0;
#pragma unroll
  for (int r = 0; r < 16; r += 2) {
    const float rl0 = __builtin_amdgcn_rcpf(li_l[crow(r, hi)]), rl1 = __builtin_amdgcn_rcpf(li_l[crow(r + 1, hi)]);
    const int orow = crow(odd ? r + 1 : r, hi);
#pragma unroll
    for (int d0 = 0; d0 < 4 * NV; ++d0) {
      const float x0 = o[d0][r] * rl0, x1 = o[d0][r + 1] * rl1;
      const float mine = odd ? x1 : x0, give = odd ? x0 : x1;
      const float got = __shfl_xor(give, 1);
      const unsigned w = cvt_pk_bf16(odd ? got : mine, odd ? mine : got);
      *(GAS unsigned*)((GAS bf16_t*)Ow + (size_t)orow * ldo_ + d0 * 32 + (r32 & ~1)) = w;
    }
  }
  }
  __syncthreads();
#undef TROW
#undef SLOAD_A
#undef SLOAD_B
#undef SWRITE_A
#undef SWRITE_B
#undef SWAIT
#undef SLOAD_E
#undef SLOAD_O
#undef SWRITE_E
#undef SWRITE_O
#undef RESC
#undef MASK
#undef QSWITCH
#undef QLOAD
}
#undef KSWZ
#undef SBAR
}

__device__ __forceinline__ void phase_attn0(KArgs a, LAS unsigned char* lds, int tid, int wave, int G, int vcu) {
  const unsigned char* QKV = (const unsigned char*)(a->ws + WS_Q8); const unsigned char* QN = (const unsigned char*)(a->ws + WS_QN); unsigned char* O = (unsigned char*)(a->ws + WS_O);
  const unsigned char* K8 = (const unsigned char*)(a->ws + WS_K8); const unsigned char* V8 = (const unsigned char*)(a->ws + WS_V8);
  LAS float* bt = (LAS float*)(lds + att::OFF_BT); const float* CSt = (const float*)(a->ws + WS_CS);
  for (int i_ = 0, u = vcu; i_ * G < 1024; ++i_, u = i_ * G + ((vcu + 2 * i_) % G)) {
    if (u >= 1024) break;
    att::UnitP U; U.has_sink = 0; U.sink = 0.f; U.qpos0 = 0; U.kpos0 = 0; U.ldo = DM; U.o8 = 1; U.rot = 0; U.CS = CSt;
    const int qb = u & 7, h = (u >> 3) & 7, b = u >> 6; const int row0 = b * PB + CTXL + 256 * qb;
    { const int dr = tid >> 5, dc = tid & 31; bt[tid] = (dr < 15 && dc < 31) ? a->in[13][h * 465 + dr * 31 + dc] * (1.0f / SM_SCALE) : att::NEGM; }
    U.Qn = QKV + (size_t)row0 * NQKV + 1536 + h * HD; U.Qr = U.Qn; U.ldqn = NQKV; U.ldqr = NQKV;
    U.K = K8 + 256 + h * HD; U.V = V8 + 256 + h * HD;
    const int R = 4 * qb; int rlo = R - 4; rlo = rlo < 0 ? 0 : rlo; rlo = rlo > 24 ? 24 : rlo; int rh = R + 3 - 4; rh = rh < 0 ? 0 : (rh > 24 ? 24 : rh); const int rhi = rh + 7;
    U.R = R; U.rlo = rlo; U.nloc = rhi - rlo + 1; U.NT = 4 + ((U.nloc + 1) & ~1);
    U.ctx_row0 = b * PB; U.loc_row0 = b * PB + CTXL + 64 * rlo;
    U.O = (bf16_t*)(O + (size_t)row0 * DM + 1024 + h * HD);
    __syncthreads();
    att::attn_unit_simple<1>(U, lds, wave);
  }
  for (int i_ = 0, u = vcu; i_ * G < 1024; ++i_, u = i_ * G + ((vcu + 2 * i_) % G)) {
    if (u >= 1024) break;
    att::UnitP U; U.R = 0; U.rlo = 0; U.ldo = DM; U.o8 = 1; U.rot = 1; U.CS = CSt;
    const int qb = u & 7, h = (u >> 3) & 7, b = u >> 6; const int row0 = b * PB + CTXL + 256 * qb;
    U.Qn = QKV + (size_t)row0 * NQKV + h * HD; U.ldqn = NQKV; U.Qr = U.Qn; U.ldqr = NQKV;
    U.K = K8 + (h >> 2) * HD; U.V = V8 + (h >> 2) * HD;
    int tlo = 4 * qb - 2; tlo = tlo < 0 ? 0 : tlo; int thi = 4 * qb + 5; thi = thi > 31 ? 31 : thi;
    U.nloc = thi - tlo + 1; U.NT = 4 + U.nloc; U.qpos0 = 256 * qb; U.kpos0 = 64 * tlo;
    U.ctx_row0 = b * PB; U.loc_row0 = b * PB + CTXL + 64 * tlo;
    U.has_sink = 1; U.sink = a->in[12][h];
    U.O = (bf16_t*)(O + (size_t)row0 * DM + h * HD);
    att::attn_unit<0>(U, lds, wave);
  }
  for (int u = vcu; u < 256; u += G) {
    att::UnitP U; U.qpos0 = 0; U.kpos0 = 0; U.R = 0; U.rlo = 0; U.ldo = DM; U.o8 = 1; U.rot = 0; U.CS = CSt;
    const int hh = u & 15, b = u >> 4; const int row0 = b * PB; const bool fa = hh < 8; const int h = hh & 7;
    U.Qn = QKV + (size_t)row0 * NQKV + (fa ? h * HD : 1536 + h * HD); U.Qr = U.Qn; U.ldqn = NQKV; U.ldqr = NQKV;
    U.K = K8 + (fa ? (h >> 2) * HD : 256 + h * HD); U.V = V8 + (fa ? (h >> 2) * HD : 256 + h * HD);
    U.nloc = 1; U.NT = 4; U.ctx_row0 = b * PB; U.loc_row0 = b * PB;
    U.has_sink = fa ? 1 : 0; U.sink = fa ? a->in[12][h] : 0.f;
    U.O = (bf16_t*)(O + (size_t)row0 * DM + (fa ? h * HD : 1024 + h * HD));
    att::attn_unit<2>(U, lds, wave);
  }
}
__device__ __forceinline__ void phase_attn1(KArgs a, LAS unsigned char* lds, int tid, int wave, int G, int vcu) {
  const unsigned char* QKV = (const unsigned char*)(a->ws + WS_Q8); const unsigned char* QN = (const unsigned char*)(a->ws + WS_QN); unsigned char* O = (unsigned char*)(a->ws + WS_O); bf16_t* OD = (bf16_t*)(a->ws + WS_H);
  const unsigned char* K8 = (const unsigned char*)(a->ws + WS_K8); const unsigned char* V8 = (const unsigned char*)(a->ws + WS_V8); const float* CSt = (const float*)(a->ws + WS_CS);
  for (int u = vcu; u < 1024; u += G) {
    att::UnitP U; U.has_sink = 0; U.sink = 0.f; U.qpos0 = 0; U.kpos0 = 0; U.R = 0; U.rlo = 0; U.nloc = 32; U.NT = 36; U.rot = 1; U.CS = CSt;
    const int qb = u & 7, h = (u >> 3) & 7, b = u >> 6; const int row0 = b * PB + CTXL + 256 * qb;
    U.Qn = QKV + (size_t)row0 * NQKV + h * HD; U.ldqn = NQKV; U.Qr = U.Qn; U.ldqr = NQKV; U.qpos0 = 256 * qb;
    U.K = K8 + (h >> 2) * HD; U.V = V8 + (h >> 2) * HD;
    U.ctx_row0 = b * PB; U.loc_row0 = b * PB + CTXL;
    U.O = (bf16_t*)(O + (size_t)row0 * DM + h * HD); U.ldo = DM; U.o8 = 1;
    att::attn_unit<2>(U, lds, wave);
  }
  for (int u = vcu; u < 1024; u += G) {
    att::UnitP U; U.has_sink = 0; U.sink = 0.f; U.qpos0 = 0; U.kpos0 = 0; U.R = 0; U.rlo = 0; U.nloc = 32; U.NT = 36; U.rot = 1; U.CS = CSt;
    const int qb = u & 7, hd = (u >> 3) & 7, b = u >> 6; const int row0 = b * PB + CTXL + 256 * qb;
    U.Qn = QKV + (size_t)row0 * NQKV + 1536 + hd * HD; U.ldqn = NQKV; U.Qr = U.Qn; U.ldqr = NQKV; U.qpos0 = 256 * qb;
    U.K = K8 + 256 + hd * HD; U.V = V8 + 256 + (hd >> 1) * 256;
    U.ctx_row0 = b * PB; U.loc_row0 = b * PB + CTXL;
    U.O = OD + (size_t)(hd & 1) * MROWS * 1024 + (size_t)row0 * 1024 + (hd >> 1) * 256; U.ldo = 1024; U.o8 = 0;
    att::attn_unit_simple<2, 2>(U, lds, wave);
  }
}
constexpr int NPHASE = 20;
__host__ __device__ __forceinline__ bool phase_active(int k) { return !(k == 3 || k == 5); }

__device__ __forceinline__ void moe_tables(KArgs a, int layer, LAS int* tb, int tid) {
    if (tid < 16) tb[17 + tid] = (int)__hip_atomic_load((unsigned*)(a->ws + WS_CTL) + CW_CNT + (layer * 16 + tid) * 64, __ATOMIC_RELAXED, __HIP_MEMORY_SCOPE_AGENT);
    __syncthreads();
    if (tid == 0) { int base = 0; for (int e = 0; e < 16; ++e) { tb[e] = base; const int nt = (tb[17 + e] + 255) >> 8; for (int t = 0; t < nt; ++t) tb[33 + base + t] = e; base += nt; } tb[16] = base; }
    __syncthreads();
}


#if MK_MULTI
#define PH_KERNEL_HEAD extern __shared__ __attribute__((aligned(16))) unsigned char lds_raw[]; LAS unsigned char* lds = (LAS unsigned char*)lds_raw; KArgs a = kargs(); \
    const int l = a->ph_lo; const int wave = __builtin_amdgcn_readfirstlane(threadIdx.x >> 6), lane = lane_id(), tid = wave * 64 + lane; const int G = gridDim.x, bx = blockIdx.x; \
    const int vcu = (G % 8 == 0) ? (bx % 8) * (G / 8) + bx / 8 : bx; const int gwv = bx * 8 + wave, ngw = G * 8; (void)l; (void)lane; (void)vcu; (void)gwv; (void)ngw; (void)lds;
__global__ void __launch_bounds__(512, 2) k_pro(Args kparam) { PH_KERNEL_HEAD phase_prologue(a, lds, tid, lane, wave, G); }
__global__ void __launch_bounds__(512, 2) k_h0(Args kparam) { PH_KERNEL_HEAD phase_h0(a, lds, tid, lane, wave); }
__global__ void __launch_bounds__(512, 2) k_inproj(Args kparam) { PH_KERNEL_HEAD
    pg8::DenseOrder S; S.init(a->ws + WS_H, a->ws + WS_WIN + (size_t)l * NQKV * DM, DM / 2, NQKV, l == 1 ? 2 : 0, G, bx);
    pg8::EpiQKV E{(bf16_t*)(a->ws + WS_QKV), (unsigned char*)(a->ws + WS_Q8), (unsigned char*)(a->ws + WS_QN), (const float*)(a->ws + WS_CS), l == 0 ? 0x10u : 0x3C00u, 0u, l == 0 ? 0x3C10u : 0x3C00u, l == 0 ? 0u : 0x1Fu,     (unsigned char*)(a->ws + WS_K8), (unsigned char*)(a->ws + WS_V8), false};
    pg8::gemm_phase<pg8::EpiQKV, pg8::DenseOrder, true>(lds, DM / 2, S, E, wave); }
__global__ void __launch_bounds__(512, 2) k_prep(Args kparam) { PH_KERNEL_HEAD phase_prep(a, lane, gwv, ngw); }
#if NAIVE_ATTN
__global__ void __launch_bounds__(512, 2) k_attn(Args kparam) { PH_KERNEL_HEAD phase_attn_naive(a, l, lds, lane, wave, gwv, ngw); }
#else
__global__ void __launch_bounds__(512, 2) k_attn(Args kparam) { PH_KERNEL_HEAD if (l == 0) phase_attn0(a, lds, tid, wave, G, vcu); else phase_attn1(a, lds, tid, wave, G, vcu); }
#endif
__global__ void __launch_bounds__(512, 2) k_combine(Args kparam) { PH_KERNEL_HEAD phase_combine(a, lane, gwv, ngw); }
__global__ void __launch_bounds__(512, 2) k_outproj(Args kparam) { PH_KERNEL_HEAD
    pg8::DenseOrder S; S.init(a->ws + WS_O, a->ws + WS_WOUT + (size_t)l * DM * DM, DM / 2, DM, l == 1 ? 1 : 0, G, bx);
    pg8::EpiPlain E{(unsigned char*)(a->ws + WS_QKV), DM, Y8SCALE / (W8SCALE * att_OSCALE), false};
    pg8::gemm_phase<pg8::EpiPlain, pg8::DenseOrder, true>(lds, DM / 2, S, E, wave); }
__global__ void __launch_bounds__(512, 2) k_ln1(Args kparam) { PH_KERNEL_HEAD phase_ln1(a, l, lds, tid, lane, gwv, ngw); }
__global__ void __launch_bounds__(512, 2) k_moe1(Args kparam) { PH_KERNEL_HEAD
    LAS int* tb = (LAS int*)(lds + TB_OFF); moe_tables(a, l, tb, tid);
    pg8::GroupedOrder<true> S{(const char*)(a->ws + WS_H), (const char*)(a->ws + WS_WGU + (size_t)l * 16 * DM * DM), DM / 2, (size_t)DM * DM, (const int*)(a->ws + WS_LIST), tb, G, vcu};
    pg8::EpiSwiGLU E{(unsigned char*)(a->ws + WS_O)};
    pg8::gemm_phase<pg8::EpiSwiGLU, pg8::GroupedOrder<true>, true>(lds, DM / 2, S, E, wave); }
__global__ void __launch_bounds__(512, 2) k_moe2(Args kparam) { PH_KERNEL_HEAD
    LAS int* tb = (LAS int*)(lds + TB_OFF); moe_tables(a, l, tb, tid);
    pg8::GroupedOrder<false> S{(const char*)(a->ws + WS_O), (const char*)(a->ws + WS_WD + (size_t)l * 16 * DM * FF), FF / 2, (size_t)DM * FF, (const int*)(a->ws + WS_LIST), tb, G, vcu};
    pg8::EpiSlots E{(unsigned char*)(a->ws + WS_QKV)};
    pg8::gemm_phase<pg8::EpiSlots, pg8::GroupedOrder<false>, true>(lds, FF / 2, S, E, wave); }
__global__ void __launch_bounds__(512, 2) k_ln2(Args kparam) { PH_KERNEL_HEAD phase_ln2(a, l, lds, tid, lane, gwv, ngw); }
typedef void (*phase_kernel_t)(Args);
#endif
#if !MK_MULTI
template <int L>
__device__ __forceinline__ void layer_phases(LAS unsigned char* lds, const XcdBarrier& bar, const int lo, const int hi, const int wave) {
    constexpr int l = L, pb = 2 + 9 * L;
    const int G = gridDim.x, bx = blockIdx.x;
    const int vcu = (G % 8 == 0) ? (bx % 8) * (G / 8) + bx / 8 : bx;
    const int gwv = bx * 8 + wave, ngw = G * 8;
#define IN(k) (lo <= (k) && (k) < hi)
#define PHASE_END(k) do { if (hi > (k) + 1) xcd_barrier(bar); } while (0)
#define PH_BEGIN(k) for (int rep_ = 0; rep_ <= ((REP_MASK >> (k)) & 1); ++rep_) { const bool dry_ = rep_ < ((REP_MASK >> (k)) & 1); (void)dry_; KArgs a = kargs(); const int lane = lane_id(), tid = wave * 64 + lane; (void)tid; (void)lane;
#define PH_END(k) if (rep_ < ((REP_MASK >> (k)) & 1)) xcd_barrier(bar); } PHASE_END(k);
    if (IN(pb + 0)) { PH_BEGIN(pb + 0)
        pg8::DenseOrder S; S.init(a->ws + WS_H, a->ws + WS_WIN + (size_t)l * NQKV * DM, DM / 2, NQKV, l == 1 ? 2 : 0, G, bx);
        pg8::EpiQKV E{(bf16_t*)(a->ws + WS_QKV), (unsigned char*)(a->ws + WS_Q8), (unsigned char*)(a->ws + WS_QN), (const float*)(a->ws + WS_CS), l == 0 ? 0x10u : 0x3C00u, 0u, l == 0 ? 0x3C10u : 0x3C00u, l == 0 ? 0u : 0x1Fu,     (unsigned char*)(a->ws + WS_K8), (unsigned char*)(a->ws + WS_V8), dry_};
        pg8::gemm_phase<pg8::EpiQKV, pg8::DenseOrder, true>(lds, DM / 2, S, E, wave, dry_);
        PH_END(pb + 0) }
    if (l == 1 && IN(pb + 1)) { PH_BEGIN(pb + 1) phase_prep(a, lane, gwv, ngw); PH_END(pb + 1) }
    if (IN(pb + 2)) { PH_BEGIN(pb + 2)
#if NAIVE_ATTN
        phase_attn_naive(a, l, lds, lane, wave, gwv, ngw);
#else
        if (l == 0) phase_attn0(a, lds, tid, wave, G, vcu); else phase_attn1(a, lds, tid, wave, G, vcu);
#endif
        PH_END(pb + 2) }
    if (l == 1 && IN(pb + 3)) { PH_BEGIN(pb + 3) phase_combine(a, lane, gwv, ngw); PH_END(pb + 3) }
    if (IN(pb + 4)) { PH_BEGIN(pb + 4)
        pg8::DenseOrder S; S.init(a->ws + WS_O, a->ws + WS_WOUT + (size_t)l * DM * DM, DM / 2, DM, l == 1 ? 1 : 0, G, bx);
        pg8::EpiPlain E{(unsigned char*)(a->ws + WS_QKV), DM, Y8SCALE / (W8SCALE * att_OSCALE), dry_};
        pg8::gemm_phase<pg8::EpiPlain, pg8::DenseOrder, true>(lds, DM / 2, S, E, wave, dry_);
        PH_END(pb + 4) }
    if (IN(pb + 5)) { PH_BEGIN(pb + 5) phase_ln1(a, l, lds, tid, lane, gwv, ngw, rep_ < ((REP_MASK >> (pb + 5)) & 1)); PH_END(pb + 5) }
    if (IN(pb + 6)) { PH_BEGIN(pb + 6)
        LAS int* tb = (LAS int*)(lds + TB_OFF); moe_tables(a, l, tb, tid);
        pg8::GroupedOrder<true> S{(const char*)(a->ws + WS_H), (const char*)(a->ws + WS_WGU + (size_t)l * 16 * DM * DM), DM / 2, (size_t)DM * DM, (const int*)(a->ws + WS_LIST), tb, G, vcu};
        pg8::EpiSwiGLU E{(unsigned char*)(a->ws + WS_O)};
        pg8::gemm_phase<pg8::EpiSwiGLU, pg8::GroupedOrder<true>, true>(lds, DM / 2, S, E, wave, dry_);
        PH_END(pb + 6) }
    if (IN(pb + 7)) { PH_BEGIN(pb + 7)
        LAS int* tb = (LAS int*)(lds + TB_OFF); moe_tables(a, l, tb, tid);
        pg8::GroupedOrder<false> S{(const char*)(a->ws + WS_O), (const char*)(a->ws + WS_WD + (size_t)l * 16 * DM * FF), FF / 2, (size_t)DM * FF, (const int*)(a->ws + WS_LIST), tb, G, vcu};
        pg8::EpiSlots E{(unsigned char*)(a->ws + WS_QKV)};
        pg8::gemm_phase<pg8::EpiSlots, pg8::GroupedOrder<false>, true>(lds, FF / 2, S, E, wave, dry_);
        PH_END(pb + 7) }
    if (IN(pb + 8)) { PH_BEGIN(pb + 8) phase_ln2(a, l, lds, tid, lane, gwv, ngw, rep_ < ((REP_MASK >> (pb + 8)) & 1)); PH_END(pb + 8) }
#undef IN
#undef PHASE_END
#undef PH_BEGIN
#undef PH_END
}
__global__ void __launch_bounds__(512, 2) mk_fwd(Args kparam) {
    extern __shared__ __attribute__((aligned(16))) unsigned char lds_raw[];
    LAS unsigned char* lds = (LAS unsigned char*)lds_raw;
    const int wave = __builtin_amdgcn_readfirstlane((int)(threadIdx.x >> 6));
    const int G = gridDim.x, bx = blockIdx.x;
    volatile LAS unsigned* MISC = (volatile LAS unsigned*)(lds + MISC_OFF);
    if (wave == 0 && lane_id() < 4) MISC[lane_id()] = 0u;
    __syncthreads();
    XcdBarrier bar = xcd_barrier_post((unsigned*)(kargs()->ws + WS_CTL) + CW_BAR, MISC, wave);
    const int lo = kargs()->ph_lo, hi = kargs()->ph_hi;
#define IN(k) (lo <= (k) && (k) < hi)
#define PHASE_END(k) do { if (hi > (k) + 1) xcd_barrier(bar); } while (0)

    if (IN(0)) { for (int rep_ = 0; rep_ <= (REP_MASK & 1); ++rep_) { KArgs a = kargs(); const int lane = lane_id(); phase_prologue(a, lds, wave * 64 + lane, lane, wave, G); if (rep_ < (REP_MASK & 1)) xcd_barrier(bar); } PHASE_END(0); }
    if (IN(1)) { KArgs a = kargs(); { const int lane = lane_id(); phase_h0(a, lds, wave * 64 + lane, lane, wave); } PHASE_END(1); }
    for (int xb_ = 0; xb_ < BAR_PROBE; ++xb_) xcd_barrier(bar);

    layer_phases<0>(lds, bar, lo, hi, wave);
    layer_phases<1>(lds, bar, lo, hi, wave);
#undef IN
#undef PHASE_END
}

#endif

extern "C" void kernel_launch(void* const* d_in, const int* in_sizes, int n_in, void* d_out, int out_size, void* d_ws, size_t ws_size, hipStream_t stream) {
    static int grid = 0;
    if (grid == 0) {
        if (n_in != 28 || out_size != NB * SEQ * DM || ws_size < WS_END) { fprintf(stderr, "kernel_launch: shape/workspace mismatch (n_in %d out %d ws %zu need %zu)\n", n_in, out_size, ws_size, (size_t)WS_END); grid = -1; return; }
        int dev = 0, cus = 0;
        if (hipGetDevice(&dev) != hipSuccess || hipDeviceGetAttribute(&cus, hipDeviceAttributeMultiprocessorCount, dev) != hipSuccess) { grid = -1; return; }
#if MK_MULTI
        const void* ks[] = {(const void*)k_pro, (const void*)k_h0, (const void*)k_inproj, (const void*)k_prep, (const void*)k_attn, (const void*)k_combine, (const void*)k_outproj, (const void*)k_ln1, (const void*)k_moe1, (const void*)k_moe2, (const void*)k_ln2};
        for (int i = 0; i < 11; ++i) if (hipFuncSetAttribute(ks[i], hipFuncAttributeMaxDynamicSharedMemorySize, LDS_BYTES) != hipSuccess) { fprintf(stderr, "kernel_launch: hipFuncSetAttribute failed\n"); grid = -1; return; }
#else
        if (hipFuncSetAttribute((const void*)mk_fwd, hipFuncAttributeMaxDynamicSharedMemorySize, LDS_BYTES) != hipSuccess) { fprintf(stderr, "kernel_launch: hipFuncSetAttribute failed\n"); grid = -1; return; }
        int per_cu = 0;
        if (hipOccupancyMaxActiveBlocksPerMultiprocessor(&per_cu, (const void*)mk_fwd, 512, LDS_BYTES) != hipSuccess || per_cu < 1) fprintf(stderr, "kernel_launch: occupancy query says %d\n", per_cu);
        (void)hipGetLastError();
#endif
        grid = cus;
    }
    if (grid < 0) return;
    (void)hipMemsetAsync((char*)d_ws + WS_CTL, 0, CTL_BYTES, stream);
    Args a{};
    for (int i = 0; i < 28; ++i) a.in[i] = (const float*)d_in[i];
    a.out = (float*)d_out; a.ws = (unsigned char*)d_ws;
#if MK_MULTI
    {
        const phase_kernel_t seq[9] = {k_inproj, k_prep, k_attn, k_combine, k_outproj, k_ln1, k_moe1, k_moe2, k_ln2};
        a.ph_lo = 0; a.ph_hi = 0;
        hipLaunchKernelGGL(k_pro, dim3(grid), dim3(512), LDS_BYTES, stream, a);
        hipLaunchKernelGGL(k_h0, dim3(grid), dim3(512), LDS_BYTES, stream, a);
        for (int l = 0; l < 2; ++l) for (int j = 0; j < 9; ++j) { if (l == 0 && (j == 1 || j == 3)) continue; a.ph_lo = l; a.ph_hi = l; hipLaunchKernelGGL(seq[j], dim3(grid), dim3(512), LDS_BYTES, stream, a); }
    }
#else
    a.ph_lo = 0; a.ph_hi = NPHASE; hipLaunchKernelGGL(mk_fwd, dim3(grid), dim3(512), LDS_BYTES, stream, a);
#endif
    const hipError_t le = hipPeekAtLastError();
    if (le != hipSuccess) fprintf(stderr, "kernel_launch: launch failed: %s\n", hipGetErrorName(le));
}
```

```cpp
#include <hip/hip_runtime.h>
#include <cstdio>
#include <cstdint>

#ifndef MK_MULTI
#define MK_MULTI 0
#endif

#ifndef NAIVE_ATTN
#define NAIVE_ATTN 0
#endif

#ifndef REP_MASK
#define REP_MASK 0
#endif

#ifndef GEMM_PROBE_NOEPI
#define GEMM_PROBE_NOEPI 0
#endif
#ifndef GEMM_PROBE_NODMA
#define GEMM_PROBE_NODMA 0
#endif
#ifndef GEMM_PROBE_HALFST
#define GEMM_PROBE_HALFST 0
#endif
#ifndef BAR_PROBE
#define BAR_PROBE 0
#endif
#ifndef EPIQKV_PROBE
#define EPIQKV_PROBE 0
#endif
#ifndef EPI_REP
#define EPI_REP 0
#endif
#ifndef STAMP_PHASE
#define STAMP_PHASE -1
#endif
#ifndef STAMP_BIN
#define STAMP_BIN 10.0f
#define STAMP_OFS 0.0f
#endif
#ifndef LN1_DRYVAR
#define LN1_DRYVAR 0
#endif

#define GAS __attribute__((address_space(1)))
#define LAS __attribute__((address_space(3)))
typedef unsigned short bf16_t;
typedef short bf16x8 __attribute__((ext_vector_type(8)));
typedef float f32x4 __attribute__((ext_vector_type(4)));
typedef float f32x2 __attribute__((ext_vector_type(2)));
typedef float f32x16 __attribute__((ext_vector_type(16)));
typedef unsigned u32x4 __attribute__((ext_vector_type(4)));
typedef unsigned u32x2 __attribute__((ext_vector_type(2)));

constexpr int DM = 2048, NB = 16, SEQ = 2048, CTXL = 256, PB = SEQ + CTXL, MROWS = NB * PB;
constexpr int NQKV = 4608, HD = 128, NE = 16, FF = 1024, GRIDW = 64;
constexpr float ALPHA = 1.4142135623730951f;
constexpr float SM_SCALE = 0.08838834764831845f;
constexpr float LAMBDA_INIT1 = 0.35550906759096927f;
constexpr float ONE_M_LI = 1.0f - LAMBDA_INIT1;
constexpr int LCAP = MROWS;
constexpr int MAXT = 304;

constexpr size_t MiB = 1u << 20;
constexpr size_t WS_CTL = 0, CTL_BYTES = 1 * MiB;
constexpr size_t WS_MOD = 1 * MiB;
constexpr size_t WS_CS = 3 * MiB;
constexpr size_t WS_GW = 4 * MiB;
constexpr size_t WS_PPOS = 4 * MiB + 512 * 1024;
constexpr size_t WS_LIST = 5 * MiB;
constexpr size_t WS_WIN = 8 * MiB;
constexpr size_t WS_WOUT = 44 * MiB;
constexpr size_t WS_WGU = 60 * MiB;
constexpr size_t WS_K8 = (60 + 128) * MiB;
constexpr size_t WS_V8 = (60 + 128 + 48) * MiB;
constexpr size_t WS_WD = 316 * MiB;
constexpr size_t WS_XC = 444 * MiB;
constexpr size_t WS_H = 476 * MiB;
constexpr size_t WS_QKV = 620 * MiB;
constexpr size_t WS_Q8 = (620 + 162) * MiB;
constexpr size_t WS_QN = 944 * MiB;
constexpr size_t WS_O = 1088 * MiB;
constexpr size_t WS_END = 1240 * MiB;
constexpr int CW_BAR = 4096;
constexpr int CW_MODF = 12288;
constexpr int CW_CNT = 16384;

constexpr int LDS_BYTES = 163840;
constexpr int RING_BYTES = 131072;
constexpr int TB_OFF = RING_BYTES;
constexpr int STASH_OFF = RING_BYTES + 2048;
constexpr int MISC_OFF = LDS_BYTES - 64;

__device__ __forceinline__ unsigned cvt_pk_bf16(float lo, float hi) { unsigned r; asm volatile("v_cvt_pk_bf16_f32 %0, %1, %2" : "=v"(r) : "v"(lo), "v"(hi)); return r; }
__device__ __forceinline__ unsigned cvt4_fp8(float a, float b, float c, float d) { int w = __builtin_amdgcn_cvt_pk_fp8_f32(a, b, 0, false); w = __builtin_amdgcn_cvt_pk_fp8_f32(c, d, w, true); return (unsigned)w; }
constexpr float att_OSCALE = 16.0f;
constexpr float Y8SCALE = 16.0f;
__device__ __forceinline__ f32x4 fp8x4_to_f32(unsigned w) { const f32x2 lo = __builtin_amdgcn_cvt_pk_f32_fp8((int)w, false), hi = __builtin_amdgcn_cvt_pk_f32_fp8((int)w, true); return (f32x4){lo.x, lo.y, hi.x, hi.y}; }
constexpr float W8SCALE = 64.0f;
__device__ __forceinline__ float bf_lo(unsigned w) { return __uint_as_float(w << 16); }
__device__ __forceinline__ float bf_hi(unsigned w) { return __uint_as_float(w & 0xffff0000u); }
__device__ __forceinline__ float bf2f(bf16_t b) { return __uint_as_float((unsigned)b << 16); }
__device__ __forceinline__ float wave_sum(float v) {
#pragma unroll
    for (int o = 1; o < 64; o <<= 1) v += __shfl_xor(v, o);
    return v;
}
__device__ __forceinline__ float wave_max(float v) {
#pragma unroll
    for (int o = 1; o < 64; o <<= 1) v = fmaxf(v, __shfl_xor(v, o));
    return v;
}
__device__ __forceinline__ int lane_id() { int l; asm volatile("v_mbcnt_lo_u32_b32 %0, -1, 0\n\tv_mbcnt_hi_u32_b32 %0, -1, %0" : "=v"(l)); return l; }
#define LDS_WAIT() asm volatile("s_waitcnt lgkmcnt(0)" ::: "memory")
#define VM_WAIT() asm volatile("s_waitcnt vmcnt(0)" ::: "memory")

struct Args { const float* in[28]; float* out; unsigned char* ws; int ph_lo, ph_hi; };
typedef const __attribute__((address_space(4))) Args* KArgs;
__device__ __forceinline__ KArgs kargs() { KArgs p = (KArgs)__builtin_amdgcn_kernarg_segment_ptr(); asm volatile("" : "+s"(p)); return p; }
namespace pg8 {
constexpr int BM = 256, BK = 64, HALF = 128, HTB = HALF * BK * 2, STAGE_BYTES = 8 * HTB, NXCD = 8, WGM = 12;
__host__ __device__ __forceinline__ int lds_byte(int r, int c) { const int st = (r >> 4) * 2 + (c >> 5), rr = r & 15, cc = c & 31, ob = rr * 64 + cc * 2; return st * 1024 + (ob ^ (((ob >> 9) & 1) << 5)); }
__host__ __device__ __forceinline__ void stage_rc(int b, int& R, int& C) { const int st = b / 1024, sb = b % 1024, swz = sb ^ (((sb >> 9) & 1) << 5); R = (st >> 1) * 16 + swz / 64; C = (st & 1) * 32 + (swz % 64) / 2; }
__host__ __device__ __forceinline__ int perm32(int rho) { const int n = rho >> 4, i = rho & 15; return 8 * (i >> 2) + 4 * n + (i & 3); }

typedef int v4i_t __attribute__((ext_vector_type(4)));
typedef int v8i_t __attribute__((ext_vector_type(8)));
struct Unit { int pm, pn, e, mt; };

constexpr bool ALIGN_EPI_ = true;
template <class Epi, class Sched, bool FP8 = false>
__device__ __forceinline__ void gemm_phase(LAS unsigned char* lds, const int K, const Sched& S, const Epi& E, const int wid, const bool skip_epi = false) {
    const int lane = lane_id(), tid = wid * 64 + lane, wr = wid >> 2, wc = wid & 3, fr = lane & 15, fq = lane >> 4;
    const int nt = K / BK;
    int RA[2]; unsigned CA[2], voffB[2];
#pragma unroll
    for (int i = 0; i < 2; ++i) { int R, C; stage_rc(tid * 16 + i * 8192, R, C); const int Rb = (R & ~31) + perm32(R & 31);
        RA[i] = R; CA[i] = (unsigned)C * 2u; voffB[i] = (unsigned)(Rb * K + C) * 2u; }
    const size_t kstep = (size_t)(BK * 2);
    const size_t hstep = (size_t)HALF * K * 2;
    const unsigned ldsw = (unsigned)wid * 1024u;
    const int aoff = lds_byte(wr * 64 + fr, fq * 8), boff = lds_byte(wc * 32 + fr, fq * 8);
#define PG8_SA(b, h) (((b) * 2 + (h)) * HTB)
#define PG8_SB(b, h) ((4 + (b) * 2 + (h)) * HTB)
#define PG8_STAGE(bufoff, gbase, v0, v1) do { if (GEMM_PROBE_NODMA && skip_epi) break; \
        __builtin_amdgcn_global_load_lds((const unsigned*)((const char*)(gbase) + (v0)), (LAS unsigned*)(lds + (bufoff) + ldsw), 16, 0, 0); \
        __builtin_amdgcn_global_load_lds((const unsigned*)((const char*)(gbase) + (v1)), (LAS unsigned*)(lds + (bufoff) + ldsw + 8192), 16, 0, 0); } while (0)
#define PG8_LD8(p) __builtin_shufflevector(*(const LAS v4i_t*)(p), *(const LAS v4i_t*)((p) + 1024), 0, 1, 2, 3, 4, 5, 6, 7)
#define PG8_LDA(dst, b, h) do { if constexpr (FP8) { _Pragma("unroll") for (int m = 0; m < 4; ++m) dst##8[m] = PG8_LD8(lds + PG8_SA(b, h) + aoff + m * 2048); } \
        else { _Pragma("unroll") for (int m = 0; m < 4; ++m) _Pragma("unroll") for (int k = 0; k < 2; ++k) dst[m][k] = *(const LAS bf16x8*)(lds + PG8_SA(b, h) + aoff + m * 2048 + k * 1024); } } while (0)
#define PG8_LDB(dst, b, h) do { if constexpr (FP8) { _Pragma("unroll") for (int n = 0; n < 2; ++n) dst##8[n] = PG8_LD8(lds + PG8_SB(b, h) + boff + n * 2048); } \
        else { _Pragma("unroll") for (int n = 0; n < 2; ++n) _Pragma("unroll") for (int k = 0; k < 2; ++k) dst[n][k] = *(const LAS bf16x8*)(lds + PG8_SB(b, h) + boff + n * 2048 + k * 1024); } } while (0)
#define PG8_CAT(x) __builtin_shufflevector(__builtin_bit_cast(v4i_t, x[0]), __builtin_bit_cast(v4i_t, x[1]), 0, 1, 2, 3, 4, 5, 6, 7)
#define PG8_MMA(ai, bj, At, Bt) do { __builtin_amdgcn_s_setprio(1); \
        if constexpr (FP8) { _Pragma("unroll") for (int m = 0; m < 4; ++m) _Pragma("unroll") for (int n = 0; n < 2; ++n) \
            asm volatile("v_mfma_f32_16x16x128_f8f6f4 %0, %1, %2, %0" : "+v"(acc[ai][bj][m][n]) : "v"(Bt##8[n]), "v"(At##8[m])); } \
        else { _Pragma("unroll") for (int m = 0; m < 4; ++m) _Pragma("unroll") for (int n = 0; n < 2; ++n) _Pragma("unroll") for (int k = 0; k < 2; ++k) \
            acc[ai][bj][m][n] = __builtin_amdgcn_mfma_f32_16x16x32_bf16(Bt[n][k], At[m][k], acc[ai][bj][m][n], 0, 0, 0); } \
        __builtin_amdgcn_s_setprio(0); } while (0)
#define PG8_WAIT_V(n) asm volatile("s_waitcnt vmcnt(" #n ")" ::: "memory")
#define PG8_WAIT_L(n) asm volatile("s_waitcnt lgkmcnt(" #n ")" ::: "memory")
#define PG8_BAR __builtin_amdgcn_s_barrier()
#define PG8_SCHED __builtin_amdgcn_sched_barrier(0)
    Unit cur, nxt; int ui = 0;
    if (!S.next(0, cur)) return;
    f32x4 acc[2][2][4][2];
#pragma unroll
    for (int a = 0; a < 2; ++a)
#pragma unroll
        for (int b = 0; b < 2; ++b)
#pragma unroll
            for (int m = 0; m < 4; ++m)
#pragma unroll
                for (int n = 0; n < 2; ++n) acc[a][b][m][n] = (f32x4){0.f, 0.f, 0.f, 0.f};
    bf16x8 At[4][2], B0[2][2], B1[2][2];
    v8i_t At8[4], B08[2], B18[2];
    unsigned c00 = S.a_off(cur, 0, RA[0]) + CA[0], c01 = S.a_off(cur, 0, RA[1]) + CA[1], c10 = S.a_off(cur, 1, RA[0]) + CA[0], c11 = S.a_off(cur, 1, RA[1]) + CA[1];
    const char* cA = S.a_base(cur); const char* cB = S.b_base(cur);
    PG8_STAGE(PG8_SB(0, 0), cB, voffB[0], voffB[1]); PG8_STAGE(PG8_SB(0, 1), cB + hstep, voffB[0], voffB[1]); PG8_STAGE(PG8_SA(0, 0), cA, c00, c01); PG8_STAGE(PG8_SA(0, 1), cA, c10, c11);
    if (wr == 1) PG8_BAR;
    PG8_WAIT_V(2); PG8_BAR;
    PG8_STAGE(PG8_SB(1, 0), cB + kstep, voffB[0], voffB[1]); PG8_STAGE(PG8_SA(1, 0), cA + kstep, c00, c01); PG8_STAGE(PG8_SB(1, 1), cB + hstep + kstep, voffB[0], voffB[1]);
    PG8_WAIT_V(6); PG8_BAR;
    LAS u32x4* stash = (LAS u32x4*)(lds + STASH_OFF) + tid;
    for (;;) {
        const bool has_next = S.next(ui + 1, nxt);
        const char* nA = cA; const char* nB = cB;
        if (has_next) { nA = S.a_base(nxt); nB = S.b_base(nxt); }
        if constexpr (Sched::GATHER) {
            u32x4 sv = (u32x4){c00, c01, c10, c11};
            if (has_next) { sv.x = S.a_off(nxt, 0, RA[0]) + CA[0]; sv.y = S.a_off(nxt, 0, RA[1]) + CA[1]; sv.z = S.a_off(nxt, 1, RA[0]) + CA[0]; sv.w = S.a_off(nxt, 1, RA[1]) + CA[1]; }
            *stash = sv;
        }
#pragma clang loop unroll(disable)
        for (int t = 0; t < nt; t += 2) {
            const bool last = (t == nt - 2);
            const char* a1 = cA + (size_t)(t + 1) * kstep;
            const char* a2 = last ? nA : cA + (size_t)(t + 2) * kstep; const char* b2 = last ? nB : cB + (size_t)(t + 2) * kstep;
            const char* a3 = a2 + kstep; const char* b3 = b2 + kstep;
            unsigned x00 = c00, x01 = c01, x10 = c10, x11 = c11;
            if constexpr (Sched::GATHER) { if (last) { const u32x4 sv = *stash; x00 = sv.x; x01 = sv.y; x10 = sv.z; x11 = sv.w; } }
            PG8_LDB(B0, 0, 0); PG8_LDB(B1, 0, 1); PG8_SCHED; PG8_LDA(At, 0, 0); PG8_STAGE(PG8_SA(1, 1), a1, c10, c11);
            PG8_WAIT_V(8); PG8_WAIT_L(0); PG8_BAR; PG8_MMA(0, 0, At, B0); PG8_MMA(0, 1, At, B1); PG8_BAR; PG8_SCHED;
            PG8_LDA(At, 0, 1); PG8_STAGE(PG8_SB(0, 0), b2, voffB[0], voffB[1]); PG8_STAGE(PG8_SB(0, 1), b2 + hstep, voffB[0], voffB[1]); PG8_STAGE(PG8_SA(0, 0), a2, x00, x01);
            PG8_WAIT_V(8); PG8_WAIT_L(0); PG8_BAR; PG8_MMA(1, 0, At, B0); PG8_MMA(1, 1, At, B1); PG8_BAR; PG8_SCHED;
            PG8_LDB(B0, 1, 0); PG8_LDB(B1, 1, 1); PG8_SCHED; PG8_LDA(At, 1, 0); PG8_STAGE(PG8_SA(0, 1), a2, x10, x11);
            PG8_WAIT_V(8); PG8_WAIT_L(0); PG8_BAR; PG8_MMA(0, 0, At, B0); PG8_MMA(0, 1, At, B1); PG8_BAR; PG8_SCHED;
            PG8_LDA(At, 1, 1); PG8_STAGE(PG8_SB(1, 0), b3, voffB[0], voffB[1]); PG8_STAGE(PG8_SB(1, 1), b3 + hstep, voffB[0], voffB[1]); PG8_STAGE(PG8_SA(1, 0), a3, x00, x01);
            PG8_WAIT_V(8); PG8_WAIT_L(0); PG8_BAR; PG8_MMA(1, 0, At, B0); PG8_MMA(1, 1, At, B1); PG8_BAR; PG8_SCHED;
        }
        if constexpr (ALIGN_EPI_) { if (wr == 0) PG8_BAR; }
        if constexpr (FP8) asm volatile("s_nop 15\n\ts_nop 15" ::: "memory");
        if constexpr (EPI_REP == 0) { if (!(GEMM_PROBE_NOEPI && skip_epi)) E(acc, cur, wr, wc, fr, fq); }
        else { int nrep_ = EPI_REP + 1; asm volatile("" : "+s"(nrep_)); for (int er_ = 0; er_ < nrep_; ++er_) { asm volatile("" ::: "memory"); E(acc, cur, wr, wc, fr, fq); } }
        if (!has_next) break;
#pragma unroll
        for (int a = 0; a < 2; ++a)
#pragma unroll
            for (int b = 0; b < 2; ++b)
#pragma unroll
                for (int m = 0; m < 4; ++m)
#pragma unroll
                    for (int n = 0; n < 2; ++n) acc[a][b][m][n] = (f32x4){0.f, 0.f, 0.f, 0.f};
        cur = nxt; cA = nA; cB = nB; ++ui;
        if constexpr (Sched::GATHER) { const u32x4 sv = *stash; c00 = sv.x; c01 = sv.y; c10 = sv.z; c11 = sv.w; }
        if constexpr (ALIGN_EPI_) { if (wr == 1) PG8_BAR; }
    }
    PG8_WAIT_V(0);
    if constexpr (!ALIGN_EPI_) { if (wr == 0) PG8_BAR; }
    PG8_BAR;
#undef PG8_SA
#undef PG8_SB
#undef PG8_STAGE
#undef PG8_LDA
#undef PG8_LD8
#undef PG8_LDB
#undef PG8_MMA
#undef PG8_CAT
#undef PG8_WAIT_V
#undef PG8_WAIT_L
#undef PG8_BAR
#undef PG8_SCHED
}

struct DenseOrder {
    static constexpr bool GATHER = false;
    const char* A; const char* Bt; int K; int nMe, nN, nwg, ntot, G, c; int mode;
    __device__ __forceinline__ void init(const void* A_, const void* Bt_, int K_, int N, int mode_, int G_, int c_) { A = (const char*)A_; Bt = (const char*)Bt_; K = K_; mode = mode_; nMe = mode_ ? 128 : 144; nN = N / BM; nwg = nMe * nN; ntot = nwg + (mode_ == 2 ? 160 : 0); G = G_; c = c_; }
    __device__ __forceinline__ bool next(int i, Unit& u) const {
        const long L = (long)i * G + c; if (L >= ntot) return false;
        u.e = 0; u.mt = 0;
        if (L >= nwg) { const int idx = (int)L - nwg; const int b = idx / 10, j = idx - b * 10; u.pm = 9 * b; u.pn = j < 2 ? 4 + j : 8 + j; return true; }
        int wgid = (int)L; { const int q = nwg / NXCD, r = nwg % NXCD, xcd = wgid % NXCD, off = wgid / NXCD; wgid = (xcd < r ? xcd * (q + 1) : r * (q + 1) + (xcd - r) * q) + off; }
        const int nig = WGM * nN, gid = wgid / nig, fm = gid * WGM, gsz = (nMe - fm) < WGM ? (nMe - fm) : WGM;
        const int pme = fm + ((wgid % nig) % gsz); u.pn = (wgid % nig) / gsz; u.pm = mode ? pme + (pme >> 3) + 1 : pme; return true;
    }
    __device__ __forceinline__ const char* a_base(const Unit& u) const { return A + (size_t)u.pm * BM * K * 2; }
    __device__ __forceinline__ const char* b_base(const Unit& u) const { return Bt + (size_t)u.pn * BM * K * 2; }
    __device__ __forceinline__ unsigned a_off(const Unit&, int h, int R) const { return (unsigned)((h * HALF + R) * K * 2); }
};
template <bool GATHER_>
struct GroupedOrder {
    static constexpr bool GATHER = GATHER_;
    const char* A; const char* Bt; int K; size_t bstride; const int* list; const LAS int* tb; int G, vcu;
    __device__ __forceinline__ bool next(int i, Unit& u) const {
        const int L = i * G + vcu; const int T = tb[16]; if (L >= T * 8) return false;
        u.pm = L >> 3; u.pn = L & 7; u.e = tb[33 + u.pm]; u.mt = u.pm - tb[u.e]; return true;
    }
    __device__ __forceinline__ const char* a_base(const Unit& u) const { return GATHER ? A : A + (size_t)u.pm * BM * K * 2; }
    __device__ __forceinline__ const char* b_base(const Unit& u) const { return Bt + (size_t)u.e * bstride + (size_t)u.pn * BM * K * 2; }
    __device__ __forceinline__ unsigned a_off(const Unit& u, int h, int R) const {
        if (!GATHER) return (unsigned)((h * HALF + R) * K * 2);
        const int s = u.mt * BM + h * HALF + R; const int n = tb[17 + u.e];
        const int pair = (s < n) ? list[(size_t)u.e * LCAP + s] : 0;
        return (unsigned)(pair >> 1) * (unsigned)(K * 2);
    }
};

struct EpiQKV {
    bf16_t* RAW; unsigned char* Q8; unsigned char* QN8; const float* CS; unsigned ropemask, qnmask, k8mask, rawmask; unsigned char* K8; unsigned char* V8; bool dry;
    __device__ __forceinline__ void operator()(const f32x4 (&acc)[2][2][4][2], const Unit& u, int wr, int wc, int fr, int fq) const {
        const int pn = u.pn; const int bidx = u.pm / 9; const bool isctx = (u.pm - bidx * 9) == 0;
        const bool rope = !isctx && ((ropemask >> pn) & 1u) && !((EPIQKV_PROBE & 1) && dry); const bool qn = !isctx && ((qnmask >> pn) & 1u) && !((EPIQKV_PROBE & 2) && dry);
        const int row0 = u.pm * BM + wr * 64 + fr;
        const int col0 = pn * BM + wc * 32 + 8 * fq;
        const int qncol0 = ((pn < 4) ? 256 * pn : 1024 + 256 * (pn - 6)) + wc * 32 + 8 * fq;
        const int p0 = 16 * wc + 4 * fq;
        const bool raw = (rawmask >> pn) & 1u;
        const bool isv = (pn == 5) || (pn >= 14); const bool k8 = ((k8mask >> pn) & 1u) || isv;
        const int k8col0 = (isv ? (pn == 5 ? 0 : 256 + (pn - 14) * 256) : (pn == 4 ? 0 : 256 + (pn - 10) * 256)) + wc * 32 + 8 * fq;
        unsigned char* KV8 = isv ? V8 : K8;
        f32x4 csA[8], csB[8];
#pragma unroll
        for (int i = 0; i < 8; ++i) { csA[i] = (f32x4){1.f, 0.f, 1.f, 0.f}; csB[i] = csA[i];
            if (rope) { const int t = row0 + (i >> 2) * HALF + (i & 3) * 16 - bidx * PB - CTXL; const float* cp = CS + ((size_t)t * 64 + p0) * 2; csA[i] = *(const f32x4*)cp; csB[i] = *(const f32x4*)(cp + 4); } }
#pragma unroll
        for (int ai = 0; ai < 2; ++ai)
#pragma unroll
            for (int m = 0; m < 4; ++m) {
                const int row = row0 + ai * HALF + m * 16;
                const f32x4 cs0 = csA[ai * 4 + m], cs1 = csB[ai * 4 + m];
#pragma unroll
                for (int bj = 0; bj < 2; ++bj) {
                    f32x4 v0 = acc[ai][bj][m][0] * (1.0f / W8SCALE), v1 = acc[ai][bj][m][1] * (1.0f / W8SCALE);
                    if (qn) { u32x2 w; w.x = cvt4_fp8(v0[0], v0[1], v0[2], v0[3]); w.y = cvt4_fp8(v1[0], v1[1], v1[2], v1[3]);
                        *(u32x2*)(QN8 + (size_t)row * DM + qncol0 + bj * HALF) = w; }
                    if (rope) {
                        f32x4 r0, r1;
                        r0[0] = v0[0] * cs0[0] - v0[1] * cs0[1]; r0[1] = v0[0] * cs0[1] + v0[1] * cs0[0];
                        r0[2] = v0[2] * cs0[2] - v0[3] * cs0[3]; r0[3] = v0[2] * cs0[3] + v0[3] * cs0[2];
                        r1[0] = v1[0] * cs1[0] - v1[1] * cs1[1]; r1[1] = v1[0] * cs1[1] + v1[1] * cs1[0];
                        r1[2] = v1[2] * cs1[2] - v1[3] * cs1[3]; r1[3] = v1[2] * cs1[3] + v1[3] * cs1[2];
                        v0 = r0; v1 = r1;
                    }
                    if (k8) { u32x2 w; w.x = cvt4_fp8(v0[0], v0[1], v0[2], v0[3]); w.y = cvt4_fp8(v1[0], v1[1], v1[2], v1[3]);
                        *(u32x2*)(KV8 + (size_t)row * 1280 + k8col0 + bj * HALF) = w; }
                    else if (raw) { u32x4 w; w.x = cvt_pk_bf16(v0[0], v0[1]); w.y = cvt_pk_bf16(v0[2], v0[3]); w.z = cvt_pk_bf16(v1[0], v1[1]); w.w = cvt_pk_bf16(v1[2], v1[3]);
                        *(u32x4*)(RAW + (size_t)row * 1280 + col0 + bj * HALF) = w; }
                    else { u32x2 w; w.x = cvt4_fp8(v0[0], v0[1], v0[2], v0[3]); w.y = cvt4_fp8(v1[0], v1[1], v1[2], v1[3]);
                        *(u32x2*)(Q8 + (size_t)row * NQKV + col0 + bj * HALF) = w; }
                }
            }
    }
};
struct EpiPlain {
    unsigned char* O; int ldc; float scale; bool dry;
    __device__ __forceinline__ void operator()(const f32x4 (&acc)[2][2][4][2], const Unit& u, int wr, int wc, int fr, int fq) const {
        const int row0 = u.pm * BM + wr * 64 + fr; const int col0 = u.pn * BM + wc * 32 + 8 * fq;
#pragma unroll
        for (int ai = 0; ai < 2; ++ai)
#pragma unroll
            for (int m = 0; m < 4; ++m) { unsigned char* rowp = O + (size_t)(row0 + ai * HALF + m * 16) * ldc + col0;
#pragma unroll
                for (int bj = 0; bj < 2; ++bj) { const f32x4 v0 = acc[ai][bj][m][0] * scale, v1 = acc[ai][bj][m][1] * scale;
                    u32x2 w; w.x = cvt4_fp8(v0[0], v0[1], v0[2], v0[3]); w.y = cvt4_fp8(v1[0], v1[1], v1[2], v1[3]);
                    if (!(GEMM_PROBE_HALFST && dry && bj == 1)) *(u32x2*)(rowp + bj * HALF) = w; } }
    }
};
struct EpiSwiGLU {
    unsigned char* ACT;
    __device__ __forceinline__ void operator()(const f32x4 (&acc)[2][2][4][2], const Unit& u, int wr, int wc, int fr, int fq) const {
        const int row0 = u.pm * BM + wr * 64 + fr; const int col0 = u.pn * HALF + wc * 32 + 8 * fq;
#pragma unroll
        for (int ai = 0; ai < 2; ++ai)
#pragma unroll
            for (int m = 0; m < 4; ++m) {
                float o[8];
#pragma unroll
                for (int n = 0; n < 2; ++n)
#pragma unroll
                    for (int j = 0; j < 4; ++j) { const float g = acc[ai][0][m][n][j] * (1.0f / W8SCALE), up = acc[ai][1][m][n][j] * (1.0f / W8SCALE);
                        const float s = __builtin_amdgcn_rcpf(1.0f + __builtin_amdgcn_exp2f(-g * 1.4426950408889634f)); o[n * 4 + j] = g * s * up; }
                u32x2 w; w.x = cvt4_fp8(o[0], o[1], o[2], o[3]); w.y = cvt4_fp8(o[4], o[5], o[6], o[7]);
                *(u32x2*)(ACT + (size_t)(row0 + ai * HALF + m * 16) * FF + col0) = w;
            }
    }
};
struct EpiSlots {
    unsigned char* DNS;
    __device__ __forceinline__ void operator()(const f32x4 (&acc)[2][2][4][2], const Unit& u, int wr, int wc, int fr, int fq) const {
        const int row0 = u.pm * BM + wr * 64 + fr; const int col0 = u.pn * BM + wc * 32 + 8 * fq; constexpr float sc = Y8SCALE / W8SCALE;
#pragma unroll
        for (int ai = 0; ai < 2; ++ai)
#pragma unroll
            for (int m = 0; m < 4; ++m) { unsigned char* rowp = DNS + (size_t)(row0 + ai * HALF + m * 16) * DM + col0;
#pragma unroll
                for (int bj = 0; bj < 2; ++bj) { const f32x4 v0 = acc[ai][bj][m][0] * sc, v1 = acc[ai][bj][m][1] * sc;
                    u32x2 w; w.x = cvt4_fp8(v0[0], v0[1], v0[2], v0[3]); w.y = cvt4_fp8(v1[0], v1[1], v1[2], v1[3]);
                    *(u32x2*)(rowp + bj * HALF) = w; } }
    }
};
}
typedef GAS unsigned gu32;
#define XB_TMO      128
#define XB_XCNT(j)  (256  + 64 * (j))
#define XB_XSUB(j)  (1280 + 64 * (j))
#define XB_XGEN(j)  (2304 + 64 * (j))
#define XB_TOP      3328
#define XB_TOPGEN   3392
#define XCD_BAR_WORDS 3456
#define XB_SPIN_CAP (1u << 18)
__device__ __forceinline__ unsigned xb_ld(unsigned* p)              { return __hip_atomic_load((GAS unsigned*)p, __ATOMIC_RELAXED, __HIP_MEMORY_SCOPE_AGENT); }
__device__ __forceinline__ unsigned xb_add(unsigned* p, unsigned v) { return __hip_atomic_fetch_add((GAS unsigned*)p, v, __ATOMIC_RELAXED, __HIP_MEMORY_SCOPE_AGENT); }
__device__ __forceinline__ unsigned xb_xcc_id() { return (unsigned)__builtin_amdgcn_s_getreg((3 << 11) | 20) & 0xFu; }
#define XB_SPIN(cond, bar) do { unsigned _sp = 0; while (cond) { __builtin_amdgcn_s_sleep(1); \
    if ((++_sp & 255u) == 0u) { if (xb_ld(&(bar)[XB_TMO])) break; if (_sp > XB_SPIN_CAP) { (void)xb_add(&(bar)[XB_TMO], 1u); break; } } } } while (0)
struct XcdBarrier { unsigned* bar; unsigned x; volatile LAS unsigned* st; int wave; };
__device__ __forceinline__ XcdBarrier xcd_barrier_post(unsigned* bar, volatile LAS unsigned* st, int wave) {
    XcdBarrier b; b.bar = bar; b.x = xb_xcc_id(); b.st = st; b.wave = wave;
    if (wave == 0 && lane_id() == 0) (void)xb_add(&bar[XB_XCNT(b.x)], 1u);
    return b;
}
__device__ __forceinline__ void xcd_barrier_complete(unsigned* bar, unsigned x, unsigned& nloc, unsigned& nx) {
    const unsigned G = gridDim.x * gridDim.y * gridDim.z;
    unsigned sum, cnt, mine, sp = 0u;
    for (;;) {
        sum = 0u; cnt = 0u; mine = 0u;
#pragma unroll
        for (unsigned j = 0; j < 16; ++j) { const unsigned c = xb_ld(&bar[XB_XCNT(j)]); sum += c; cnt += (c > 0u) ? 1u : 0u; mine = (j == x) ? c : mine; }
        if (sum == G) break;
        __builtin_amdgcn_s_sleep(1);
        if ((++sp & 255u) == 0u) { if (xb_ld(&bar[XB_TMO])) break; if (sp > XB_SPIN_CAP) { (void)xb_add(&bar[XB_TMO], 1u); break; } }
    }
    nloc = mine > 0u ? mine : 1u; nx = cnt > 0u ? cnt : 1u;
}
__device__ __forceinline__ void xcd_barrier(const XcdBarrier& b) {
    asm volatile("s_waitcnt vmcnt(0)" ::: "memory");
    __syncthreads();
    if (b.wave == 0 && lane_id() == 0) {
        unsigned* bar = b.bar; asm volatile("" : "+s"(bar));
        __builtin_amdgcn_s_waitcnt(0);
        unsigned nloc = b.st[0], nx = b.st[1];
        if (nloc == 0u) { xcd_barrier_complete(bar, b.x, nloc, nx); b.st[0] = nloc; b.st[1] = nx; }
        const unsigned old = xb_add(&bar[XB_XSUB(b.x)], 1u);
        const unsigned gen = old / nloc;
        if (old + 1u == (gen + 1u) * nloc) {
            __builtin_amdgcn_fence(__ATOMIC_RELEASE, "agent");
            asm volatile("s_waitcnt vmcnt(0)" ::: "memory");
            const unsigned og = xb_add(&bar[XB_TOP], 1u);
            const unsigned tg = og / nx;
            if (og + 1u == (tg + 1u) * nx) xb_add(&bar[XB_TOPGEN], 1u);
            else XB_SPIN(xb_ld(&bar[XB_TOPGEN]) == tg, bar);
            __builtin_amdgcn_fence(__ATOMIC_ACQUIRE, "agent");
            xb_add(&bar[XB_XGEN(b.x)], 1u);
            asm volatile("s_waitcnt vmcnt(0)" ::: "memory");
        } else {
            XB_SPIN(xb_ld(&bar[XB_XGEN(b.x)]) == gen, bar);
            __builtin_amdgcn_fence(__ATOMIC_ACQUIRE, "agent");
            asm volatile("s_waitcnt vmcnt(0)" ::: "memory");
        }
    }
    __syncthreads();
}

__device__ __forceinline__ const float* res_in0(KArgs a, int b, int p) {
    return (p < CTXL) ? a->in[2] + ((size_t)b * CTXL + p) * DM : a->in[0] + ((size_t)b * SEQ + (p - CTXL)) * DM;
}
__device__ __forceinline__ bf16_t* res_bf(KArgs a, int b, int p) {
    return (p < CTXL) ? (bf16_t*)(a->ws + WS_XC) + ((size_t)b * CTXL + p) * DM : (bf16_t*)(a->out + ((size_t)b * SEQ + (p - CTXL)) * DM);
}
__device__ __forceinline__ const float* mod_ptr(KArgs a, int layer, int b, bool isctx, int seg) {
    return (const float*)(a->ws + WS_MOD) + ((size_t)layer * 17 + (isctx ? 16 : b)) * (6 * DM) + (size_t)seg * DM;
}

template <bool F8>
__device__ __forceinline__ void transpose_item(const float* W, int K, int N, void* WTv, int rowmode, const float* kscale, LAS float* scr, int item, int lane) {
    const int nblk = N / 32, g = item >> 3, kbh = g / nblk, nb = g - kbh * nblk, kb = kbh * 8 + (item & 7), k0 = 64 * kb, n0 = 32 * nb;
    const int kq = lane >> 3, nq = (lane & 7) * 4;
    f32x4 v[8];
#pragma unroll
    for (int i = 0; i < 8; ++i) v[i] = *(const GAS f32x4*)((const GAS float*)W + (size_t)(k0 + 8 * i + kq) * N + n0 + nq);
#pragma unroll
    for (int i = 0; i < 8; ++i) { const int kk = 8 * i + kq; const int k = k0 + kk;
        if (kscale != nullptr && k >= 1024) v[i] *= kscale[(k - 1024) & 255] * ONE_M_LI;
        LAS float* d = scr + kk * 33 + nq; d[0] = v[i][0]; d[1] = v[i][1]; d[2] = v[i][2]; d[3] = v[i][3]; }
    LDS_WAIT(); asm volatile("" ::: "memory");
    const int c = lane & 7;
#pragma unroll
    for (int j = 0; j < 4; ++j) { const int n = (lane >> 3) + 8 * j; const LAS float* s = scr + (8 * c) * 33 + n;
        const int ng = n0 + n; const int dest = (rowmode == 0) ? ng : ((ng >> 7) * 256 + (ng & 127) + (rowmode == 2 ? 128 : 0));
        if constexpr (F8) { u32x2 o; o.x = cvt4_fp8(s[0 * 33] * W8SCALE, s[1 * 33] * W8SCALE, s[2 * 33] * W8SCALE, s[3 * 33] * W8SCALE); o.y = cvt4_fp8(s[4 * 33] * W8SCALE, s[5 * 33] * W8SCALE, s[6 * 33] * W8SCALE, s[7 * 33] * W8SCALE);
            *(GAS u32x2*)((GAS unsigned char*)WTv + (size_t)dest * K + k0 + 8 * c) = o; }
        else { u32x4 o; o.x = cvt_pk_bf16(s[0 * 33], s[1 * 33]); o.y = cvt_pk_bf16(s[2 * 33], s[3 * 33]); o.z = cvt_pk_bf16(s[4 * 33], s[5 * 33]); o.w = cvt_pk_bf16(s[6 * 33], s[7 * 33]);
            *(u32x4*)((bf16_t*)WTv + (size_t)dest * K + k0 + 8 * c) = o; } }
    LDS_WAIT(); asm volatile("" ::: "memory");
}
struct TrItem { const float* W; unsigned char* WT; const float* ks; int K, N, rowmode, k0, n0; };
__device__ __forceinline__ void tr_set(TrItem& t, const float* W, int K, int N, unsigned char* WT, int rowmode, const float* ks, int item) {
    const int nblk = N / 32, g = item >> 3, kbh = g / nblk, nb = g - kbh * nblk, kb = kbh * 8 + (item & 7);
    t.W = W; t.WT = WT; t.ks = ks; t.K = K; t.N = N; t.rowmode = rowmode; t.k0 = 64 * kb; t.n0 = 32 * nb;
}
__device__ __forceinline__ void tr_load(const TrItem& t, int lane, f32x4* v) {
    const int kq = lane >> 3, nq = (lane & 7) * 4;
#pragma unroll
    for (int i = 0; i < 8; ++i) v[i] = *(const GAS f32x4*)((const GAS float*)t.W + (size_t)(t.k0 + 8 * i + kq) * t.N + t.n0 + nq);
}
__device__ __forceinline__ void tr_stage(const TrItem& t, int lane, f32x4* v, LAS float* scr) {
    const int kq = lane >> 3, nq = (lane & 7) * 4;
#pragma unroll
    for (int i = 0; i < 8; ++i) { const int kk = 8 * i + kq; const int k = t.k0 + kk;
        if (t.ks != nullptr && k >= 1024) v[i] *= t.ks[(k - 1024) & 255] * ONE_M_LI;
        LAS float* d = scr + kk * 33 + nq; d[0] = v[i][0]; d[1] = v[i][1]; d[2] = v[i][2]; d[3] = v[i][3]; }
    LDS_WAIT(); asm volatile("" ::: "memory");
}
__device__ __forceinline__ void tr_store(const TrItem& t, int lane, const LAS float* scr) {
    const int c = lane & 7;
#pragma unroll
    for (int j = 0; j < 4; ++j) { const int n = (lane >> 3) + 8 * j; const LAS float* s = scr + (8 * c) * 33 + n;
        const int ng = t.n0 + n; const int dest = (t.rowmode == 0) ? ng : ((ng >> 7) * 256 + (ng & 127) + (t.rowmode == 2 ? 128 : 0));
        u32x2 o; o.x = cvt4_fp8(s[0 * 33] * W8SCALE, s[1 * 33] * W8SCALE, s[2 * 33] * W8SCALE, s[3 * 33] * W8SCALE); o.y = cvt4_fp8(s[4 * 33] * W8SCALE, s[5 * 33] * W8SCALE, s[6 * 33] * W8SCALE, s[7 * 33] * W8SCALE);
        *(GAS u32x2*)((GAS unsigned char*)t.WT + (size_t)dest * t.K + t.k0 + 8 * c) = o; }
    LDS_WAIT(); asm volatile("" ::: "memory");
}
template <int DEPTH, class Dec>
__device__ __forceinline__ void tr_pipeline(Dec decode, int e0, int estep, int etot, int lane, LAS float* scr) {
    f32x4 v[DEPTH][8]; TrItem t[DEPTH];
#pragma unroll
    for (int i = 0; i < DEPTH; ++i) if (e0 + i * estep < etot) { decode(e0 + i * estep, t[i]); tr_load(t[i], lane, v[i]); }
    for (int e = e0; e < etot; e += DEPTH * estep) {
#pragma unroll
        for (int i = 0; i < DEPTH; ++i) {
            if (e + i * estep < etot) { tr_stage(t[i], lane, v[i], scr); const TrItem tc = t[i];
                if (e + (i + DEPTH) * estep < etot) { decode(e + (i + DEPTH) * estep, t[i]); tr_load(t[i], lane, v[i]); }
                tr_store(tc, lane, scr); } }
    }
}
#if MK_MULTI
constexpr int DEF_DOWN = 0, DEF_UP = 0, DEF_GATE = 0, DEF_S1 = 0, DEF_S2 = 0, DEF_S3 = 0;
#else
constexpr int DEF_DOWN = 16384, DEF_UP = 16384, DEF_GATE = 16384, DEF_S1 = 17920, DEF_S2 = 28160, DEF_S3 = 42496;
#endif
constexpr int DEF_TOTAL = DEF_DOWN + DEF_UP + DEF_GATE;
__device__ __forceinline__ void deferred_items(KArgs a, LAS unsigned char* lds, int slot, int c, int ntot, int G, int wave, int lane) {
    const int rem = ntot % G; const int rank = rem ? c - rem : c, nidle = rem ? G - rem : G;
    if (rank < 0) return;
    const int lo = slot == 0 ? 0 : slot == 1 ? DEF_S1 : slot == 2 ? DEF_S2 : DEF_S3, hi = slot == 0 ? DEF_S1 : slot == 1 ? DEF_S2 : slot == 2 ? DEF_S3 : DEF_TOTAL;
    __syncthreads();
    LAS float* scr = (LAS float*)(lds + wave * 16384);
    auto decode = [&](int d, TrItem& t) {
        if (d < DEF_DOWN) { const int r = 16384 + d; const int le = r >> 10, ri = r & 1023; tr_set(t, a->in[27] + (size_t)le * FF * DM, FF, DM, (unsigned char*)(a->ws + WS_WD) + (size_t)le * DM * FF, 0, nullptr, ri); }
        else if (d < DEF_DOWN + DEF_UP) { const int r = 16384 + (d - DEF_DOWN); const int le = r >> 10, ri = r & 1023; tr_set(t, a->in[26] + (size_t)le * DM * FF, DM, FF, (unsigned char*)(a->ws + WS_WGU) + (size_t)le * DM * DM, 2, nullptr, ri); }
        else { const int r = 16384 + (d - DEF_DOWN - DEF_UP); const int le = r >> 10, ri = r & 1023; tr_set(t, a->in[25] + (size_t)le * DM * FF, DM, FF, (unsigned char*)(a->ws + WS_WGU) + (size_t)le * DM * DM, 1, nullptr, ri); }
    };
    tr_pipeline<2>(decode, lo + rank * 8 + wave, nidle * 8, hi, lane, scr);
    __syncthreads();
}
constexpr int CONV0_TOTAL = 2048 + 3 * 16384;
__device__ __forceinline__ void conv_layer0_burst(KArgs a, LAS unsigned char* lds, int c, int G, int wave, int lane) {
    __syncthreads();
    LAS float* scr = (LAS float*)(lds + wave * 16384);
    auto decode = [&](int e, TrItem& t) {
        if (e < 2048) tr_set(t, a->in[11], DM, DM, (unsigned char*)(a->ws + WS_WOUT), 0, nullptr, e);
        else { const int x = e - 2048, kind = x >> 14, r = x & 16383, le = r >> 10, ri = r & 1023;
            if (kind == 0) tr_set(t, a->in[25] + (size_t)le * DM * FF, DM, FF, (unsigned char*)(a->ws + WS_WGU) + (size_t)le * DM * DM, 1, nullptr, ri);
            else if (kind == 1) tr_set(t, a->in[26] + (size_t)le * DM * FF, DM, FF, (unsigned char*)(a->ws + WS_WGU) + (size_t)le * DM * DM, 2, nullptr, ri);
            else tr_set(t, a->in[27] + (size_t)le * FF * DM, FF, DM, (unsigned char*)(a->ws + WS_WD) + (size_t)le * DM * FF, 0, nullptr, ri); }
    };
    tr_pipeline<4>(decode, c * 8 + wave, G * 8, CONV0_TOTAL, lane, scr);
    __syncthreads();
}
__device__ __forceinline__ void phase_prologue(KArgs a, LAS unsigned char* lds, int tid, int lane, int wave, int G) {
    const int bx = blockIdx.x;
    if (bx < 192) {
        const int l = bx / 96, jg = bx - l * 96;
        LAS float* S = (LAS float*)lds;
        for (int idx = tid; idx < 17 * DM; idx += 512) { const int r = idx >> 11, k = idx & 2047; const float v = (r < 16) ? a->in[1][r * DM + k] : a->in[3][k]; S[idx] = v / (1.0f + __expf(-v)); }
        __syncthreads();
        const int c2 = tid & 63, kp = wave;
        const float* wbase = a->in[4] + (size_t)l * DM * (6 * DM) + jg * 128 + 2 * c2;
        float acc0[17], acc1[17];
#pragma unroll
        for (int r = 0; r < 17; ++r) { acc0[r] = 0.f; acc1[r] = 0.f; }
        f32x2 wn[16];
#pragma unroll
        for (int q = 0; q < 16; ++q) wn[q] = *(const GAS f32x2*)((const GAS float*)wbase + (size_t)(kp * 256 + q) * (6 * DM));
        for (int k16 = 0; k16 < 16; ++k16) {
            const int k = kp * 256 + k16 * 16;
            f32x2 w[16];
#pragma unroll
            for (int q = 0; q < 16; ++q) w[q] = wn[q];
            if (k16 < 15) {
#pragma unroll
                for (int q = 0; q < 16; ++q) wn[q] = *(const GAS f32x2*)((const GAS float*)wbase + (size_t)(k + 16 + q) * (6 * DM)); }
#pragma unroll
            for (int r = 0; r < 17; ++r) {
#pragma unroll
                for (int g = 0; g < 4; ++g) { const f32x4 s4 = *(const LAS f32x4*)(S + r * DM + k + 4 * g);
#pragma unroll
                    for (int q = 0; q < 4; ++q) { acc0[r] += s4[q] * w[4 * g + q].x; acc1[r] += s4[q] * w[4 * g + q].y; } }
                __builtin_amdgcn_sched_barrier(0); }
        }
        __syncthreads();
        LAS float* P = (LAS float*)lds;
#pragma unroll
        for (int r = 0; r < 17; ++r) { P[(kp * 17 + r) * 128 + 2 * c2] = acc0[r]; P[(kp * 17 + r) * 128 + 2 * c2 + 1] = acc1[r]; }
        __syncthreads();
        float* MOD = (float*)(a->ws + WS_MOD);
        for (int idx = tid; idx < 17 * 128; idx += 512) { const int r = idx >> 7, cc = idx & 127; float s = 0.f;
#pragma unroll
            for (int q = 0; q < 8; ++q) s += P[(q * 17 + r) * 128 + cc];
            const int col = jg * 128 + cc; MOD[((size_t)l * 17 + r) * (6 * DM) + col] = s + a->in[5][l * (6 * DM) + col]; }
        VM_WAIT(); __syncthreads();
        if (bx < 32 && tid == 0) { __builtin_amdgcn_fence(__ATOMIC_RELEASE, "agent"); (void)xb_add((unsigned*)(a->ws + WS_CTL) + CW_MODF, 1u); }
    }
    {
        float* CS = (float*)(a->ws + WS_CS);
        for (int idx = bx * 512 + tid; idx < SEQ * 64; idx += G * 512) { const int t = idx >> 6, p = idx & 63; const int i = p & 31;
            const float inv = powf(10000.0f, -(float)i / 32.0f); const float pos = (p < 32) ? (float)(t / GRIDW) : (float)(t % GRIDW); const float ang = pos * inv;
            CS[2 * idx] = cosf(ang); CS[2 * idx + 1] = sinf(ang); }
    }
    {
        LAS float* scr = (LAS float*)(lds + wave * 16384);
        const int gwv = bx * 8 + wave, NGW = G * 8;
        constexpr int I_IN = 32 * 144, I_OUT = 32 * 64, I_E = 1024;
        constexpr int NITEMS = 2 * I_IN + 2 * I_OUT + 3 * 32 * I_E;
        bf16_t* WIN = (bf16_t*)(a->ws + WS_WIN); bf16_t* WOUT = (bf16_t*)(a->ws + WS_WOUT); bf16_t* WGU = (bf16_t*)(a->ws + WS_WGU); bf16_t* WD = (bf16_t*)(a->ws + WS_WD);
        constexpr int CUTG = 2 * I_IN + 2 * I_OUT + 16 * I_E, CUTU = 2 * I_IN + 2 * I_OUT + 32 * I_E + 16 * I_E, NKEEP = 2 * I_IN + I_OUT;     (void)CUTG; (void)CUTU;
        const int nfw = (G > 192) ? (G - 192) * 8 : 0, HEAD = nfw * 16;
        for (int k = (bx >= 192 ? 0 : 16); ; ++k) { const int n = k < 16 ? (bx - 192) * 8 + wave + nfw * k : HEAD + gwv + NGW * (k - 16); if (n >= NKEEP) break;
            const int it = n < 2 * I_IN ? n : n + I_OUT;
            int r = it;
            if (r < I_IN) { transpose_item<true>(a->in[10], DM, NQKV, (unsigned char*)WIN, 0, nullptr, scr, r, lane); continue; } r -= I_IN;
            if (r < I_IN) { transpose_item<true>(a->in[14], DM, NQKV, (unsigned char*)WIN + (size_t)NQKV * DM, 0, nullptr, scr, r, lane); continue; } r -= I_IN;
            if (r < I_OUT) { transpose_item<true>(a->in[11], DM, DM, (unsigned char*)WOUT, 0, nullptr, scr, r, lane); continue; } r -= I_OUT;
            if (r < I_OUT) { transpose_item<true>(a->in[15], DM, DM, (unsigned char*)WOUT + (size_t)DM * DM, 0, a->in[22], scr, r, lane); continue; } r -= I_OUT;
            if (r < 32 * I_E) { const int le = r >> 10, ri = r & 1023; transpose_item<true>(a->in[25] + (size_t)le * DM * FF, DM, FF, (unsigned char*)WGU + (size_t)le * DM * DM, 1, nullptr, scr, ri, lane); continue; } r -= 32 * I_E;
            if (r < 32 * I_E) { const int le = r >> 10, ri = r & 1023; transpose_item<true>(a->in[26] + (size_t)le * DM * FF, DM, FF, (unsigned char*)WGU + (size_t)le * DM * DM, 2, nullptr, scr, ri, lane); continue; } r -= 32 * I_E;
            { const int le = r >> 10, ri = r & 1023; transpose_item<true>(a->in[27] + (size_t)le * FF * DM, FF, DM, (unsigned char*)WD + (size_t)le * DM * FF, 0, nullptr, scr, ri, lane); }
        }
    }
}

__device__ __forceinline__ void phase_h0(KArgs a, LAS unsigned char* lds, int tid, int lane, int wave) {
    unsigned char* H = (unsigned char*)(a->ws + WS_H);
    const int bx = blockIdx.x, b = bx >> 4; LAS float* L = (LAS float*)lds;
    __syncthreads();
    if (tid == 0) { unsigned* f = (unsigned*)(a->ws + WS_CTL) + CW_MODF; unsigned sp = 0u; while (xb_ld(f) < 32u) { __builtin_amdgcn_s_sleep(1); if (++sp > (1u << 22)) break; } __builtin_amdgcn_fence(__ATOMIC_ACQUIRE, "agent"); }
    __syncthreads();
    for (int k = tid; k < DM; k += 512) { L[k] = mod_ptr(a, 0, b, false, 1)[k] + 1.0f; L[DM + k] = mod_ptr(a, 0, b, false, 0)[k]; L[2 * DM + k] = mod_ptr(a, 0, b, true, 1)[k] + 1.0f; L[3 * DM + k] = mod_ptr(a, 0, b, true, 0)[k]; }
    __syncthreads();
    const unsigned l16 = lane * 16, l4 = lane * 4;
    for (int i0 = wave; i0 < 144; i0 += 24) {
        f32x4 xv[3][8];
#pragma unroll
        for (int q = 0; q < 3; ++q) { const int row = bx * 144 + i0 + 8 * q, p = row - b * PB; const float* x = res_in0(a, b, p); asm volatile("" : "+s"(x));
#pragma unroll
            for (int j = 0; j < 8; ++j) xv[q][j] = *(const GAS f32x4*)((const GAS char*)x + l16 + j * 1024); }
#pragma unroll
        for (int q = 0; q < 3; ++q) { const int row = bx * 144 + i0 + 8 * q, p = row - b * PB; const bool isctx = p < CTXL;
            unsigned char* hp = H + (size_t)row * DM; asm volatile("" : "+s"(hp));
            const LAS unsigned char* V = lds + (isctx ? 2 * DM * 4 : 0);
#pragma unroll
            for (int j = 0; j < 8; ++j) { const f32x4 s1 = *(const LAS f32x4*)(V + l16 + j * 1024), s0 = *(const LAS f32x4*)(V + DM * 4 + l16 + j * 1024);
                const f32x4 h = xv[q][j] * s1 + s0; *(GAS unsigned*)((GAS unsigned char*)hp + l4 + j * 256) = cvt4_fp8(h[0], h[1], h[2], h[3]); } }
    }
    __syncthreads();
}

__device__ __forceinline__ void phase_prep(KArgs a, int lane, int gwv, int ngw) {
    const bf16_t* RAW = (const bf16_t*)(a->ws + WS_QKV); const float* CS = (const float*)(a->ws + WS_CS); unsigned char* K8 = (unsigned char*)(a->ws + WS_K8);
    const f32x2 gk = *(const f32x2*)(a->in[17] + 2 * lane);
    for (int row0 = gwv; row0 < MROWS; row0 += 3 * ngw) {
        unsigned w[3][2]; f32x2 cs[3];
#pragma unroll
        for (int q = 0; q < 3; ++q) { const int row = row0 + q * ngw; if (row >= MROWS) continue; const int b = row / PB, p = row - b * PB; const bool isctx = p < CTXL;
            cs[q] = (f32x2){1.f, 0.f}; if (!isctx) cs[q] = *(const f32x2*)(CS + ((size_t)(p - CTXL) * 64 + lane) * 2);
            w[q][0] = *((const unsigned*)(RAW + (size_t)row * 1280 + 8 * HD) + lane); w[q][1] = *((const unsigned*)(RAW + (size_t)row * 1280 + 9 * HD) + lane); }
#pragma unroll
        for (int q = 0; q < 3; ++q) { const int row = row0 + q * ngw; if (row >= MROWS) continue;
#pragma unroll
            for (int h = 0; h < 2; ++h) {
                const float x0 = bf_lo(w[q][h]), x1 = bf_hi(w[q][h]); const float ss = wave_sum(x0 * x0 + x1 * x1);
                const float rstd = 1.0f / sqrtf(ss * (1.0f / 128.0f) + 1e-6f);
                const float y0 = x0 * rstd * gk.x, y1 = x1 * rstd * gk.y;
                const float r0 = y0 * cs[q].x - y1 * cs[q].y, r1 = y0 * cs[q].y + y1 * cs[q].x;
                *((unsigned short*)(K8 + (size_t)row * 1280 + h * HD) + lane) = (unsigned short)__builtin_amdgcn_cvt_pk_fp8_f32(r0, r1, 0, false);
            } }
    }
}

__device__ __forceinline__ void phase_combine(KArgs a, int lane, int gwv, int ngw) {
    const bf16_t* OD = (const bf16_t*)(a->ws + WS_H); unsigned char* O = (unsigned char*)(a->ws + WS_O);
    float lam;
    { const f32x2 q1 = *(const f32x2*)(a->in[18] + 2 * lane), k1 = *(const f32x2*)(a->in[19] + 2 * lane), q2 = *(const f32x2*)(a->in[20] + 2 * lane), k2 = *(const f32x2*)(a->in[21] + 2 * lane);
      const float d1 = wave_sum(q1.x * k1.x + q1.y * k1.y), d2 = wave_sum(q2.x * k2.x + q2.y * k2.y); lam = expf(d1) - expf(d2) + LAMBDA_INIT1; }
    for (int lr = gwv; lr < NB * SEQ; lr += ngw) {
        const int b = lr / SEQ, t = lr - b * SEQ; const int row = b * PB + CTXL + t;
        u32x2 w0[4], w1[4];
#pragma unroll
        for (int h = 0; h < 4; ++h) { w0[h] = *(const u32x2*)(OD + (size_t)row * 1024 + h * 256 + 4 * lane); w1[h] = *(const u32x2*)(OD + (size_t)MROWS * 1024 + (size_t)row * 1024 + h * 256 + 4 * lane); }
#pragma unroll
        for (int h = 0; h < 4; ++h) {
            const float d0 = bf_lo(w0[h].x) - lam * bf_lo(w1[h].x), d1 = bf_hi(w0[h].x) - lam * bf_hi(w1[h].x), d2 = bf_lo(w0[h].y) - lam * bf_lo(w1[h].y), d3 = bf_hi(w0[h].y) - lam * bf_hi(w1[h].y);
            const float ss = wave_sum(d0 * d0 + d1 * d1 + d2 * d2 + d3 * d3); const float rstd = 1.0f / sqrtf(ss * (1.0f / 256.0f) + 1e-6f);
            const float rs = rstd * att_OSCALE;
            *(unsigned*)(O + (size_t)row * DM + 1024 + h * 256 + 4 * lane) = cvt4_fp8(d0 * rs, d1 * rs, d2 * rs, d3 * rs);
        }
    }
}
#define UNI(p) asm volatile("" : "+s"(p))
#define LD4F(p, j) (*(const GAS f32x4*)((const GAS char*)(p) + l16 + (j) * 1024))
#define LD4H(p, j) (*(const GAS u32x2*)((const GAS char*)(p) + l8 + (j) * 512))
#define LD4B(p, j) (*(const GAS unsigned*)((const GAS char*)(p) + l4 + (j) * 256))
__device__ __forceinline__ int ln_row(int layer, int n) { return layer == 0 ? n : (n >> 11) * PB + CTXL + (n & 2047); }
__device__ __forceinline__ void phase_ln1(KArgs a, int layer, LAS unsigned char* lds, int tid, int lane, int gwv, int ngw, bool dry = false) {
    LAS float* WT = (LAS float*)lds;
    for (int k = tid; k < DM; k += 512) { const f32x4* wr = (const f32x4*)(a->in[23] + (size_t)k * 16);
#pragma unroll
        for (int c = 0; c < 4; ++c) { const f32x4 w = wr[c]; WT[(4 * c + 0) * DM + k] = w[0]; WT[(4 * c + 1) * DM + k] = w[1]; WT[(4 * c + 2) * DM + k] = w[2]; WT[(4 * c + 3) * DM + k] = w[3]; } }
    const int wg_ = gwv >> 3; const bool stc = (layer == 0) && ((wg_ & 15) < 2); const int sb_ = wg_ >> 4;
    LAS float* A2 = (LAS float*)(lds + RING_BYTES); LAS float* B2 = A2 + DM; LAS bf16_t* G1h = (LAS bf16_t*)(lds + RING_BYTES + 16384); LAS bf16_t* LGh = G1h + DM; LAS bf16_t* LBh = LGh + DM;
    for (int k = tid; k < DM; k += 512) { const float lg = a->in[6][layer * DM + k], lb = a->in[7][layer * DM + k], s2 = mod_ptr(a, layer, sb_, stc, 4)[k] + 1.0f, sh = mod_ptr(a, layer, sb_, stc, 3)[k];
        A2[k] = lg * s2; B2[k] = lb * s2 + sh; const unsigned w = cvt_pk_bf16(mod_ptr(a, layer, sb_, stc, 2)[k], lg); G1h[k] = (bf16_t)(w & 0xffffu); LGh[k] = (bf16_t)(w >> 16); LBh[k] = (bf16_t)(cvt_pk_bf16(lb, lb) & 0xffffu); }
    LAS unsigned* lcnt = (LAS unsigned*)(lds + RING_BYTES + 16384 + 12288); LAS unsigned* nent = lcnt + 16; LAS unsigned* gbase = lcnt + 32; LAS unsigned* ent = lcnt + 64;
    if (tid < 17) lcnt[tid] = 0u;
    __syncthreads();
    const unsigned l16 = lane * 16, l8 = lane * 8, l4 = lane * 4;
    float* GW = (float*)(a->ws + WS_GW); int* LIST = (int*)(a->ws + WS_LIST); int* PPOS = (int*)(a->ws + WS_PPOS); unsigned* CNT = (unsigned*)(a->ws + WS_CTL) + CW_CNT + layer * 16 * 64;
    const int NV = layer == 0 ? MROWS : NB * SEQ;
    const int my_e = (lane >> 1) & 15, my_g = my_e >> 2, my_i = my_e & 3;
    const float my_rb = a->in[24][my_e];
    const int npw = NV / 2 / (ngw >> 3), wv = gwv & 7, pr0 = (gwv >> 3) * npw;
    for (int pi = wv; pi < npw; pi += 8) { const int pr = pr0 + pi;
        f32x4 v[2][8]; int rows[2];
        const int row0 = ln_row(layer, 2 * pr); rows[0] = row0; rows[1] = row0 + 1;
        const int b = row0 / PB, p = row0 - b * PB; const bool isctx = p < CTXL;
        const float* g1 = mod_ptr(a, layer, b, isctx, 2); const float* sh2 = mod_ptr(a, layer, b, isctx, 3); const float* sc2 = mod_ptr(a, layer, b, isctx, 4);
        const float* lng = a->in[6] + layer * DM; const float* lnb = a->in[7] + layer * DM; UNI(lng); UNI(lnb);
        const float* x0 = res_in0(a, b, p); const float* x1p = res_in0(a, b, p + 1); bf16_t* xb0 = res_bf(a, b, p); bf16_t* xb1 = res_bf(a, b, p + 1);
        const unsigned char* y0 = (const unsigned char*)(a->ws + WS_QKV) + (size_t)row0 * DM; const unsigned char* y1 = y0 + DM;
        unsigned char* h80 = (unsigned char*)(a->ws + WS_H) + (size_t)row0 * DM; unsigned char* h81 = h80 + DM;
        bf16_t* xo0 = xb0; bf16_t* xo1 = xb1;
        if (dry) { xo0 = (bf16_t*)(a->ws + WS_QN) + (size_t)row0 * DM; xo1 = xo0 + DM; h80 = (unsigned char*)(a->ws + WS_QN + 160 * MiB) + (size_t)row0 * DM; h81 = h80 + DM; }
        UNI(g1); UNI(sh2); UNI(sc2); UNI(x0); UNI(x1p); UNI(xb0); UNI(xb1); UNI(y0); UNI(y1); UNI(h80); UNI(h81); UNI(xo0); UNI(xo1);
        float s0 = 0.f, s1 = 0.f;
        const bool fast = (isctx == stc);
#pragma unroll
        for (int j = 0; j < 8; ++j) { f32x4 gv; if (fast) { const u32x2 gw_ = *(const LAS u32x2*)((const LAS unsigned char*)G1h + l8 + j * 512); gv[0] = bf_lo(gw_.x); gv[1] = bf_hi(gw_.x); gv[2] = bf_lo(gw_.y); gv[3] = bf_hi(gw_.y); } else gv = LD4F(g1, j);
#pragma unroll
            for (int q = 0; q < 2; ++q) { f32x4 xv; if (layer == 0) xv = LD4F(q ? x1p : x0, j); else { const u32x2 xw = LD4H(q ? xb1 : xb0, j); xv[0] = bf_lo(xw.x); xv[1] = bf_hi(xw.x); xv[2] = bf_lo(xw.y); xv[3] = bf_hi(xw.y); }
                const f32x4 yv = fp8x4_to_f32(LD4B(q ? y1 : y0, j)) * (1.0f / Y8SCALE);
                v[q][j] = xv * ALPHA + gv * yv; const float ss = (v[q][j][0] + v[q][j][1]) + (v[q][j][2] + v[q][j][3]); if (q) s1 += ss; else s0 += ss; } }
        const float mean0 = wave_sum(s0) * (1.0f / DM), mean1 = wave_sum(s1) * (1.0f / DM); float q0 = 0.f, q1 = 0.f;
#pragma unroll
        for (int j = 0; j < 8; ++j) { v[0][j] = v[0][j] - mean0; q0 += (v[0][j][0] * v[0][j][0] + v[0][j][1] * v[0][j][1]) + (v[0][j][2] * v[0][j][2] + v[0][j][3] * v[0][j][3]);
            v[1][j] = v[1][j] - mean1; q1 += (v[1][j][0] * v[1][j][0] + v[1][j][1] * v[1][j][1]) + (v[1][j][2] * v[1][j][2] + v[1][j][3] * v[1][j][3]); }
        const float rstd0 = 1.0f / sqrtf(wave_sum(q0) * (1.0f / DM) + 1e-5f), rstd1 = 1.0f / sqrtf(wave_sum(q1) * (1.0f / DM) + 1e-5f);
#pragma unroll
        for (int j = 0; j < 8; ++j) { f32x4 lg4, lb4, a4, b4;
            if (fast) { const u32x2 gw_ = *(const LAS u32x2*)((const LAS unsigned char*)LGh + l8 + j * 512), bw_ = *(const LAS u32x2*)((const LAS unsigned char*)LBh + l8 + j * 512);
                lg4[0] = bf_lo(gw_.x); lg4[1] = bf_hi(gw_.x); lg4[2] = bf_lo(gw_.y); lg4[3] = bf_hi(gw_.y); lb4[0] = bf_lo(bw_.x); lb4[1] = bf_hi(bw_.x); lb4[2] = bf_lo(bw_.y); lb4[3] = bf_hi(bw_.y);
                a4 = *(const LAS f32x4*)((const LAS unsigned char*)A2 + l16 + j * 1024); b4 = *(const LAS f32x4*)((const LAS unsigned char*)B2 + l16 + j * 1024); }
            else { lg4 = LD4F(lng, j); lb4 = LD4F(lnb, j); const f32x4 s4 = LD4F(sc2, j) + 1.0f; a4 = lg4 * s4; b4 = lb4 * s4 + LD4F(sh2, j); }
#pragma unroll
            for (int q = 0; q < 2; ++q) { const f32x4 nn = v[q][j] * (q ? rstd1 : rstd0); const f32x4 x1 = nn * lg4 + lb4;
                { u32x2 w; w.x = cvt_pk_bf16(x1[0], x1[1]); w.y = cvt_pk_bf16(x1[2], x1[3]); *(GAS u32x2*)((GAS char*)(q ? xo1 : xo0) + l8 + j * 512) = w; }
                const f32x4 h2 = nn * a4 + b4; v[q][j] = h2;
                *(GAS unsigned*)((GAS unsigned char*)(q ? h81 : h80) + l4 + j * 256) = cvt4_fp8(h2[0], h2[1], h2[2], h2[3]); } }
        if (LN1_DRYVAR >= 1 && dry) continue;
        float t[32];
#pragma unroll
        for (int e = 0; e < 16; ++e) { float t0 = 0.f, t1 = 0.f;
#pragma unroll
            for (int j = 0; j < 8; ++j) { const f32x4 w4 = *(const LAS f32x4*)(WT + e * DM + 4 * lane + 256 * j);
                t0 += (v[0][j][0] * w4[0] + v[0][j][1] * w4[1]) + (v[0][j][2] * w4[2] + v[0][j][3] * w4[3]);
                t1 += (v[1][j][0] * w4[0] + v[1][j][1] * w4[1]) + (v[1][j][2] * w4[2] + v[1][j][3] * w4[3]); }
            t[e] = t0; t[16 + e] = t1; }
#define RSTEP(N, BIT, OFF) _Pragma("unroll") for (int i = 0; i < N; ++i) { const bool up = (lane & BIT) != 0; const float send = up ? t[i] : t[N + i], keep = up ? t[N + i] : t[i]; t[i] = keep + __shfl_xor(send, OFF); }
        RSTEP(16, 32, 32) RSTEP(8, 16, 16) RSTEP(4, 8, 8) RSTEP(2, 4, 4) RSTEP(1, 2, 2)
#undef RSTEP
        const float lg = t[0] + __shfl_xor(t[0], 1);
        const float sc = 1.0f / (1.0f + __expf(-lg)), bi = sc + my_rb;
        const float b1 = __shfl_xor(bi, 2), b2 = __shfl_xor(bi, 4), b3 = __shfl_xor(bi, 6);
        const float h1 = fmaxf(bi, b1), l1 = fminf(bi, b1), h2m = fmaxf(b2, b3), l2 = fminf(b2, b3);
        const float gs = fmaxf(h1, h2m) + fmaxf(fminf(h1, h2m), fmaxf(l1, l2));
        const int rank = ((b1 > bi) || (b1 == bi && (my_i ^ 1) < my_i)) + ((b2 > bi) || (b2 == bi && (my_i ^ 2) < my_i)) + ((b3 > bi) || (b3 == bi && (my_i ^ 3) < my_i));
        const float g1s = __shfl_xor(gs, 8), g2s = __shfl_xor(gs, 16), g3s = __shfl_xor(gs, 24);
        const bool best = !((g1s > gs) || (g1s == gs && (my_g ^ 1) < my_g)) && !((g2s > gs) || (g2s == gs && (my_g ^ 2) < my_g)) && !((g3s > gs) || (g3s == gs && (my_g ^ 3) < my_g));
        const float c = (rank < 2) ? sc : 0.f;
        const float csum = c + __shfl_xor(c, 2) + __shfl_xor(c, 4) + __shfl_xor(c, 6);
        if (best && rank < 2 && (lane & 1) == 0 && !dry) {
            const int row = (lane & 32) ? rows[1] : rows[0]; const int pair = 2 * row + rank;
            const unsigned lp = __hip_atomic_fetch_add(lcnt + my_e, 1u, __ATOMIC_RELAXED, __HIP_MEMORY_SCOPE_WORKGROUP);
            const unsigned slot = __hip_atomic_fetch_add(nent, 1u, __ATOMIC_RELAXED, __HIP_MEMORY_SCOPE_WORKGROUP);
            ent[slot] = (unsigned)pair | ((unsigned)my_e << 17) | (lp << 21);
            GW[pair] = sc / csum;
        }
    }
    __syncthreads();
    if (tid < 16) { const unsigned n = lcnt[tid]; gbase[tid] = n ? __hip_atomic_fetch_add(CNT + tid * 64, n, __ATOMIC_RELAXED, __HIP_MEMORY_SCOPE_AGENT) : 0u; }
    __syncthreads();
    { const unsigned ne = nent[0]; for (unsigned i = tid; i < ne; i += 512) { const unsigned w = ent[i]; const unsigned e = (w >> 17) & 15u; const unsigned pos = gbase[e] + (w >> 21); LIST[(size_t)e * LCAP + pos] = (int)(w & 0x1FFFFu); PPOS[w & 0x1FFFFu] = (int)((e << 20) | pos); } }
}

__device__ __forceinline__ void phase_ln2(KArgs a, int layer, LAS unsigned char* lds, int tid, int lane, int gwv, int ngw, bool dry = false) {
    const unsigned l16 = lane * 16, l8 = lane * 8, l4 = lane * 4;
    const int NV = layer == 0 ? MROWS : NB * SEQ;
    const int npw = NV / 2 / (ngw >> 3), wv = gwv & 7, wg = gwv >> 3, pr0 = wg * npw, b = wg >> 4;
    LAS float* L = (LAS float*)lds;
    for (int k = tid; k < DM; k += 512) { L[k] = a->in[8][layer * DM + k]; L[DM + k] = a->in[9][layer * DM + k];
        L[2 * DM + k] = mod_ptr(a, layer, b, false, 5)[k]; L[3 * DM + k] = mod_ptr(a, 1, b, false, 1)[k] + 1.0f; L[4 * DM + k] = mod_ptr(a, 1, b, false, 0)[k];
        L[5 * DM + k] = mod_ptr(a, layer, b, true, 5)[k]; L[6 * DM + k] = mod_ptr(a, 1, b, true, 1)[k] + 1.0f; L[7 * DM + k] = mod_ptr(a, 1, b, true, 0)[k]; }
    LAS int* TBE = (LAS int*)(lds + 8 * DM * 4);
    if (tid == 0) { int base = 0; for (int e = 0; e < 16; ++e) { TBE[e] = base * 256; base += ((int)__hip_atomic_load((unsigned*)(a->ws + WS_CTL) + CW_CNT + (layer * 16 + e) * 64, __ATOMIC_RELAXED, __HIP_MEMORY_SCOPE_AGENT) + 255) >> 8; } }
    __syncthreads();
#define LV(idx, j) (*(const LAS f32x4*)(lds + (idx) * (DM * 4) + l16 + (j) * 1024))
    for (int pi = wv; pi < npw; pi += 8) { const int pr = pr0 + pi;
        const int row0 = ln_row(layer, 2 * pr);
        const int p = row0 - b * PB; const bool isctx = p < CTXL; const int vo = isctx ? 3 : 0;
        bf16_t* xo0 = res_bf(a, b, p); bf16_t* xo1 = res_bf(a, b, p + 1);
        const u32x4 pp4 = *(const u32x4*)((const int*)(a->ws + WS_PPOS) + 2 * row0); const f32x4 gw4 = *(const f32x4*)((const float*)(a->ws + WS_GW) + 2 * row0) * (1.0f / Y8SCALE);
        const unsigned char* DNS = (const unsigned char*)(a->ws + WS_QKV);
        const int sl0 = __builtin_amdgcn_readfirstlane(TBE[pp4.x >> 20] + (int)(pp4.x & 0xFFFFFu)), sl1 = __builtin_amdgcn_readfirstlane(TBE[pp4.y >> 20] + (int)(pp4.y & 0xFFFFFu));
        const int sl2 = __builtin_amdgcn_readfirstlane(TBE[pp4.z >> 20] + (int)(pp4.z & 0xFFFFFu)), sl3 = __builtin_amdgcn_readfirstlane(TBE[pp4.w >> 20] + (int)(pp4.w & 0xFFFFFu));
        const unsigned char* dn0 = DNS + (size_t)sl0 * DM; const unsigned char* dn1 = DNS + (size_t)sl1 * DM; const unsigned char* dn2 = DNS + (size_t)sl2 * DM; const unsigned char* dn3 = DNS + (size_t)sl3 * DM;
        unsigned char* hp0 = (unsigned char*)(a->ws + WS_H) + (size_t)row0 * DM; unsigned char* hp1 = hp0 + DM;
        bf16_t* xw0 = xo0; bf16_t* xw1 = xo1;
        if (dry) { xw0 = (bf16_t*)(a->ws + WS_QN) + (size_t)row0 * 2 * DM; xw1 = xw0 + 2 * DM; hp0 = (unsigned char*)(a->ws + WS_H) + (size_t)MROWS * DM + (size_t)row0 * DM; hp1 = hp0 + DM; }
        UNI(xo0); UNI(xo1); UNI(hp0); UNI(hp1); UNI(xw0); UNI(xw1);
        f32x4 v[2][8]; float s0 = 0.f, s1 = 0.f;
#pragma unroll
        for (int j = 0; j < 8; ++j) { const f32x4 gv = LV(2 + vo, j);
#pragma unroll
            for (int q = 0; q < 2; ++q) { const u32x2 xw = LD4H(q ? xo1 : xo0, j); f32x4 xv; xv[0] = bf_lo(xw.x); xv[1] = bf_hi(xw.x); xv[2] = bf_lo(xw.y); xv[3] = bf_hi(xw.y);
                const f32x4 f = fp8x4_to_f32(LD4B(q ? dn2 : dn0, j)) * (q ? gw4[2] : gw4[0]) + fp8x4_to_f32(LD4B(q ? dn3 : dn1, j)) * (q ? gw4[3] : gw4[1]);
                v[q][j] = xv * ALPHA + gv * f; const float ss = (v[q][j][0] + v[q][j][1]) + (v[q][j][2] + v[q][j][3]); if (q) s1 += ss; else s0 += ss; } }
        const float mean0 = wave_sum(s0) * (1.0f / DM), mean1 = wave_sum(s1) * (1.0f / DM); float q0 = 0.f, q1 = 0.f;
#pragma unroll
        for (int j = 0; j < 8; ++j) { v[0][j] = v[0][j] - mean0; q0 += (v[0][j][0] * v[0][j][0] + v[0][j][1] * v[0][j][1]) + (v[0][j][2] * v[0][j][2] + v[0][j][3] * v[0][j][3]);
            v[1][j] = v[1][j] - mean1; q1 += (v[1][j][0] * v[1][j][0] + v[1][j][1] * v[1][j][1]) + (v[1][j][2] * v[1][j][2] + v[1][j][3] * v[1][j][3]); }
        const float rstd0 = 1.0f / sqrtf(wave_sum(q0) * (1.0f / DM) + 1e-5f), rstd1 = 1.0f / sqrtf(wave_sum(q1) * (1.0f / DM) + 1e-5f);
#pragma unroll
        for (int j = 0; j < 8; ++j) { const f32x4 lg4 = LV(0, j), lb4 = LV(1, j); f32x4 sc4 = lg4, sh4 = lb4; if (layer == 0) { sc4 = LV(3 + vo, j); sh4 = LV(4 + vo, j); }
#pragma unroll
            for (int q = 0; q < 2; ++q) { const f32x4 x2 = v[q][j] * (q ? rstd1 : rstd0) * lg4 + lb4;
                if (layer == 1) *(GAS f32x4*)((GAS char*)(q ? xw1 : xw0) + l16 + j * 1024) = x2;
                else { u32x2 w; w.x = cvt_pk_bf16(x2[0], x2[1]); w.y = cvt_pk_bf16(x2[2], x2[3]); *(GAS u32x2*)((GAS char*)(q ? xw1 : xw0) + l8 + j * 512) = w;
                    const f32x4 h = x2 * sc4 + sh4; *(GAS unsigned*)((GAS char*)(q ? hp1 : hp0) + l4 + j * 256) = cvt4_fp8(h[0], h[1], h[2], h[3]); } } }
    }
#undef LV
    __syncthreads();
}
#undef LD4F
#undef LD4H
#undef LD4B
#undef UNI

__device__ __forceinline__ float dot128(const LAS float* q, const bf16_t* kp) {
    float s = 0.f;
#pragma unroll
    for (int c = 0; c < 16; ++c) { const u32x4 kv = *(const u32x4*)(kp + 8 * c); const f32x4 qa = *(const LAS f32x4*)(q + 8 * c), qb = *(const LAS f32x4*)(q + 8 * c + 4);
        s += (qa[0] * bf_lo(kv.x) + qa[1] * bf_hi(kv.x)) + (qa[2] * bf_lo(kv.y) + qa[3] * bf_hi(kv.y)) + (qb[0] * bf_lo(kv.z) + qb[1] * bf_hi(kv.z)) + (qb[2] * bf_lo(kv.w) + qb[3] * bf_hi(kv.w)); }
    return s;
}
__device__ __forceinline__ int naive_local_row(int mode, int b, int idx, int lo, int r0, int c0) {
    if (mode == 0) return b * PB + CTXL + lo + idx;
    if (mode == 1) return b * PB + CTXL + (r0 + (idx >> 4)) * GRIDW + c0 + (idx & 15);
    return b * PB + CTXL + idx;
}
__device__ __forceinline__ void naive_attn_task(KArgs a, int layer, int task, LAS float* wl, int lane) {
    const bf16_t* QKV = (const bf16_t*)(a->ws + WS_QKV); const bf16_t* QN = (const bf16_t*)(a->ws + WS_QN); bf16_t* O = (bf16_t*)(a->ws + WS_O); bf16_t* OD = (bf16_t*)(a->ws + WS_H);
    constexpr int NL = NB * 8 * SEQ, NX = NB * 8 * CTXL;
    int mode, idx;
    if (layer == 0) { if (task < NL) { mode = 0; idx = task; } else if (task < 2 * NL) { mode = 1; idx = task - NL; } else if (task < 2 * NL + NX) { mode = 2; idx = task - 2 * NL; } else { mode = 3; idx = task - 2 * NL - NX; } }
    else { if (task < NL) { mode = 4; idx = task; } else { mode = 5; idx = task - NL; } }
    const bool ctxq = (mode == 2 || mode == 3); const int nq = ctxq ? CTXL : SEQ;
    const int qi = idx % nq, h = (idx / nq) & 7, b = idx / (nq * 8);
    const int qrow = b * PB + (ctxq ? qi : CTXL + qi);
    const bool bfam = (mode == 1 || mode == 3);
    const int qcol = (bfam || mode == 5) ? 1536 + h * HD : h * HD;
    const int kcol = bfam ? 2560 + h * HD : (mode == 5 ? 2560 + h * HD : 1024 + (h >> 2) * HD);
    const int vcol = bfam ? 3584 + h * HD : (mode == 5 ? 3584 + (h >> 1) * 256 : 1280 + (h >> 2) * HD);
    LAS float* sc = wl; LAS float* qr = wl + 2304; LAS float* qn = wl + 2304 + 128;
    { const unsigned w = *((const unsigned*)(QKV + (size_t)qrow * NQKV + qcol) + lane); qr[2 * lane] = bf_lo(w); qr[2 * lane + 1] = bf_hi(w);
      unsigned w2 = w;
      if (mode == 0 || mode == 4) w2 = *((const unsigned*)(QN + (size_t)qrow * DM + h * HD) + lane);
      if (mode == 5) w2 = *((const unsigned*)(QN + (size_t)qrow * DM + 1024 + h * HD) + lane);
      qn[2 * lane] = bf_lo(w2); qn[2 * lane + 1] = bf_hi(w2); }
    LDS_WAIT();
    int nloc = 0, lo = 0, r0 = 0, c0 = 0; const int rq = qi >> 6, cq = qi & 63;
    if (mode == 0) { lo = max(0, qi - 128); const int hi = min(SEQ - 1, qi + 128); nloc = hi - lo + 1; }
    else if (mode == 1) { r0 = min(max(rq - 4, 0), 24); c0 = min(max(cq - 8, 0), 48); nloc = 128; }
    else if (mode >= 4) nloc = SEQ;
    float mx = -1e30f;
    for (int j = lane; j < CTXL; j += 64) { const float s = dot128(qn, QKV + (size_t)(b * PB + j) * NQKV + kcol) * SM_SCALE; sc[j] = s; mx = fmaxf(mx, s); }
    for (int j = lane; j < nloc; j += 64) { const int kr = naive_local_row(mode, b, j, lo, r0, c0);
        float s = dot128(qr, QKV + (size_t)kr * NQKV + kcol) * SM_SCALE;
        if (mode == 1) { const int krr = r0 + (j >> 4), kcc = c0 + (j & 15); s += a->in[13][h * 465 + (krr - rq + 7) * 31 + (kcc - cq + 15)]; }
        sc[CTXL + j] = s; mx = fmaxf(mx, s); }
    mx = wave_max(mx);
    const bool sink = (mode == 0 || mode == 2); const float sk = sink ? a->in[12][h] : 0.f;
    if (sink) mx = fmaxf(mx, sk);
    float sum = 0.f; const int ntot = CTXL + nloc;
    for (int j = lane; j < ntot; j += 64) { const float pp = __expf(sc[j] - mx); sc[j] = pp; sum += pp; }
    sum = wave_sum(sum); if (sink) sum += __expf(sk - mx);
    LDS_WAIT();
    const float inv = 1.0f / sum;
    if (mode != 5) {
        float a0 = 0.f, a1 = 0.f;
        for (int j = 0; j < ntot; ++j) { const int kr = (j < CTXL) ? b * PB + j : naive_local_row(mode, b, j - CTXL, lo, r0, c0);
            const float pp = sc[j]; const unsigned w = *((const unsigned*)(QKV + (size_t)kr * NQKV + vcol) + lane); a0 += pp * bf_lo(w); a1 += pp * bf_hi(w); }
        const int ocol = bfam ? 1024 + h * HD : h * HD;
        *((unsigned*)(O + (size_t)qrow * DM + ocol) + lane) = cvt_pk_bf16(a0 * inv, a1 * inv);
    } else {
        float a0 = 0.f, a1 = 0.f, a2 = 0.f, a3 = 0.f;
        for (int j = 0; j < ntot; ++j) { const int kr = (j < CTXL) ? b * PB + j : b * PB + j;
            const float pp = sc[j]; const u32x2 w = *((const u32x2*)(QKV + (size_t)kr * NQKV + vcol) + lane); a0 += pp * bf_lo(w.x); a1 += pp * bf_hi(w.x); a2 += pp * bf_lo(w.y); a3 += pp * bf_hi(w.y); }
        u32x2 o; o.x = cvt_pk_bf16(a0 * inv, a1 * inv); o.y = cvt_pk_bf16(a2 * inv, a3 * inv);
        *((u32x2*)(OD + (size_t)(h & 1) * MROWS * 1024 + (size_t)qrow * 1024 + (h >> 1) * 256) + lane) = o;
    }
    LDS_WAIT();
}
__device__ __noinline__ void phase_attn_naive(KArgs a, int layer, LAS unsigned char* lds, int lane, int wave, int gwv, int ngw) {
    LAS float* wl = (LAS float*)(lds + wave * 10240);
    const int ntask = (layer == 0) ? 2 * NB * 8 * SEQ + 2 * NB * 8 * CTXL : 2 * NB * 8 * SEQ;
    for (int t = gwv; t < ntask; t += ngw) naive_attn_task(a, layer, t, wl, lane);
}
namespace att {
constexpr int LDK8 = 1280, LDV8 = 1280;
constexpr int SHM_V = 64 * 128 * 2, SHM_K = 64 * 128 * 2;
constexpr int OFF_V = 0, OFF_K = 2 * SHM_V, OFF_WS = 2 * SHM_V + 2 * SHM_K, OFF_BT = OFF_WS + 8 * 256, ATT_LDS = OFF_BT + 2048;
constexpr float THR = 6.f;
constexpr float NEGM = -1e30f;
constexpr float OSCALE = att_OSCALE;
using s16x4 = __attribute__((ext_vector_type(4))) short;
#define KSWZ(row, colB) ((row) * 256 + ((colB) ^ (((row) & 7) << 4)))
#define SBAR() __builtin_amdgcn_sched_barrier(0)
__device__ __forceinline__ int crow(int r, int hi) { return (r & 3) + 8 * (r >> 2) + 4 * hi; }

__device__ __forceinline__ void partialSM(f32x16& p0, f32x16& p1, float& m_reg, float& mn, float& alpha) {
  constexpr float C = SM_SCALE * 1.4426950408889634f;
  float pmax = p0[0];
#pragma unroll
  for (int r = 1; r < 16; ++r) pmax = fmaxf(pmax, p0[r]);
#pragma unroll
  for (int r = 0; r < 16; ++r) pmax = fmaxf(pmax, p1[r]);
  { auto rr = __builtin_amdgcn_permlane32_swap(__float_as_uint(pmax), __float_as_uint(pmax), false, false);
    pmax = fmaxf(__uint_as_float(rr[0]), __uint_as_float(rr[1])); }
  if (__builtin_expect(__all(pmax - m_reg <= THR / SM_SCALE), 1)) { mn = m_reg; alpha = 1.f; }
  else { mn = fmaxf(m_reg, pmax); alpha = __builtin_amdgcn_exp2f((m_reg - mn) * C); m_reg = mn; }
  const float mnC = -mn * C;
#pragma unroll
  for (int r = 0; r < 16; ++r) p0[r] = fmaf(p0[r], C, mnC);
#pragma unroll
  for (int r = 0; r < 16; ++r) p1[r] = fmaf(p1[r], C, mnC);
#pragma unroll
  for (int r = 0; r < 16; ++r) p0[r] = __builtin_amdgcn_exp2f(p0[r]);
}
__device__ __forceinline__ void finishSM(f32x16& p0, f32x16& p1, float alpha, float& l_reg, bf16x8& pa0, bf16x8& pa1, bf16x8& pa2, bf16x8& pa3) {
#pragma unroll
  for (int r = 0; r < 16; ++r) p1[r] = __builtin_amdgcn_exp2f(p1[r]);
  float ps = 0;
#pragma unroll
  for (int r = 0; r < 16; ++r) ps += p0[r];
#pragma unroll
  for (int r = 0; r < 16; ++r) ps += p1[r];
  { auto rr = __builtin_amdgcn_permlane32_swap(__float_as_uint(ps), __float_as_uint(ps), false, false);
    ps = __uint_as_float(rr[0]) + __uint_as_float(rr[1]); }
  l_reg = l_reg * alpha + ps;
#define PK4(P, BASE, OUT) do { unsigned a0 = cvt_pk_bf16(P[BASE + 0], P[BASE + 1]), a1 = cvt_pk_bf16(P[BASE + 2], P[BASE + 3]);   \
    unsigned b0 = cvt_pk_bf16(P[BASE + 4], P[BASE + 5]), b1 = cvt_pk_bf16(P[BASE + 6], P[BASE + 7]);                              \
    auto r0 = __builtin_amdgcn_permlane32_swap(a0, b0, false, false); auto r1 = __builtin_amdgcn_permlane32_swap(a1, b1, false, false); \
    u32x4 w = {r0[0], r1[0], r0[1], r1[1]}; OUT = __builtin_bit_cast(bf16x8, w); } while (0)
  PK4(p0, 0, pa0); PK4(p0, 8, pa1); PK4(p1, 0, pa2); PK4(p1, 8, pa3);
#undef PK4
}
__device__ __forceinline__ void qkt(f32x16& p0, f32x16& p1, const LAS unsigned char* Ks, const bf16x8* qr, int r32, int hi) {
  p0 = f32x16{}; p1 = f32x16{};
#pragma unroll
  for (int d0 = 0; d0 < 8; ++d0) { const int cb = (d0 * 16 + hi * 8) * 2;
    const bf16x8 b0 = *(const LAS bf16x8*)(Ks + KSWZ(r32, cb));
    const bf16x8 b1 = *(const LAS bf16x8*)(Ks + KSWZ(32 + r32, cb));
    p0 = __builtin_amdgcn_mfma_f32_32x32x16_bf16(b0, qr[d0], p0, 0, 0, 0);
    p1 = __builtin_amdgcn_mfma_f32_32x32x16_bf16(b1, qr[d0], p1, 0, 0, 0); }
}
typedef int v8i_t __attribute__((ext_vector_type(8)));
typedef int v4i_t __attribute__((ext_vector_type(4)));
#define K8SWZ(row, cb) ((row) * 128 + (((((cb) >> 4) ^ (((row) >> 1) & 7))) << 4) + ((cb) & 15))
__device__ __forceinline__ void qkt8(f32x16& p0, f32x16& p1, const LAS unsigned char* Ks, const v8i_t* qr8, int r32, int hi) {
  p0 = f32x16{}; p1 = f32x16{};
#pragma unroll
  for (int s = 0; s < 2; ++s) { const int cb = 64 * s + 32 * hi;
    const v8i_t a0 = __builtin_shufflevector(*(const LAS v4i_t*)(Ks + K8SWZ(r32, cb)), *(const LAS v4i_t*)(Ks + K8SWZ(r32, cb + 16)), 0, 1, 2, 3, 4, 5, 6, 7);
    const v8i_t a1 = __builtin_shufflevector(*(const LAS v4i_t*)(Ks + K8SWZ(32 + r32, cb)), *(const LAS v4i_t*)(Ks + K8SWZ(32 + r32, cb + 16)), 0, 1, 2, 3, 4, 5, 6, 7);
    p0 = __builtin_amdgcn_mfma_scale_f32_32x32x64_f8f6f4(a0, qr8[s], p0, 0, 0, 0, 0, 0, 0);
    p1 = __builtin_amdgcn_mfma_scale_f32_32x32x64_f8f6f4(a1, qr8[s], p1, 0, 0, 0, 0, 0, 0); }
}
__device__ __forceinline__ int v_st(int k, int c) { const int kk = (k & ~0xC) | ((k & 4) << 1) | ((k & 8) >> 1); return ((kk >> 3) * 4 + (c >> 5)) * 512 + ((kk & 7) * 32 + (c & 31)) * 2; }
__device__ __forceinline__ int v_rd_base(int lane) { return ((lane & 3) << 3) | (((lane >> 2) & 3) << 6) | (((lane >> 4) & 1) << 5) | (((lane >> 5) & 1) << 8); }
constexpr int v_rd_off(int d0, int ks, int half) { return d0 * 512 + ks * 4096 + half * 2048; }
template <int OFF> __device__ __forceinline__ s16x4 tr_read(int vb) {
  s16x4 r; asm volatile("ds_read_b64_tr_b16 %0, %1 offset:%2" : "=&v"(r) : "v"(vb), "i"(OFF) : "memory"); return r;
}
template <int D0> __device__ __forceinline__ void pv_one(f32x16& od, int vb, bf16x8 pa0, bf16x8 pa1, bf16x8 pa2, bf16x8 pa3) {
  const s16x4 l0 = tr_read<v_rd_off(D0, 0, 0)>(vb), h0 = tr_read<v_rd_off(D0, 0, 1)>(vb), l1 = tr_read<v_rd_off(D0, 1, 0)>(vb), h1 = tr_read<v_rd_off(D0, 1, 1)>(vb);
  const s16x4 l2 = tr_read<v_rd_off(D0, 2, 0)>(vb), h2 = tr_read<v_rd_off(D0, 2, 1)>(vb), l3 = tr_read<v_rd_off(D0, 3, 0)>(vb), h3 = tr_read<v_rd_off(D0, 3, 1)>(vb);
  asm volatile("s_waitcnt lgkmcnt(0)" ::: "memory"); SBAR();
#define PK(L, H) (bf16x8){L[0], L[1], L[2], L[3], H[0], H[1], H[2], H[3]}
  od = __builtin_amdgcn_mfma_f32_32x32x16_bf16(pa0, PK(l0, h0), od, 0, 0, 0);
  od = __builtin_amdgcn_mfma_f32_32x32x16_bf16(pa1, PK(l1, h1), od, 0, 0, 0);
  od = __builtin_amdgcn_mfma_f32_32x32x16_bf16(pa2, PK(l2, h2), od, 0, 0, 0);
  od = __builtin_amdgcn_mfma_f32_32x32x16_bf16(pa3, PK(l3, h3), od, 0, 0, 0);
#undef PK
}
__device__ __forceinline__ void pv_d0(f32x16* o, int vb, bf16x8 pa0, bf16x8 pa1, bf16x8 pa2, bf16x8 pa3) {
  pv_one<0>(o[0], vb, pa0, pa1, pa2, pa3); pv_one<1>(o[1], vb, pa0, pa1, pa2, pa3); pv_one<2>(o[2], vb, pa0, pa1, pa2, pa3); pv_one<3>(o[3], vb, pa0, pa1, pa2, pa3);
}


__device__ __forceinline__ void finishSM8(f32x16& p0, f32x16& p1, float alpha, float& l_reg, v8i_t& pa) {
#pragma unroll
  for (int r = 0; r < 16; ++r) p1[r] = __builtin_amdgcn_exp2f(p1[r]);
  float ps = 0;
#pragma unroll
  for (int r = 0; r < 16; ++r) ps += p0[r];
#pragma unroll
  for (int r = 0; r < 16; ++r) ps += p1[r];
  { auto rr = __builtin_amdgcn_permlane32_swap(__float_as_uint(ps), __float_as_uint(ps), false, false);
    ps = __uint_as_float(rr[0]) + __uint_as_float(rr[1]); }
  l_reg = l_reg * alpha + ps;
  pa = (v8i_t){(int)cvt4_fp8(p0[0], p0[1], p0[2], p0[3]), (int)cvt4_fp8(p0[4], p0[5], p0[6], p0[7]), (int)cvt4_fp8(p0[8], p0[9], p0[10], p0[11]), (int)cvt4_fp8(p0[12], p0[13], p0[14], p0[15]),
               (int)cvt4_fp8(p1[0], p1[1], p1[2], p1[3]), (int)cvt4_fp8(p1[4], p1[5], p1[6], p1[7]), (int)cvt4_fp8(p1[8], p1[9], p1[10], p1[11]), (int)cvt4_fp8(p1[12], p1[13], p1[14], p1[15])};
}
template <int ND = 4>
__device__ __forceinline__ void pv8(f32x16* o, const LAS unsigned char* vlo, const LAS unsigned char* vhi, v8i_t pa) {
#pragma unroll
  for (int d0 = 0; d0 < ND; ++d0) {
    const v8i_t vb = __builtin_shufflevector(*(const LAS v4i_t*)(vlo + d0 * 2048), *(const LAS v4i_t*)(vhi + d0 * 2048), 0, 1, 2, 3, 4, 5, 6, 7);
    o[d0] = __builtin_amdgcn_mfma_scale_f32_32x32x64_f8f6f4(pa, vb, o[d0], 0, 0, 0, 0, 0, 0); }
}

struct UnitP {
  const unsigned char* Qn; const unsigned char* Qr; int ldqn, ldqr;
  const unsigned char* K; const unsigned char* V;
  int ctx_row0, loc_row0, nloc, NT;
  bf16_t* O; int ldo; int o8;
  float sink; int has_sink;
  int qpos0, kpos0;
  int R, rlo;
  int fuse; float lam; const bf16_t* O1; unsigned char* Oc;
  int qraw; const float* gq;
  int rot; const float* CS;
};
template <int MODE>
__device__ __forceinline__ void attn_unit(const UnitP& U, LAS unsigned char* lds, const int wid) {
  const int lane = lane_id(), tid = wid * 64 + lane, r32 = lane & 31, hi = lane >> 5;
  LAS unsigned char* V_lds = lds + OFF_V; LAS unsigned char* K_lds = lds + OFF_K;
  LAS float* wsf = (LAS float*)(lds + OFF_WS) + wid * 64; LAS float* li_l = wsf; LAS float* al_l = wsf + 32;
  const LAS float* bt = (const LAS float*)(lds + OFF_BT);
  float m_reg = -1e30f, l_reg = 0; f32x16 o[4] = {}; v8i_t qr8[2];
#define QLOAD(Qp, ldq) do { const unsigned char* Qw_ = (Qp) + (size_t)(wid * 32 + r32) * (ldq) + hi * 32; \
    _Pragma("unroll") for (int s_ = 0; s_ < 2; ++s_) qr8[s_] = __builtin_shufflevector(*(const v4i_t*)(Qw_ + s_ * 64), *(const v4i_t*)(Qw_ + s_ * 64 + 16), 0, 1, 2, 3, 4, 5, 6, 7); } while (0)
  bool qdone_ = false;
  if constexpr (MODE == 2) { if (U.qraw) { qdone_ = true;
    const unsigned char* Qw_ = U.Qn + (size_t)(wid * 32 + r32) * U.ldqn + hi * 64; u32x4 rw[2][4]; float ss = 0.f;
#pragma unroll
    for (int s_ = 0; s_ < 2; ++s_)
#pragma unroll
      for (int c_ = 0; c_ < 4; ++c_) rw[s_][c_] = *(const GAS u32x4*)((const GAS unsigned char*)Qw_ + s_ * 128 + c_ * 16);
#pragma unroll
    for (int s_ = 0; s_ < 2; ++s_)
#pragma unroll
      for (int c_ = 0; c_ < 4; ++c_)
#pragma unroll
        for (int k_ = 0; k_ < 4; ++k_) { const float x0 = bf_lo(rw[s_][c_][k_]), x1 = bf_hi(rw[s_][c_][k_]); ss += x0 * x0 + x1 * x1; }
    ss += __shfl_xor(ss, 32);
    const float rstd = 1.0f / sqrtf(ss * (1.0f / 128.0f) + 1e-6f);
#pragma unroll
    for (int s_ = 0; s_ < 2; ++s_)
#pragma unroll
      for (int c_ = 0; c_ < 4; ++c_) { const GAS float* g_ = (const GAS float*)U.gq + hi * 32 + 64 * s_ + 8 * c_; const f32x4 g0 = *(const GAS f32x4*)g_, g1 = *(const GAS f32x4*)(g_ + 4); const u32x4 w_ = rw[s_][c_];
        qr8[s_][2 * c_] = (int)cvt4_fp8(bf_lo(w_.x) * rstd * g0[0], bf_hi(w_.x) * rstd * g0[1], bf_lo(w_.y) * rstd * g0[2], bf_hi(w_.y) * rstd * g0[3]);
        qr8[s_][2 * c_ + 1] = (int)cvt4_fp8(bf_lo(w_.z) * rstd * g1[0], bf_hi(w_.z) * rstd * g1[1], bf_lo(w_.w) * rstd * g1[2], bf_hi(w_.w) * rstd * g1[3]); }
  } }
  if (!qdone_) QLOAD(U.Qn, U.ldqn);
  const int sr = tid >> 4, sc = (tid & 15) * 8;
  const int cgq = tid >> 4, kg = tid & 15;
  const int vwr = (4 * cgq) * 64 + ((((2 * (kg & 1) + (kg >> 3)) ^ (cgq & 3))) << 4) + ((kg & 7) >> 1) * 4;
  const int vsw = (r32 >> 2) & 3;
  const LAS unsigned char* vlo0 = V_lds + r32 * 64 + (((2 * hi) ^ vsw) << 4); const LAS unsigned char* vhi0 = V_lds + r32 * 64 + (((2 * hi + 1) ^ vsw) << 4);
  const unsigned char* Kh = U.K; const unsigned char* Vh = U.V;
  constexpr int SD = 2;
  u32x4 vsa, vsb; u32x2 ks0a, ks1a, ks0b, ks1b;
#define TROW(j) ((j) < 4 ? U.ctx_row0 + 64 * (j) : U.loc_row0 + 64 * (((j) - 4) < U.nloc ? ((j) - 4) : U.nloc - 1))
#define SLOAD_A(j) do { const size_t v_ = (size_t)(TROW(j) + 4 * kg) * LDV8 + 4 * cgq; vsa.x = *(const unsigned*)(Vh + v_); vsa.y = *(const unsigned*)(Vh + v_ + LDV8); vsa.z = *(const unsigned*)(Vh + v_ + 2 * LDV8); vsa.w = *(const unsigned*)(Vh + v_ + 3 * LDV8); const size_t k_ = (size_t)(TROW(j) + sr) * LDK8 + sc; ks0a = *(const u32x2*)(Kh + k_); ks1a = *(const u32x2*)(Kh + k_ + (size_t)32 * LDK8); } while (0)
#define SLOAD_B(j) do { const size_t v_ = (size_t)(TROW(j) + 4 * kg) * LDV8 + 4 * cgq; vsb.x = *(const unsigned*)(Vh + v_); vsb.y = *(const unsigned*)(Vh + v_ + LDV8); vsb.z = *(const unsigned*)(Vh + v_ + 2 * LDV8); vsb.w = *(const unsigned*)(Vh + v_ + 3 * LDV8); const size_t k_ = (size_t)(TROW(j) + sr) * LDK8 + sc; ks0b = *(const u32x2*)(Kh + k_); ks1b = *(const u32x2*)(Kh + k_ + (size_t)32 * LDK8); } while (0)
#define SWRITE_A(b) do { { const unsigned t0_ = __builtin_amdgcn_perm(vsa.y, vsa.x, 0x05010400u), t1_ = __builtin_amdgcn_perm(vsa.y, vsa.x, 0x07030602u), t2_ = __builtin_amdgcn_perm(vsa.w, vsa.z, 0x05010400u), t3_ = __builtin_amdgcn_perm(vsa.w, vsa.z, 0x07030602u); \
      LAS unsigned char* vp_ = V_lds + (b) * SHM_V + vwr; *(LAS unsigned*)(vp_) = __builtin_amdgcn_perm(t2_, t0_, 0x05040100u); *(LAS unsigned*)(vp_ + 64) = __builtin_amdgcn_perm(t2_, t0_, 0x07060302u); \
      *(LAS unsigned*)(vp_ + 128) = __builtin_amdgcn_perm(t3_, t1_, 0x05040100u); *(LAS unsigned*)(vp_ + 192) = __builtin_amdgcn_perm(t3_, t1_, 0x07060302u); } \
    *(LAS u32x2*)(K_lds + (b) * SHM_K + K8SWZ(sr, sc)) = ks0a; *(LAS u32x2*)(K_lds + (b) * SHM_K + K8SWZ(32 + sr, sc)) = ks1a; } while (0)
#define SWRITE_B(b) do { { const unsigned t0_ = __builtin_amdgcn_perm(vsb.y, vsb.x, 0x05010400u), t1_ = __builtin_amdgcn_perm(vsb.y, vsb.x, 0x07030602u), t2_ = __builtin_amdgcn_perm(vsb.w, vsb.z, 0x05010400u), t3_ = __builtin_amdgcn_perm(vsb.w, vsb.z, 0x07030602u); \
      LAS unsigned char* vp_ = V_lds + (b) * SHM_V + vwr; *(LAS unsigned*)(vp_) = __builtin_amdgcn_perm(t2_, t0_, 0x05040100u); *(LAS unsigned*)(vp_ + 64) = __builtin_amdgcn_perm(t2_, t0_, 0x07060302u); \
      *(LAS unsigned*)(vp_ + 128) = __builtin_amdgcn_perm(t3_, t1_, 0x05040100u); *(LAS unsigned*)(vp_ + 192) = __builtin_amdgcn_perm(t3_, t1_, 0x07060302u); } \
    *(LAS u32x2*)(K_lds + (b) * SHM_K + K8SWZ(sr, sc)) = ks0b; *(LAS u32x2*)(K_lds + (b) * SHM_K + K8SWZ(32 + sr, sc)) = ks1b; } while (0)
#define SLOAD_E(j) SLOAD_A(j)
#define SWRITE_E(b) SWRITE_A(b)
#define SLOAD_O(j) do { if constexpr (SD == 2) SLOAD_B(j); else SLOAD_A(j); } while (0)
#define SWRITE_O(b) do { if constexpr (SD == 2) SWRITE_B(b); else SWRITE_A(b); } while (0)
#define SWAIT() do { if constexpr (SD == 2) asm volatile("s_waitcnt vmcnt(6)" ::: "memory"); else asm volatile("s_waitcnt vmcnt(0)" ::: "memory"); } while (0)
#define RESC(a) do { if (__any((a) < 1.f)) { if (hi == 0) al_l[r32] = (a); asm volatile("s_waitcnt lgkmcnt(0)" ::: "memory"); \
    _Pragma("unroll") for (int d = 0; d < 4; ++d) _Pragma("unroll") for (int r = 0; r < 16; ++r) o[d][r] *= al_l[crow(r, hi)]; } } while (0)
  const int qrow_l = wid * 32 + r32;
  unsigned boff[8];
  if constexpr (MODE == 1) { const int cq = 32 * (wid & 1) + r32; int c0 = cq - 8; c0 = c0 < 0 ? 0 : (c0 > 48 ? 48 : c0);
#pragma unroll
    for (int g = 0; g < 8; ++g) { unsigned w = 0;
#pragma unroll
      for (int q = 0; q < 4; ++q) { const int r = (g & 3) * 4 + q; const int kc = 4 * hi + (r & 3) + 8 * (r >> 2) + 32 * (g >> 2);
        const unsigned byte = ((unsigned)(kc - c0) < 16u) ? (unsigned)(kc - cq + 15) : 31u; w |= byte << (8 * q); }
      boff[g] = w; } }
#define MASK(P0, P1, j) do { if ((j) >= 4) { const int jl_ = (j) - 4; \
    if constexpr (MODE == 0) { const int d0_ = U.kpos0 + 64 * jl_ + 4 * hi - (U.qpos0 + qrow_l); const int dw_ = U.kpos0 + 64 * jl_ - (U.qpos0 + wid * 32); \
      if (dw_ - 31 < -128 || dw_ + 63 > 128) _Pragma("unroll") for (int r = 0; r < 16; ++r) { const int d_ = d0_ + (r & 3) + 8 * (r >> 2); \
        if (d_ < -128 || d_ > 128) P0[r] = NEGM; if (d_ + 32 < -128 || d_ + 32 > 128) P1[r] = NEGM; } } \
    if constexpr (MODE == 1) { const int kr_ = U.rlo + jl_; const int rq_ = U.R + (wid >> 1); \
      int r0_ = rq_ - 4; r0_ = r0_ < 0 ? 0 : (r0_ > 24 ? 24 : r0_); \
      const bool rowok_ = (jl_ < U.nloc) && kr_ >= r0_ && kr_ <= r0_ + 7; \
      const LAS unsigned char* tb_ = (const LAS unsigned char*)bt + (rowok_ ? (kr_ - rq_ + 7) : 15) * 128; \
      _Pragma("unroll") for (int g = 0; g < 4; ++g) { SBAR(); \
        _Pragma("unroll") for (int q = 0; q < 4; ++q) { const int r = 4 * g + q; \
          const unsigned o0_ = __builtin_amdgcn_ubfe(boff[g], 8 * q, 8), o1_ = __builtin_amdgcn_ubfe(boff[4 + g], 8 * q, 8); \
          P0[r] += *(const LAS float*)(tb_ + o0_ * 4); P1[r] += *(const LAS float*)(tb_ + o1_ * 4); } \
        asm volatile("s_waitcnt lgkmcnt(0)" ::: "memory"); SBAR(); } } } } while (0)
#define QSWITCH(j) do { if ((j) == 4 && U.rot) { const float* cs_ = U.CS + ((size_t)(U.qpos0 + wid * 32 + r32) * 64 + 16 * hi) * 2; \
    _Pragma("unroll") for (int s_ = 0; s_ < 2; ++s_) _Pragma("unroll") for (int d_ = 0; d_ < 8; ++d_) { const f32x4 c4_ = *(const f32x4*)(cs_ + (32 * s_ + 2 * d_) * 2);   \
      const int w_ = qr8[s_][d_]; const f32x2 a_ = __builtin_amdgcn_cvt_pk_f32_fp8(w_, false), b_ = __builtin_amdgcn_cvt_pk_f32_fp8(w_, true); \
      int o_ = __builtin_amdgcn_cvt_pk_fp8_f32(a_.x * c4_[0] - a_.y * c4_[1], a_.x * c4_[1] + a_.y * c4_[0], 0, false); \
      o_ = __builtin_amdgcn_cvt_pk_fp8_f32(b_.x * c4_[2] - b_.y * c4_[3], b_.x * c4_[3] + b_.y * c4_[2], o_, true); qr8[s_][d_] = o_; } } } while (0)
  f32x16 pA0, pA1, pB0, pB1; float mnA, mnB, alA, alB; v8i_t pa; const int NT = U.NT;
  SLOAD_E(0); asm volatile("s_waitcnt vmcnt(0)" ::: "memory"); SWRITE_E(0); __syncthreads();
  qkt8(pA0, pA1, K_lds, qr8, r32, hi); partialSM(pA0, pA1, m_reg, mnA, alA);
  SLOAD_O(1); if constexpr (SD == 2) { if (2 < NT) SLOAD_E(2); }
  SWAIT(); SWRITE_O(1); __syncthreads();
  for (int j = 1; j + 1 < NT; j += 2) {
    QSWITCH(j);
    SBAR(); qkt8(pB0, pB1, K_lds + SHM_K, qr8, r32, hi); MASK(pB0, pB1, j);
    finishSM8(pA0, pA1, alA, l_reg, pa); SBAR();
    if constexpr (SD == 2) SLOAD_O(j + 2); else SLOAD_E(j + 1);
    SBAR();
    pv8(o, vlo0, vhi0, pa); partialSM(pB0, pB1, m_reg, mnB, alB);
    __syncthreads(); SWAIT(); SWRITE_E(0);
    RESC(alB); __syncthreads();
    QSWITCH(j + 1);
    SBAR(); qkt8(pA0, pA1, K_lds, qr8, r32, hi); MASK(pA0, pA1, j + 1);
    finishSM8(pB0, pB1, alB, l_reg, pa); SBAR();
    if constexpr (SD == 2) { if (j + 3 < NT) SLOAD_E(j + 3); } else SLOAD_O(j + 2);
    SBAR();
    pv8(o, vlo0 + SHM_V, vhi0 + SHM_V, pa); partialSM(pA0, pA1, m_reg, mnA, alA);
    __syncthreads(); SWAIT(); SWRITE_O(1);
    RESC(alA); __syncthreads();
  }
  QSWITCH(NT - 1);
  SBAR(); qkt8(pB0, pB1, K_lds + SHM_K, qr8, r32, hi); MASK(pB0, pB1, NT - 1);
  finishSM8(pA0, pA1, alA, l_reg, pa); SBAR();
  pv8(o, vlo0, vhi0, pa); partialSM(pB0, pB1, m_reg, mnB, alB);
  __syncthreads(); RESC(alB);
  finishSM8(pB0, pB1, alB, l_reg, pa); SBAR();
  pv8(o, vlo0 + SHM_V, vhi0 + SHM_V, pa);
  if (U.has_sink) l_reg += __builtin_amdgcn_exp2f(U.sink * 1.4426950408889634f - m_reg * (SM_SCALE * 1.4426950408889634f));
  if (hi == 0) li_l[r32] = l_reg; asm volatile("s_waitcnt lgkmcnt(0)" ::: "memory");
  if (U.o8) {
    LAS unsigned char* st = K_lds + wid * 4096;
#pragma unroll
    for (int r = 0; r < 16; ++r) {
      const float rl = __builtin_amdgcn_rcpf(li_l[crow(r, hi)]) * OSCALE; const int orow = crow(r, hi);
#pragma unroll
      for (int d0 = 0; d0 < 4; ++d0) { const float x = o[d0][r] * rl; st[orow * 128 + d0 * 32 + r32] = (unsigned char)__builtin_amdgcn_cvt_pk_fp8_f32(x, x, 0, false); }
    }
    asm volatile("s_waitcnt lgkmcnt(0)" ::: "memory");
    unsigned char* Ob8 = (unsigned char*)U.O; int ld8 = U.ldo; asm volatile("" : "+s"(Ob8), "+s"(ld8));
#pragma unroll
    for (int i4 = 0; i4 < 4; ++i4) { const int chunk = i4 * 64 + lane; const int row = chunk >> 3, cb = chunk & 7;
      *(GAS u32x4*)((GAS unsigned char*)Ob8 + (size_t)(wid * 32 + row) * ld8 + cb * 16) = *(const LAS u32x4*)(st + chunk * 16); }
  } else {
  bf16_t* Ob_ = U.O; int ldo_ = U.ldo; asm volatile("" : "+s"(Ob_), "+s"(ldo_));
  bf16_t* Ow = Ob_ + (size_t)(wid * 32) * ldo_;
  const bool odd = (lane & 1) != 0;
#pragma unroll
  for (int r = 0; r < 16; r += 2) {
    const float rl0 = __builtin_amdgcn_rcpf(li_l[crow(r, hi)]), rl1 = __builtin_amdgcn_rcpf(li_l[crow(r + 1, hi)]);
    const int orow = crow(odd ? r + 1 : r, hi);
#pragma unroll
    for (int d0 = 0; d0 < 4; ++d0) {
      const float x0 = o[d0][r] * rl0, x1 = o[d0][r + 1] * rl1;
      const float mine = odd ? x1 : x0, give = odd ? x0 : x1;
      const float got = __shfl_xor(give, 1);
      const unsigned w = cvt_pk_bf16(odd ? got : mine, odd ? mine : got);
      *(GAS unsigned*)((GAS bf16_t*)Ow + (size_t)orow * ldo_ + d0 * 32 + (r32 & ~1)) = w;
    }
  }
  }
  __syncthreads();
#undef TROW
#undef SLOAD_A
#undef SLOAD_B
#undef SWRITE_A
#undef SWRITE_B
#undef SWAIT
#undef SLOAD_E
#undef SLOAD_O
#undef SWRITE_E
#undef SWRITE_O
#undef RESC
#undef MASK
#undef QSWITCH
#undef QLOAD
}
template <int MODE, int NV = 1>
__device__ __forceinline__ void attn_unit_simple(const UnitP& U, LAS unsigned char* lds, const int wid) {
  const int lane = lane_id(), tid = wid * 64 + lane, r32 = lane & 31, hi = lane >> 5;
  LAS unsigned char* V_lds = lds + OFF_V; LAS unsigned char* K_lds = lds + OFF_K;
  LAS float* wsf = (LAS float*)(lds + OFF_WS) + wid * 64; LAS float* li_l = wsf; LAS float* al_l = wsf + 32;
  const LAS float* bt = (const LAS float*)(lds + OFF_BT);
  float m_reg = -1e30f, l_reg = 0; f32x16 o[4 * NV] = {}; v8i_t qr8[2];
#define QLOAD(Qp, ldq) do { const unsigned char* Qw_ = (Qp) + (size_t)(wid * 32 + r32) * (ldq) + hi * 32; \
    _Pragma("unroll") for (int s_ = 0; s_ < 2; ++s_) qr8[s_] = __builtin_shufflevector(*(const v4i_t*)(Qw_ + s_ * 64), *(const v4i_t*)(Qw_ + s_ * 64 + 16), 0, 1, 2, 3, 4, 5, 6, 7); } while (0)
  QLOAD(U.Qn, U.ldqn);
  const int sr = tid >> 4, sc = (tid & 15) * 8;
  const int cgq = tid >> 4, kg = tid & 15;
  const int vwr = (4 * cgq) * 64 + ((((2 * (kg & 1) + (kg >> 3)) ^ (cgq & 3))) << 4) + ((kg & 7) >> 1) * 4;
  const int vsw = (r32 >> 2) & 3;
  const LAS unsigned char* vlo0 = V_lds + r32 * 64 + (((2 * hi) ^ vsw) << 4); const LAS unsigned char* vhi0 = V_lds + r32 * 64 + (((2 * hi + 1) ^ vsw) << 4);
  const unsigned char* Kh = U.K; const unsigned char* Vh = U.V;
  constexpr int SD = 1;
  u32x4 vsa, vsb, vsa2; u32x2 ks0a, ks1a, ks0b, ks1b;
#define TROW(j) ((j) < 4 ? U.ctx_row0 + 64 * (j) : U.loc_row0 + 64 * (((j) - 4) < U.nloc ? ((j) - 4) : U.nloc - 1))
#define SLOAD_A(j) do { const size_t v_ = (size_t)(TROW(j) + 4 * kg) * LDV8 + 4 * cgq; vsa.x = *(const unsigned*)(Vh + v_); vsa.y = *(const unsigned*)(Vh + v_ + LDV8); vsa.z = *(const unsigned*)(Vh + v_ + 2 * LDV8); vsa.w = *(const unsigned*)(Vh + v_ + 3 * LDV8); if constexpr (NV == 2) { vsa2.x = *(const unsigned*)(Vh + v_ + 128); vsa2.y = *(const unsigned*)(Vh + v_ + LDV8 + 128); vsa2.z = *(const unsigned*)(Vh + v_ + 2 * LDV8 + 128); vsa2.w = *(const unsigned*)(Vh + v_ + 3 * LDV8 + 128); } const size_t k_ = (size_t)(TROW(j) + sr) * LDK8 + sc; ks0a = *(const u32x2*)(Kh + k_); ks1a = *(const u32x2*)(Kh + k_ + (size_t)32 * LDK8); } while (0)
#define SLOAD_B(j) do { const size_t v_ = (size_t)(TROW(j) + 4 * kg) * LDV8 + 4 * cgq; vsb.x = *(const unsigned*)(Vh + v_); vsb.y = *(const unsigned*)(Vh + v_ + LDV8); vsb.z = *(const unsigned*)(Vh + v_ + 2 * LDV8); vsb.w = *(const unsigned*)(Vh + v_ + 3 * LDV8); const size_t k_ = (size_t)(TROW(j) + sr) * LDK8 + sc; ks0b = *(const u32x2*)(Kh + k_); ks1b = *(const u32x2*)(Kh + k_ + (size_t)32 * LDK8); } while (0)
#define SWRITE_A(b) do { { const unsigned t0_ = __builtin_amdgcn_perm(vsa.y, vsa.x, 0x05010400u), t1_ = __builtin_amdgcn_perm(vsa.y, vsa.x, 0x07030602u), t2_ = __builtin_amdgcn_perm(vsa.w, vsa.z, 0x05010400u), t3_ = __builtin_amdgcn_perm(vsa.w, vsa.z, 0x07030602u); \
      LAS unsigned char* vp_ = V_lds + (b) * SHM_V + vwr; *(LAS unsigned*)(vp_) = __builtin_amdgcn_perm(t2_, t0_, 0x05040100u); *(LAS unsigned*)(vp_ + 64) = __builtin_amdgcn_perm(t2_, t0_, 0x07060302u); \
      *(LAS unsigned*)(vp_ + 128) = __builtin_amdgcn_perm(t3_, t1_, 0x05040100u); *(LAS unsigned*)(vp_ + 192) = __builtin_amdgcn_perm(t3_, t1_, 0x07060302u); } \
    if constexpr (NV == 2) { const unsigned t0_ = __builtin_amdgcn_perm(vsa2.y, vsa2.x, 0x05010400u), t1_ = __builtin_amdgcn_perm(vsa2.y, vsa2.x, 0x07030602u), t2_ = __builtin_amdgcn_perm(vsa2.w, vsa2.z, 0x05010400u), t3_ = __builtin_amdgcn_perm(vsa2.w, vsa2.z, 0x07030602u); \
      LAS unsigned char* vp_ = V_lds + (b) * SHM_V + vwr + 8192; *(LAS unsigned*)(vp_) = __builtin_amdgcn_perm(t2_, t0_, 0x05040100u); *(LAS unsigned*)(vp_ + 64) = __builtin_amdgcn_perm(t2_, t0_, 0x07060302u); \
      *(LAS unsigned*)(vp_ + 128) = __builtin_amdgcn_perm(t3_, t1_, 0x05040100u); *(LAS unsigned*)(vp_ + 192) = __builtin_amdgcn_perm(t3_, t1_, 0x07060302u); } \
    *(LAS u32x2*)(K_lds + (b) * SHM_K + K8SWZ(sr, sc)) = ks0a; *(LAS u32x2*)(K_lds + (b) * SHM_K + K8SWZ(32 + sr, sc)) = ks1a; } while (0)
#define SWRITE_B(b) do { { const unsigned t0_ = __builtin_amdgcn_perm(vsb.y, vsb.x, 0x05010400u), t1_ = __builtin_amdgcn_perm(vsb.y, vsb.x, 0x07030602u), t2_ = __builtin_amdgcn_perm(vsb.w, vsb.z, 0x05010400u), t3_ = __builtin_amdgcn_perm(vsb.w, vsb.z, 0x07030602u); \
      LAS unsigned char* vp_ = V_lds + (b) * SHM_V + vwr; *(LAS unsigned*)(vp_) = __builtin_amdgcn_perm(t2_, t0_, 0x05040100u); *(LAS unsigned*)(vp_ + 64) = __builtin_amdgcn_perm(t2_, t0_, 0x07060302u); \
      *(LAS unsigned*)(vp_ + 128) = __builtin_amdgcn_perm(t3_, t1_, 0x05040100u); *(LAS unsigned*)(vp_ + 192) = __builtin_amdgcn_perm(t3_, t1_, 0x07060302u); } \
    *(LAS u32x2*)(K_lds + (b) * SHM_K + K8SWZ(sr, sc)) = ks0b; *(LAS u32x2*)(K_lds + (b) * SHM_K + K8SWZ(32 + sr, sc)) = ks1b; } while (0)
#define SLOAD_E(j) SLOAD_A(j)
#define SWRITE_E(b) SWRITE_A(b)
#define SLOAD_O(j) do { if constexpr (SD == 2) SLOAD_B(j); else SLOAD_A(j); } while (0)
#define SWRITE_O(b) do { if constexpr (SD == 2) SWRITE_B(b); else SWRITE_A(b); } while (0)
#define SWAIT() do { if constexpr (SD == 2) asm volatile("s_waitcnt vmcnt(6)" ::: "memory"); else asm volatile("s_waitcnt vmcnt(0)" ::: "memory"); } while (0)
#define RESC(a) do { if (__any((a) < 1.f)) { if (hi == 0) al_l[r32] = (a); asm volatile("s_waitcnt lgkmcnt(0)" ::: "memory"); \
    _Pragma("unroll") for (int d = 0; d < 4 * NV; ++d) _Pragma("unroll") for (int r = 0; r < 16; ++r) o[d][r] *= al_l[crow(r, hi)]; } } while (0)
  const int qrow_l = wid * 32 + r32;
  unsigned boff[8];
  if constexpr (MODE == 1) { const int cq = 32 * (wid & 1) + r32; int c0 = cq - 8; c0 = c0 < 0 ? 0 : (c0 > 48 ? 48 : c0);
#pragma unroll
    for (int g = 0; g < 8; ++g) { unsigned w = 0;
#pragma unroll
      for (int q = 0; q < 4; ++q) { const int r = (g & 3) * 4 + q; const int kc = 4 * hi + (r & 3) + 8 * (r >> 2) + 32 * (g >> 2);
        const unsigned byte = ((unsigned)(kc - c0) < 16u) ? (unsigned)(kc - cq + 15) : 31u; w |= byte << (8 * q); }
      boff[g] = w; } }
#define MASK(P0, P1, j) do { if ((j) >= 4) { const int jl_ = (j) - 4; \
    if constexpr (MODE == 0) { const int d0_ = U.kpos0 + 64 * jl_ + 4 * hi - (U.qpos0 + qrow_l); const int dw_ = U.kpos0 + 64 * jl_ - (U.qpos0 + wid * 32); \
      if (dw_ - 31 < -128 || dw_ + 63 > 128) _Pragma("unroll") for (int r = 0; r < 16; ++r) { const int d_ = d0_ + (r & 3) + 8 * (r >> 2); \
        if (d_ < -128 || d_ > 128) P0[r] = NEGM; if (d_ + 32 < -128 || d_ + 32 > 128) P1[r] = NEGM; } } \
    if constexpr (MODE == 1) { const int kr_ = U.rlo + jl_; const int rq_ = U.R + (wid >> 1); \
      int r0_ = rq_ - 4; r0_ = r0_ < 0 ? 0 : (r0_ > 24 ? 24 : r0_); \
      const bool rowok_ = (jl_ < U.nloc) && kr_ >= r0_ && kr_ <= r0_ + 7; \
      const LAS unsigned char* tb_ = (const LAS unsigned char*)bt + (rowok_ ? (kr_ - rq_ + 7) : 15) * 128; \
      _Pragma("unroll") for (int g = 0; g < 4; ++g) { SBAR(); \
        _Pragma("unroll") for (int q = 0; q < 4; ++q) { const int r = 4 * g + q; \
          const unsigned o0_ = __builtin_amdgcn_ubfe(boff[g], 8 * q, 8), o1_ = __builtin_amdgcn_ubfe(boff[4 + g], 8 * q, 8); \
          P0[r] += *(const LAS float*)(tb_ + o0_ * 4); P1[r] += *(const LAS float*)(tb_ + o1_ * 4); } \
        asm volatile("s_waitcnt lgkmcnt(0)" ::: "memory"); SBAR(); } } } } while (0)
#define QSWITCH(j) do { if ((j) == 4 && U.rot) { const float* cs_ = U.CS + ((size_t)(U.qpos0 + wid * 32 + r32) * 64 + 16 * hi) * 2; \
    _Pragma("unroll") for (int s_ = 0; s_ < 2; ++s_) _Pragma("unroll") for (int d_ = 0; d_ < 8; ++d_) { const f32x4 c4_ = *(const f32x4*)(cs_ + (32 * s_ + 2 * d_) * 2);   \
      const int w_ = qr8[s_][d_]; const f32x2 a_ = __builtin_amdgcn_cvt_pk_f32_fp8(w_, false), b_ = __builtin_amdgcn_cvt_pk_f32_fp8(w_, true); \
      int o_ = __builtin_amdgcn_cvt_pk_fp8_f32(a_.x * c4_[0] - a_.y * c4_[1], a_.x * c4_[1] + a_.y * c4_[0], 0, false); \
      o_ = __builtin_amdgcn_cvt_pk_fp8_f32(b_.x * c4_[2] - b_.y * c4_[3], b_.x * c4_[3] + b_.y * c4_[2], o_, true); qr8[s_][d_] = o_; } } } while (0)
  f32x16 p0, p1; float mn, al; v8i_t pa; const int NT = U.NT;
  SLOAD_A(0);
  for (int j = 0; j < NT; ++j) {
    const int buf = j & 1;
    asm volatile("s_waitcnt vmcnt(0)" ::: "memory"); SWRITE_A(buf);
    if (j + 1 < NT) SLOAD_A(j + 1);
    __syncthreads();
    QSWITCH(j);
    bool live = true;
    if constexpr (MODE == 1) { if (j >= 4) { const int jl = j - 4, kr = U.rlo + jl, rq = U.R + (wid >> 1); int r0 = rq - 4; r0 = r0 < 0 ? 0 : (r0 > 24 ? 24 : r0); live = (jl < U.nloc) && kr >= r0 && kr <= r0 + 7; } }
    if (live) {
      qkt8(p0, p1, K_lds + buf * SHM_K, qr8, r32, hi); MASK(p0, p1, j);
      partialSM(p0, p1, m_reg, mn, al);
      finishSM8(p0, p1, al, l_reg, pa);
      RESC(al);
      pv8<4 * NV>(o, vlo0 + buf * SHM_V, vhi0 + buf * SHM_V, pa);
    }
  }
  if (U.has_sink) l_reg += __builtin_amdgcn_exp2f(U.sink * 1.4426950408889634f - m_reg * (SM_SCALE * 1.4426950408889634f));
  if (hi == 0) li_l[r32] = l_reg; asm volatile("s_waitcnt lgkmcnt(0)" ::: "memory");
  bool fused_ = false;
  if constexpr (NV == 2) { if (U.fuse) { fused_ = true;
    __syncthreads();
    LAS unsigned char* st = lds + (wid < 4 ? wid * 16384 : 69632 + (wid - 4) * 16384);
#pragma unroll
    for (int r = 0; r < 16; ++r) { const float rl = __builtin_amdgcn_rcpf(li_l[crow(r, hi)]); const int orow = crow(r, hi);
#pragma unroll
      for (int d0 = 0; d0 < 8; ++d0) *(LAS unsigned short*)(st + orow * 512 + (d0 * 32 + r32) * 2) = (unsigned short)cvt_pk_bf16(o[d0 < 4 * NV ? d0 : 0][r] * rl, 0.f); }
    const bf16_t* O1 = U.O1; unsigned char* Oc = U.Oc; const float lam = U.lam; asm volatile("" : "+s"(O1), "+s"(Oc));
    const int rsel = lane >> 5, cc = lane & 31;
    u32x4 w1[16];
#pragma unroll
    for (int it = 0; it < 16; ++it) w1[it] = *(const GAS u32x4*)((const GAS bf16_t*)O1 + (size_t)(wid * 32 + 2 * it + rsel) * 1024 + cc * 8);
    asm volatile("s_waitcnt lgkmcnt(0)" ::: "memory");
#pragma unroll
    for (int it = 0; it < 16; ++it) { const int row = 2 * it + rsel;
      const u32x4 a4 = *(const LAS u32x4*)(st + row * 512 + cc * 16); const u32x4 b4 = w1[it];
      const float e0 = bf_lo(a4.x) - lam * bf_lo(b4.x), e1 = bf_hi(a4.x) - lam * bf_hi(b4.x), e2 = bf_lo(a4.y) - lam * bf_lo(b4.y), e3 = bf_hi(a4.y) - lam * bf_hi(b4.y);
      const float e4 = bf_lo(a4.z) - lam * bf_lo(b4.z), e5 = bf_hi(a4.z) - lam * bf_hi(b4.z), e6 = bf_lo(a4.w) - lam * bf_lo(b4.w), e7 = bf_hi(a4.w) - lam * bf_hi(b4.w);
      float ss = ((e0 * e0 + e1 * e1) + (e2 * e2 + e3 * e3)) + ((e4 * e4 + e5 * e5) + (e6 * e6 + e7 * e7));
#pragma unroll
      for (int o_ = 1; o_ < 32; o_ <<= 1) ss += __shfl_xor(ss, o_);
      const float rs = (1.0f / sqrtf(ss * (1.0f / 256.0f) + 1e-6f)) * OSCALE;
      u32x2 ov; ov.x = cvt4_fp8(e0 * rs, e1 * rs, e2 * rs, e3 * rs); ov.y = cvt4_fp8(e4 * rs, e5 * rs, e6 * rs, e7 * rs);
      *(GAS u32x2*)((GAS unsigned char*)Oc + (size_t)(wid * 32 + row) * DM + cc * 8) = ov; }
  } }
  if (fused_) { } else
  if (NV == 1 && U.o8) {
    __syncthreads();
    LAS unsigned char* st = K_lds + wid * 4096;
#pragma unroll
    for (int r = 0; r < 16; ++r) {
      const float rl = __builtin_amdgcn_rcpf(li_l[crow(r, hi)]) * OSCALE; const int orow = crow(r, hi);
#pragma unroll
      for (int d0 = 0; d0 < 4; ++d0) { const float x = o[d0 < 4 * NV ? d0 : 0][r] * rl; st[orow * 128 + d0 * 32 + r32] = (unsigned char)__builtin_amdgcn_cvt_pk_fp8_f32(x, x, 0, false); }
    }
    asm volatile("s_waitcnt lgkmcnt(0)" ::: "memory");
    unsigned char* Ob8 = (unsigned char*)U.O; int ld8 = U.ldo; asm volatile("" : "+s"(Ob8), "+s"(ld8));
#pragma unroll
    for (int i4 = 0; i4 < 4; ++i4) { const int chunk = i4 * 64 + lane; const int row = chunk >> 3, cb = chunk & 7;
      *(GAS u32x4*)((GAS unsigned char*)Ob8 + (size_t)(wid * 32 + row) * ld8 + cb * 16) = *(const LAS u32x4*)(st + chunk * 16); }
  } else {
  bf16_t* Ob_ = U.O; int ldo_ = U.ldo; asm volatile("" : "+s"(Ob_), "+s"(ldo_));
  bf16_t* Ow = Ob_ + (size_t)(wid * 32) * ldo_;
  const bool odd = (lane & 1) != 0;
#pragma unroll
  for (int r = 0; r < 16; r += 2) {
    const float rl0 = __builtin_amdgcn_rcpf(li_l[crow(r, hi)]), rl1 = __builtin_amdgcn_rcpf(li_l[crow(r + 1, hi)]);
    const int orow = crow(odd ? r + 1 : r, hi);
#pragma unroll
    for (int d0 = 0; d0 < 4 * NV; ++d0) {
      const float x0 = o[d0][r] * rl0, x1 = o[d0][r + 1] * rl1;
      const float mine = odd ? x1 : x0, give = odd ? x0 : x1;
      const float got = __shfl_xor(give, 1);
      const unsigned w = cvt_pk_bf16(odd ? got : mine, odd ? mine : got);
      *(GAS unsigned*)((GAS bf16_t*)Ow + (size_t)orow * ldo_ + d0 * 32 + (r32 & ~1)) = w;
    }
  }
  }
  __syncthreads();
#undef TROW
#undef SLOAD_A
#undef SLOAD_B
#undef SWRITE_A
#undef SWRITE_B
#undef SWAIT
#undef SLOAD_E
#undef SLOAD_O
#undef SWRITE_E
#undef SWRITE_O
#undef RESC
#undef MASK
#undef QSWITCH
#undef QLOAD
}
#undef KSWZ
#undef SBAR
}

__device__ __forceinline__ void phase_attn0(KArgs a, LAS unsigned char* lds, int tid, int wave, int G, int vcu) {
  const unsigned char* QKV = (const unsigned char*)(a->ws + WS_Q8); const unsigned char* QN = (const unsigned char*)(a->ws + WS_QN); unsigned char* O = (unsigned char*)(a->ws + WS_O);
  const unsigned char* K8 = (const unsigned char*)(a->ws + WS_K8); const unsigned char* V8 = (const unsigned char*)(a->ws + WS_V8);
  LAS float* bt = (LAS float*)(lds + att::OFF_BT); const float* CSt = (const float*)(a->ws + WS_CS);
  int pos_ = 0; const int mypos = vcu % 9;
  for (int i_ = 0, u = vcu; i_ * G < 1024; ++i_, u = i_ * G + ((vcu + 2 * i_) % G)) {
    if (u >= 1024) break;
    if (pos_++ == mypos) conv_layer0_burst(a, lds, vcu, G, wave, lane_id());
    att::UnitP U; U.has_sink = 0; U.sink = 0.f; U.qpos0 = 0; U.kpos0 = 0; U.ldo = DM; U.o8 = 1; U.rot = 0; U.CS = CSt;
    const int qb = u & 7, h = (u >> 3) & 7, b = u >> 6; const int row0 = b * PB + CTXL + 256 * qb;
    { const int dr = tid >> 5, dc = tid & 31; bt[tid] = (dr < 15 && dc < 31) ? a->in[13][h * 465 + dr * 31 + dc] * (1.0f / SM_SCALE) : att::NEGM; }
    U.Qn = QKV + (size_t)row0 * NQKV + 1536 + h * HD; U.Qr = U.Qn; U.ldqn = NQKV; U.ldqr = NQKV;
    U.K = K8 + 256 + h * HD; U.V = V8 + 256 + h * HD;
    const int R = 4 * qb; int rlo = R - 4; rlo = rlo < 0 ? 0 : rlo; rlo = rlo > 24 ? 24 : rlo; int rh = R + 3 - 4; rh = rh < 0 ? 0 : (rh > 24 ? 24 : rh); const int rhi = rh + 7;
    U.R = R; U.rlo = rlo; U.nloc = rhi - rlo + 1; U.NT = 4 + ((U.nloc + 1) & ~1);
    U.ctx_row0 = b * PB; U.loc_row0 = b * PB + CTXL + 64 * rlo;
    U.O = (bf16_t*)(O + (size_t)row0 * DM + 1024 + h * HD);
    __syncthreads();
    att::attn_unit_simple<1>(U, lds, wave);
  }
  for (int i_ = 0, u = vcu; i_ * G < 1024; ++i_, u = i_ * G + ((vcu + 2 * i_) % G)) {
    if (u >= 1024) break;
    if (pos_++ == mypos) conv_layer0_burst(a, lds, vcu, G, wave, lane_id());
    att::UnitP U; U.R = 0; U.rlo = 0; U.ldo = DM; U.o8 = 1; U.rot = 1; U.CS = CSt; U.qraw = 0; U.gq = nullptr;
    const int qb = u & 7, h = (u >> 3) & 7, b = u >> 6; const int row0 = b * PB + CTXL + 256 * qb;
    U.Qn = QKV + (size_t)row0 * NQKV + h * HD; U.ldqn = NQKV; U.Qr = U.Qn; U.ldqr = NQKV;
    U.K = K8 + (h >> 2) * HD; U.V = V8 + (h >> 2) * HD;
    int tlo = 4 * qb - 2; tlo = tlo < 0 ? 0 : tlo; int thi = 4 * qb + 5; thi = thi > 31 ? 31 : thi;
    U.nloc = thi - tlo + 1; U.NT = 4 + U.nloc; U.qpos0 = 256 * qb; U.kpos0 = 64 * tlo;
    U.ctx_row0 = b * PB; U.loc_row0 = b * PB + CTXL + 64 * tlo;
    U.has_sink = 1; U.sink = a->in[12][h];
    U.O = (bf16_t*)(O + (size_t)row0 * DM + h * HD);
    att::attn_unit<0>(U, lds, wave);
  }
  for (int u = vcu; u < 256; u += G) {
    if (pos_++ == mypos) conv_layer0_burst(a, lds, vcu, G, wave, lane_id());
    att::UnitP U; U.qpos0 = 0; U.kpos0 = 0; U.R = 0; U.rlo = 0; U.ldo = DM; U.o8 = 1; U.rot = 0; U.CS = CSt; U.qraw = 0; U.gq = nullptr;
    const int hh = u & 15, b = u >> 4; const int row0 = b * PB; const bool fa = hh < 8; const int h = hh & 7;
    U.Qn = QKV + (size_t)row0 * NQKV + (fa ? h * HD : 1536 + h * HD); U.Qr = U.Qn; U.ldqn = NQKV; U.ldqr = NQKV;
    U.K = K8 + (fa ? (h >> 2) * HD : 256 + h * HD); U.V = V8 + (fa ? (h >> 2) * HD : 256 + h * HD);
    U.nloc = 1; U.NT = 4; U.ctx_row0 = b * PB; U.loc_row0 = b * PB;
    U.has_sink = fa ? 1 : 0; U.sink = fa ? a->in[12][h] : 0.f;
    U.O = (bf16_t*)(O + (size_t)row0 * DM + (fa ? h * HD : 1024 + h * HD));
    att::attn_unit<2>(U, lds, wave);
  }
  if (pos_ <= mypos) conv_layer0_burst(a, lds, vcu, G, wave, lane_id());
}
__device__ __forceinline__ void phase_attn1(KArgs a, LAS unsigned char* lds, int tid, int wave, int G, int vcu) {
  const unsigned char* QKV = (const unsigned char*)(a->ws + WS_Q8); const unsigned char* QN = (const unsigned char*)(a->ws + WS_QN); unsigned char* O = (unsigned char*)(a->ws + WS_O); bf16_t* OD = (bf16_t*)(a->ws + WS_H);
  const unsigned char* K8 = (const unsigned char*)(a->ws + WS_K8); const unsigned char* V8 = (const unsigned char*)(a->ws + WS_V8); const float* CSt = (const float*)(a->ws + WS_CS);
  for (int u = vcu; u < 1024; u += G) {
    att::UnitP U; U.has_sink = 0; U.sink = 0.f; U.qpos0 = 0; U.kpos0 = 0; U.R = 0; U.rlo = 0; U.nloc = 32; U.NT = 36; U.rot = 1; U.CS = CSt;
    const int qb = u & 7, h = (u >> 3) & 7, b = u >> 6; const int row0 = b * PB + CTXL + 256 * qb;
    U.Qn = (const unsigned char*)(a->ws + WS_QKV) + ((size_t)row0 * 1280 + h * HD) * 2; U.ldqn = 2560; U.Qr = U.Qn; U.ldqr = 2560; U.qpos0 = 256 * qb; U.qraw = 1; U.gq = a->in[16];
    U.K = K8 + (h >> 2) * HD; U.V = V8 + (h >> 2) * HD;
    U.ctx_row0 = b * PB; U.loc_row0 = b * PB + CTXL;
    U.O = (bf16_t*)(O + (size_t)row0 * DM + h * HD); U.ldo = DM; U.o8 = 1;
    att::attn_unit<2>(U, lds, wave);
  }
  float lam;
  { const int lane = lane_id(); const f32x2 q1 = *(const f32x2*)(a->in[18] + 2 * lane), k1 = *(const f32x2*)(a->in[19] + 2 * lane), q2 = *(const f32x2*)(a->in[20] + 2 * lane), k2 = *(const f32x2*)(a->in[21] + 2 * lane);
    const float d1 = wave_sum(q1.x * k1.x + q1.y * k1.y), d2 = wave_sum(q2.x * k2.x + q2.y * k2.y); lam = __uint_as_float(__builtin_amdgcn_readfirstlane(__float_as_uint(expf(d1) - expf(d2) + LAMBDA_INIT1))); }
  for (int pu = vcu; pu < 512; pu += G) {
    const int qb = pu & 7, j = (pu >> 3) & 3, b = pu >> 5; const int row0 = b * PB + CTXL + 256 * qb;
#pragma clang loop unroll(disable)
    for (int s = 1; s >= 0; --s) { const int hd = 2 * j + s;
      att::UnitP U; U.has_sink = 0; U.sink = 0.f; U.qpos0 = 0; U.kpos0 = 0; U.R = 0; U.rlo = 0; U.nloc = 32; U.NT = 36; U.rot = 1; U.CS = CSt;
      U.Qn = QKV + (size_t)row0 * NQKV + 1536 + hd * HD; U.ldqn = NQKV; U.Qr = U.Qn; U.ldqr = NQKV; U.qpos0 = 256 * qb;
      U.K = K8 + 256 + hd * HD; U.V = V8 + 256 + j * 256;
      U.ctx_row0 = b * PB; U.loc_row0 = b * PB + CTXL;
      U.O1 = OD + (size_t)MROWS * 1024 + (size_t)row0 * 1024 + j * 256; U.O = (bf16_t*)U.O1; U.ldo = 1024; U.o8 = 0;
      U.fuse = (s == 0) ? 1 : 0; U.lam = lam; U.Oc = O + (size_t)row0 * DM + 1024 + j * 256;
      att::attn_unit_simple<2, 2>(U, lds, wave);
    }
  }
}
constexpr int NPHASE = 20;
__host__ __device__ __forceinline__ bool phase_active(int k) { return !(k == 3 || k == 5); }

__device__ __forceinline__ void moe_tables(KArgs a, int layer, LAS int* tb, int tid) {
    if (tid < 16) tb[17 + tid] = (int)__hip_atomic_load((unsigned*)(a->ws + WS_CTL) + CW_CNT + (layer * 16 + tid) * 64, __ATOMIC_RELAXED, __HIP_MEMORY_SCOPE_AGENT);
    __syncthreads();
    if (tid == 0) { int base = 0; for (int e = 0; e < 16; ++e) { tb[e] = base; const int nt = (tb[17 + e] + 255) >> 8; for (int t = 0; t < nt; ++t) tb[33 + base + t] = e; base += nt; } tb[16] = base; }
    __syncthreads();
}


#if MK_MULTI
#define PH_KERNEL_HEAD extern __shared__ __attribute__((aligned(16))) unsigned char lds_raw[]; LAS unsigned char* lds = (LAS unsigned char*)lds_raw; KArgs a = kargs(); \
    const int l = a->ph_lo; const int wave = __builtin_amdgcn_readfirstlane(threadIdx.x >> 6), lane = lane_id(), tid = wave * 64 + lane; const int G = gridDim.x, bx = blockIdx.x; \
    const int vcu = (G % 8 == 0) ? (bx % 8) * (G / 8) + bx / 8 : bx; const int gwv = bx * 8 + wave, ngw = G * 8; (void)l; (void)lane; (void)vcu; (void)gwv; (void)ngw; (void)lds;
__global__ void __launch_bounds__(512, 2) k_pro(Args kparam) { PH_KERNEL_HEAD phase_prologue(a, lds, tid, lane, wave, G); }
__global__ void __launch_bounds__(512, 2) k_h0(Args kparam) { PH_KERNEL_HEAD phase_h0(a, lds, tid, lane, wave); }
__global__ void __launch_bounds__(512, 2) k_inproj(Args kparam) { PH_KERNEL_HEAD
    pg8::DenseOrder S; S.init(a->ws + WS_H, a->ws + WS_WIN + (size_t)l * NQKV * DM, DM / 2, NQKV, l == 1 ? 2 : 0, G, bx);
    pg8::EpiQKV E{(bf16_t*)(a->ws + WS_QKV), (unsigned char*)(a->ws + WS_Q8), (unsigned char*)(a->ws + WS_QN), (const float*)(a->ws + WS_CS), l == 0 ? 0x10u : 0x3C00u, 0u, l == 0 ? 0x3C10u : 0x3C00u, l == 0 ? 0u : 0x1Fu,     (unsigned char*)(a->ws + WS_K8), (unsigned char*)(a->ws + WS_V8), false};
    pg8::gemm_phase<pg8::EpiQKV, pg8::DenseOrder, true>(lds, DM / 2, S, E, wave); }
__global__ void __launch_bounds__(512, 2) k_prep(Args kparam) { PH_KERNEL_HEAD phase_prep(a, lane, gwv, ngw); }
#if NAIVE_ATTN
__global__ void __launch_bounds__(512, 2) k_attn(Args kparam) { PH_KERNEL_HEAD phase_attn_naive(a, l, lds, lane, wave, gwv, ngw); }
#else
__global__ void __launch_bounds__(512, 2) k_attn(Args kparam) { PH_KERNEL_HEAD if (l == 0) phase_attn0(a, lds, tid, wave, G, vcu); else phase_attn1(a, lds, tid, wave, G, vcu); }
#endif
__global__ void __launch_bounds__(512, 2) k_combine(Args kparam) { PH_KERNEL_HEAD phase_combine(a, lane, gwv, ngw); }
__global__ void __launch_bounds__(512, 2) k_outproj(Args kparam) { PH_KERNEL_HEAD
    pg8::DenseOrder S; S.init(a->ws + WS_O, a->ws + WS_WOUT + (size_t)l * DM * DM, DM / 2, DM, l == 1 ? 1 : 0, G, bx);
    pg8::EpiPlain E{(unsigned char*)(a->ws + WS_QKV), DM, Y8SCALE / (W8SCALE * att_OSCALE), false};
    pg8::gemm_phase<pg8::EpiPlain, pg8::DenseOrder, true>(lds, DM / 2, S, E, wave); }
__global__ void __launch_bounds__(512, 2) k_ln1(Args kparam) { PH_KERNEL_HEAD phase_ln1(a, l, lds, tid, lane, gwv, ngw); }
__global__ void __launch_bounds__(512, 2) k_moe1(Args kparam) { PH_KERNEL_HEAD
    LAS int* tb = (LAS int*)(lds + TB_OFF); moe_tables(a, l, tb, tid);
    pg8::GroupedOrder<true> S{(const char*)(a->ws + WS_H), (const char*)(a->ws + WS_WGU + (size_t)l * 16 * DM * DM), DM / 2, (size_t)DM * DM, (const int*)(a->ws + WS_LIST), tb, G, vcu};
    pg8::EpiSwiGLU E{(unsigned char*)(a->ws + WS_O)};
    pg8::gemm_phase<pg8::EpiSwiGLU, pg8::GroupedOrder<true>, true>(lds, DM / 2, S, E, wave); }
__global__ void __launch_bounds__(512, 2) k_moe2(Args kparam) { PH_KERNEL_HEAD
    LAS int* tb = (LAS int*)(lds + TB_OFF); moe_tables(a, l, tb, tid);
    pg8::GroupedOrder<false> S{(const char*)(a->ws + WS_O), (const char*)(a->ws + WS_WD + (size_t)l * 16 * DM * FF), FF / 2, (size_t)DM * FF, (const int*)(a->ws + WS_LIST), tb, G, vcu};
    pg8::EpiSlots E{(unsigned char*)(a->ws + WS_QKV)};
    pg8::gemm_phase<pg8::EpiSlots, pg8::GroupedOrder<false>, true>(lds, FF / 2, S, E, wave); }
__global__ void __launch_bounds__(512, 2) k_ln2(Args kparam) { PH_KERNEL_HEAD phase_ln2(a, l, lds, tid, lane, gwv, ngw); }
typedef void (*phase_kernel_t)(Args);
#endif
#if !MK_MULTI
#if STAMP_PHASE >= 0
#define STAMP(k) do { if (blockIdx.x == 0 && wave == 0 && lane_id() == 0) { volatile LAS unsigned long long* ts_ = (volatile LAS unsigned long long*)(lds + MISC_OFF - 512); const unsigned long long now_ = __builtin_amdgcn_s_memrealtime(); \
    if ((k) == 31) ts_[32] = now_; else { ts_[(k)] = now_ - ts_[32]; ts_[32] = now_; } } } while (0)
#else
#define STAMP(k) do { } while (0)
#endif
template <int L>
__device__ __forceinline__ void layer_phases(LAS unsigned char* lds, const XcdBarrier& bar, const int lo, const int hi, const int wave) {
    constexpr int l = L, pb = 2 + 9 * L;
    const int G = gridDim.x, bx = blockIdx.x;
    const int vcu = (G % 8 == 0) ? (bx % 8) * (G / 8) + bx / 8 : bx;
    const int gwv = bx * 8 + wave, ngw = G * 8;
#define IN(k) (lo <= (k) && (k) < hi)
#define PHASE_END(k) do { if (hi > (k) + 1) xcd_barrier(bar); STAMP(k); } while (0)
#define PH_BEGIN(k) for (int rep_ = 0; rep_ <= ((REP_MASK >> (k)) & 1); ++rep_) { const bool dry_ = rep_ < ((REP_MASK >> (k)) & 1); (void)dry_; KArgs a = kargs(); const int lane = lane_id(), tid = wave * 64 + lane; (void)tid; (void)lane;
#define PH_END(k) if (rep_ < ((REP_MASK >> (k)) & 1)) xcd_barrier(bar); } PHASE_END(k);
    if (IN(pb + 0)) { PH_BEGIN(pb + 0)
        pg8::DenseOrder S; S.init(a->ws + WS_H, a->ws + WS_WIN + (size_t)l * NQKV * DM, DM / 2, NQKV, l == 1 ? 2 : 0, G, bx);
        pg8::EpiQKV E{(bf16_t*)(a->ws + WS_QKV), (unsigned char*)(a->ws + WS_Q8), (unsigned char*)(a->ws + WS_QN), (const float*)(a->ws + WS_CS), l == 0 ? 0x10u : 0x3C00u, 0u, l == 0 ? 0x3C10u : 0x3C00u, l == 0 ? 0u : 0x1Fu,     (unsigned char*)(a->ws + WS_K8), (unsigned char*)(a->ws + WS_V8), dry_};
        pg8::gemm_phase<pg8::EpiQKV, pg8::DenseOrder, true>(lds, DM / 2, S, E, wave, dry_);
        if constexpr (L == 0) deferred_items(a, lds, 0, bx, S.ntot, G, wave, lane);
        PH_END(pb + 0) }
    if (l == 1 && IN(pb + 1)) { PH_BEGIN(pb + 1) phase_prep(a, lane, gwv, ngw); PH_END(pb + 1) }
    if (IN(pb + 2)) { PH_BEGIN(pb + 2)
#if NAIVE_ATTN
        phase_attn_naive(a, l, lds, lane, wave, gwv, ngw);
#else
        if (l == 0) phase_attn0(a, lds, tid, wave, G, vcu); else phase_attn1(a, lds, tid, wave, G, vcu);
#endif
        PH_END(pb + 2) }
    if (IN(pb + 4)) { PH_BEGIN(pb + 4)
        pg8::DenseOrder S; S.init(a->ws + WS_O, a->ws + WS_WOUT + (size_t)l * DM * DM, DM / 2, DM, l == 1 ? 1 : 0, G, bx);
        pg8::EpiPlain E{(unsigned char*)(a->ws + WS_QKV), DM, Y8SCALE / (W8SCALE * att_OSCALE), dry_};
        pg8::gemm_phase<pg8::EpiPlain, pg8::DenseOrder, true>(lds, DM / 2, S, E, wave, dry_);
        if constexpr (L == 0) deferred_items(a, lds, 1, bx, S.ntot, G, wave, lane);
        PH_END(pb + 4) }
    if (IN(pb + 5)) { PH_BEGIN(pb + 5) phase_ln1(a, l, lds, tid, lane, gwv, ngw, rep_ < ((REP_MASK >> (pb + 5)) & 1)); PH_END(pb + 5) }
    if (IN(pb + 6)) { PH_BEGIN(pb + 6)
        LAS int* tb = (LAS int*)(lds + TB_OFF); moe_tables(a, l, tb, tid);
        pg8::GroupedOrder<true> S{(const char*)(a->ws + WS_H), (const char*)(a->ws + WS_WGU + (size_t)l * 16 * DM * DM), DM / 2, (size_t)DM * DM, (const int*)(a->ws + WS_LIST), tb, G, vcu};
        pg8::EpiSwiGLU E{(unsigned char*)(a->ws + WS_O)};
        pg8::gemm_phase<pg8::EpiSwiGLU, pg8::GroupedOrder<true>, true>(lds, DM / 2, S, E, wave, dry_);
        if constexpr (L == 0) deferred_items(a, lds, 2, vcu, tb[16] * 8, G, wave, lane);
        PH_END(pb + 6) }
    if (IN(pb + 7)) { PH_BEGIN(pb + 7)
        LAS int* tb = (LAS int*)(lds + TB_OFF); moe_tables(a, l, tb, tid);
        pg8::GroupedOrder<false> S{(const char*)(a->ws + WS_O), (const char*)(a->ws + WS_WD + (size_t)l * 16 * DM * FF), FF / 2, (size_t)DM * FF, (const int*)(a->ws + WS_LIST), tb, G, vcu};
        pg8::EpiSlots E{(unsigned char*)(a->ws + WS_QKV)};
        pg8::gemm_phase<pg8::EpiSlots, pg8::GroupedOrder<false>, true>(lds, FF / 2, S, E, wave, dry_);
        if constexpr (L == 0) deferred_items(a, lds, 3, vcu, tb[16] * 8, G, wave, lane);
        PH_END(pb + 7) }
    if (IN(pb + 8)) { PH_BEGIN(pb + 8) phase_ln2(a, l, lds, tid, lane, gwv, ngw, rep_ < ((REP_MASK >> (pb + 8)) & 1)); PH_END(pb + 8) }
#undef IN
#undef PHASE_END
#undef PH_BEGIN
#undef PH_END
}
__global__ void __launch_bounds__(512, 2) mk_fwd(Args kparam) {
    extern __shared__ __attribute__((aligned(16))) unsigned char lds_raw[];
    LAS unsigned char* lds = (LAS unsigned char*)lds_raw;
    const int wave = __builtin_amdgcn_readfirstlane((int)(threadIdx.x >> 6));
    const int G = gridDim.x, bx = blockIdx.x;
    volatile LAS unsigned* MISC = (volatile LAS unsigned*)(lds + MISC_OFF);
    if (wave == 0 && lane_id() < 4) MISC[lane_id()] = 0u;
    __syncthreads();
    XcdBarrier bar = xcd_barrier_post((unsigned*)(kargs()->ws + WS_CTL) + CW_BAR, MISC, wave);
    const int lo = kargs()->ph_lo, hi = kargs()->ph_hi;
#define IN(k) (lo <= (k) && (k) < hi)
#define PHASE_END(k) do { if (hi > (k) + 1) xcd_barrier(bar); STAMP(k); } while (0)
    STAMP(31);

    if (IN(0)) { for (int rep_ = 0; rep_ <= (REP_MASK & 1); ++rep_) { KArgs a = kargs(); const int lane = lane_id(); phase_prologue(a, lds, wave * 64 + lane, lane, wave, G); if (rep_ < (REP_MASK & 1)) xcd_barrier(bar); } STAMP(0); }
    if (IN(1)) { KArgs a = kargs(); { const int lane = lane_id(); phase_h0(a, lds, wave * 64 + lane, lane, wave); } PHASE_END(1); }
    for (int xb_ = 0; xb_ < BAR_PROBE; ++xb_) xcd_barrier(bar);

    layer_phases<0>(lds, bar, lo, hi, wave);
    layer_phases<1>(lds, bar, lo, hi, wave);
#if STAMP_PHASE >= 0
    { xcd_barrier(bar); STAMP(19);
      float* cw = (float*)(kargs()->ws + WS_CTL) + 3000;
      if (blockIdx.x == 0 && wave == 0 && lane_id() == 0) { volatile LAS unsigned long long* ts_ = (volatile LAS unsigned long long*)(lds + MISC_OFF - 512); __hip_atomic_store(cw, floorf(((float)ts_[STAMP_PHASE] * 0.01f + STAMP_OFS) * (1.0f / STAMP_BIN)), __ATOMIC_RELAXED, __HIP_MEMORY_SCOPE_AGENT);     }
      xcd_barrier(bar);
      const float c = __hip_atomic_load(cw, __ATOMIC_RELAXED, __HIP_MEMORY_SCOPE_AGENT); float* o = kargs()->out; const int lane = lane_id();
      for (size_t i = (size_t)(blockIdx.x * 512 + wave * 64 + lane) * 4; i < (size_t)NB * SEQ * DM; i += (size_t)gridDim.x * 512 * 4) *(f32x4*)(o + i) = (f32x4){c, c, c, c}; }
#endif
#undef IN
#undef PHASE_END
}

#endif

extern "C" void kernel_launch(void* const* d_in, const int* in_sizes, int n_in, void* d_out, int out_size, void* d_ws, size_t ws_size, hipStream_t stream) {
    static int grid = 0;
    if (grid == 0) {
        if (n_in != 28 || out_size != NB * SEQ * DM || ws_size < WS_END) { fprintf(stderr, "kernel_launch: shape/workspace mismatch (n_in %d out %d ws %zu need %zu)\n", n_in, out_size, ws_size, (size_t)WS_END); grid = -1; return; }
        int dev = 0, cus = 0;
        if (hipGetDevice(&dev) != hipSuccess || hipDeviceGetAttribute(&cus, hipDeviceAttributeMultiprocessorCount, dev) != hipSuccess) { grid = -1; return; }
#if MK_MULTI
        const void* ks[] = {(const void*)k_pro, (const void*)k_h0, (const void*)k_inproj, (const void*)k_prep, (const void*)k_attn, (const void*)k_combine, (const void*)k_outproj, (const void*)k_ln1, (const void*)k_moe1, (const void*)k_moe2, (const void*)k_ln2};
        for (int i = 0; i < 11; ++i) if (hipFuncSetAttribute(ks[i], hipFuncAttributeMaxDynamicSharedMemorySize, LDS_BYTES) != hipSuccess) { fprintf(stderr, "kernel_launch: hipFuncSetAttribute failed\n"); grid = -1; return; }
#else
        if (hipFuncSetAttribute((const void*)mk_fwd, hipFuncAttributeMaxDynamicSharedMemorySize, LDS_BYTES) != hipSuccess) { fprintf(stderr, "kernel_launch: hipFuncSetAttribute failed\n"); grid = -1; return; }
        int per_cu = 0;
        if (hipOccupancyMaxActiveBlocksPerMultiprocessor(&per_cu, (const void*)mk_fwd, 512, LDS_BYTES) != hipSuccess || per_cu < 1) fprintf(stderr, "kernel_launch: occupancy query says %d\n", per_cu);
        (void)hipGetLastError();
#endif
        grid = cus;
    }
    if (grid < 0) return;
    (void)hipMemsetAsync((char*)d_ws + WS_CTL, 0, CTL_BYTES, stream);
    Args a{};
    for (int i = 0; i < 28; ++i) a.in[i] = (const float*)d_in[i];
    a.out = (float*)d_out; a.ws = (unsigned char*)d_ws;
#if MK_MULTI
    {
        const phase_kernel_t seq[9] = {k_inproj, k_prep, k_attn, k_combine, k_outproj, k_ln1, k_moe1, k_moe2, k_ln2};
        a.ph_lo = 0; a.ph_hi = 0;
        hipLaunchKernelGGL(k_pro, dim3(grid), dim3(512), LDS_BYTES, stream, a);
        hipLaunchKernelGGL(k_h0, dim3(grid), dim3(512), LDS_BYTES, stream, a);
        for (int l = 0; l < 2; ++l) for (int j = 0; j < 9; ++j) { if (j == 3 || (l == 0 && j == 1)) continue; a.ph_lo = l; a.ph_hi = l; hipLaunchKernelGGL(seq[j], dim3(grid), dim3(512), LDS_BYTES, stream, a); }
    }
#else
    a.ph_lo = 0; a.ph_hi = NPHASE; hipLaunchKernelGGL(mk_fwd, dim3(grid), dim3(512), LDS_BYTES, stream, a);
#endif
    const hipError_t le = hipPeekAtLastError();
    if (le != hipSuccess) fprintf(stderr, "kernel_launch: launch failed: %s\n", hipGetErrorName(le));
}
```

```cpp
#include <hip/hip_runtime.h>
#include <cstdio>
#include <cstdint>

#ifndef MK_MULTI
#define MK_MULTI 0
#endif

#ifndef NAIVE_ATTN
#define NAIVE_ATTN 0
#endif

#ifndef REP_MASK
#define REP_MASK 0
#endif

#ifndef GEMM_PROBE_NOEPI
#define GEMM_PROBE_NOEPI 0
#endif
#ifndef GEMM_PROBE_NODMA
#define GEMM_PROBE_NODMA 0
#endif
#ifndef GEMM_PROBE_HALFST
#define GEMM_PROBE_HALFST 0
#endif
#ifndef BAR_PROBE
#define BAR_PROBE 0
#endif
#ifndef EPIQKV_PROBE
#define EPIQKV_PROBE 0
#endif
#ifndef EPI_REP
#define EPI_REP 0
#endif
#ifndef STAMP_PHASE
#define STAMP_PHASE -1
#endif
#ifndef STAMP_BIN
#define STAMP_BIN 10.0f
#define STAMP_OFS 0.0f
#endif
#ifndef LN1_DRYVAR
#define LN1_DRYVAR 0
#endif

#define GAS __attribute__((address_space(1)))
#define LAS __attribute__((address_space(3)))
typedef unsigned short bf16_t;
typedef short bf16x8 __attribute__((ext_vector_type(8)));
typedef float f32x4 __attribute__((ext_vector_type(4)));
typedef float f32x2 __attribute__((ext_vector_type(2)));
typedef float f32x16 __attribute__((ext_vector_type(16)));
typedef unsigned u32x4 __attribute__((ext_vector_type(4)));
typedef unsigned u32x2 __attribute__((ext_vector_type(2)));

constexpr int DM = 2048, NB = 16, SEQ = 2048, CTXL = 256, PB = SEQ + CTXL, MROWS = NB * PB;
constexpr int NQKV = 4608, HD = 128, NE = 16, FF = 1024, GRIDW = 64;
constexpr float ALPHA = 1.4142135623730951f;
constexpr float SM_SCALE = 0.08838834764831845f;
constexpr float LAMBDA_INIT1 = 0.35550906759096927f;
constexpr float ONE_M_LI = 1.0f - LAMBDA_INIT1;
constexpr int LCAP = MROWS;
constexpr int MAXT = 304;

constexpr size_t MiB = 1u << 20;
constexpr size_t WS_CTL = 0, CTL_BYTES = 128 * 1024;
constexpr size_t WS_MOD = 1 * MiB;
constexpr size_t WS_CS = 3 * MiB;
constexpr size_t WS_GW = 4 * MiB;
constexpr size_t WS_PPOS = 4 * MiB + 512 * 1024;
constexpr size_t WS_LIST = 5 * MiB;
constexpr size_t WS_WIN = 8 * MiB;
constexpr size_t WS_WOUT = 44 * MiB;
constexpr size_t WS_WGU = 60 * MiB;
constexpr size_t WS_K8 = (60 + 128) * MiB;
constexpr size_t WS_V8 = (60 + 128 + 48) * MiB;
constexpr size_t WS_WD = 316 * MiB;
constexpr size_t WS_XC = 444 * MiB;
constexpr size_t WS_H = 476 * MiB;
constexpr size_t WS_QKV = 620 * MiB;
constexpr size_t WS_Q8 = (620 + 162) * MiB;
constexpr size_t WS_QN = 944 * MiB;
constexpr size_t WS_O = 1088 * MiB;
constexpr size_t WS_END = 1240 * MiB;
constexpr int CW_BAR = 4096;
constexpr int CW_MODF = 12288;
constexpr int CW_CNT = 16384;

constexpr int LDS_BYTES = 163840;
constexpr int RING_BYTES = 131072;
constexpr int TB_OFF = RING_BYTES;
constexpr int STASH_OFF = RING_BYTES + 2048;
constexpr int MISC_OFF = LDS_BYTES - 64;

__device__ __forceinline__ unsigned cvt_pk_bf16(float lo, float hi) { unsigned r; asm volatile("v_cvt_pk_bf16_f32 %0, %1, %2" : "=v"(r) : "v"(lo), "v"(hi)); return r; }
__device__ __forceinline__ unsigned cvt4_fp8(float a, float b, float c, float d) { int w = __builtin_amdgcn_cvt_pk_fp8_f32(a, b, 0, false); w = __builtin_amdgcn_cvt_pk_fp8_f32(c, d, w, true); return (unsigned)w; }
constexpr float att_OSCALE = 16.0f;
constexpr float Y8SCALE = 16.0f;
__device__ __forceinline__ f32x4 fp8x4_to_f32(unsigned w) { const f32x2 lo = __builtin_amdgcn_cvt_pk_f32_fp8((int)w, false), hi = __builtin_amdgcn_cvt_pk_f32_fp8((int)w, true); return (f32x4){lo.x, lo.y, hi.x, hi.y}; }
constexpr float W8SCALE = 64.0f;
__device__ __forceinline__ float bf_lo(unsigned w) { return __uint_as_float(w << 16); }
__device__ __forceinline__ float bf_hi(unsigned w) { return __uint_as_float(w & 0xffff0000u); }
__device__ __forceinline__ float bf2f(bf16_t b) { return __uint_as_float((unsigned)b << 16); }
__device__ __forceinline__ float wave_sum(float v) {
#pragma unroll
    for (int o = 1; o < 64; o <<= 1) v += __shfl_xor(v, o);
    return v;
}
__device__ __forceinline__ float wave_max(float v) {
#pragma unroll
    for (int o = 1; o < 64; o <<= 1) v = fmaxf(v, __shfl_xor(v, o));
    return v;
}
__device__ __forceinline__ int lane_id() { int l; asm volatile("v_mbcnt_lo_u32_b32 %0, -1, 0\n\tv_mbcnt_hi_u32_b32 %0, -1, %0" : "=v"(l)); return l; }
#define LDS_WAIT() asm volatile("s_waitcnt lgkmcnt(0)" ::: "memory")
#define VM_WAIT() asm volatile("s_waitcnt vmcnt(0)" ::: "memory")

struct Args { const float* in[28]; float* out; unsigned char* ws; int ph_lo, ph_hi; };
typedef const __attribute__((address_space(4))) Args* KArgs;
__device__ __forceinline__ KArgs kargs() { KArgs p = (KArgs)__builtin_amdgcn_kernarg_segment_ptr(); asm volatile("" : "+s"(p)); return p; }
namespace pg8 {
constexpr int BM = 256, BK = 64, HALF = 128, HTB = HALF * BK * 2, STAGE_BYTES = 8 * HTB, NXCD = 8, WGM = 12;
__host__ __device__ __forceinline__ int lds_byte(int r, int c) { const int st = (r >> 4) * 2 + (c >> 5), rr = r & 15, cc = c & 31, ob = rr * 64 + cc * 2; return st * 1024 + (ob ^ (((ob >> 9) & 1) << 5)); }
__host__ __device__ __forceinline__ void stage_rc(int b, int& R, int& C) { const int st = b / 1024, sb = b % 1024, swz = sb ^ (((sb >> 9) & 1) << 5); R = (st >> 1) * 16 + swz / 64; C = (st & 1) * 32 + (swz % 64) / 2; }
__host__ __device__ __forceinline__ int perm32(int rho) { const int n = rho >> 4, i = rho & 15; return 8 * (i >> 2) + 4 * n + (i & 3); }

typedef int v4i_t __attribute__((ext_vector_type(4)));
typedef int v8i_t __attribute__((ext_vector_type(8)));
struct Unit { int pm, pn, e, mt; };

constexpr bool ALIGN_EPI_ = true;
template <class Epi, class Sched, bool FP8 = false>
__device__ __forceinline__ void gemm_phase(LAS unsigned char* lds, const int K, const Sched& S, const Epi& E, const int wid, const bool skip_epi = false) {
    const int lane = lane_id(), tid = wid * 64 + lane, wr = wid >> 2, wc = wid & 3, fr = lane & 15, fq = lane >> 4;
    const int nt = K / BK;
    int RA[2]; unsigned CA[2], voffB[2];
#pragma unroll
    for (int i = 0; i < 2; ++i) { int R, C; stage_rc(tid * 16 + i * 8192, R, C); const int Rb = (R & ~31) + perm32(R & 31);
        RA[i] = R; CA[i] = (unsigned)C * 2u; voffB[i] = (unsigned)(Rb * K + C) * 2u; }
    const size_t kstep = (size_t)(BK * 2);
    const size_t hstep = (size_t)HALF * K * 2;
    const unsigned ldsw = (unsigned)wid * 1024u;
    const int aoff = lds_byte(wr * 64 + fr, fq * 8), boff = lds_byte(wc * 32 + fr, fq * 8);
#define PG8_SA(b, h) (((b) * 2 + (h)) * HTB)
#define PG8_SB(b, h) ((4 + (b) * 2 + (h)) * HTB)
#define PG8_STAGE(bufoff, gbase, v0, v1) do { if (GEMM_PROBE_NODMA && skip_epi) break; \
        __builtin_amdgcn_global_load_lds((const unsigned*)((const char*)(gbase) + (v0)), (LAS unsigned*)(lds + (bufoff) + ldsw), 16, 0, 0); \
        __builtin_amdgcn_global_load_lds((const unsigned*)((const char*)(gbase) + (v1)), (LAS unsigned*)(lds + (bufoff) + ldsw + 8192), 16, 0, 0); } while (0)
#define PG8_LD8(p) __builtin_shufflevector(*(const LAS v4i_t*)(p), *(const LAS v4i_t*)((p) + 1024), 0, 1, 2, 3, 4, 5, 6, 7)
#define PG8_LDA(dst, b, h) do { if constexpr (FP8) { _Pragma("unroll") for (int m = 0; m < 4; ++m) dst##8[m] = PG8_LD8(lds + PG8_SA(b, h) + aoff + m * 2048); } \
        else { _Pragma("unroll") for (int m = 0; m < 4; ++m) _Pragma("unroll") for (int k = 0; k < 2; ++k) dst[m][k] = *(const LAS bf16x8*)(lds + PG8_SA(b, h) + aoff + m * 2048 + k * 1024); } } while (0)
#define PG8_LDB(dst, b, h) do { if constexpr (FP8) { _Pragma("unroll") for (int n = 0; n < 2; ++n) dst##8[n] = PG8_LD8(lds + PG8_SB(b, h) + boff + n * 2048); } \
        else { _Pragma("unroll") for (int n = 0; n < 2; ++n) _Pragma("unroll") for (int k = 0; k < 2; ++k) dst[n][k] = *(const LAS bf16x8*)(lds + PG8_SB(b, h) + boff + n * 2048 + k * 1024); } } while (0)
#define PG8_CAT(x) __builtin_shufflevector(__builtin_bit_cast(v4i_t, x[0]), __builtin_bit_cast(v4i_t, x[1]), 0, 1, 2, 3, 4, 5, 6, 7)
#define PG8_MMA(ai, bj, At, Bt) do { __builtin_amdgcn_s_setprio(1); \
        if constexpr (FP8) { _Pragma("unroll") for (int m = 0; m < 4; ++m) _Pragma("unroll") for (int n = 0; n < 2; ++n) \
            asm volatile("v_mfma_f32_16x16x128_f8f6f4 %0, %1, %2, %0" : "+v"(acc[ai][bj][m][n]) : "v"(Bt##8[n]), "v"(At##8[m])); } \
        else { _Pragma("unroll") for (int m = 0; m < 4; ++m) _Pragma("unroll") for (int n = 0; n < 2; ++n) _Pragma("unroll") for (int k = 0; k < 2; ++k) \
            acc[ai][bj][m][n] = __builtin_amdgcn_mfma_f32_16x16x32_bf16(Bt[n][k], At[m][k], acc[ai][bj][m][n], 0, 0, 0); } \
        __builtin_amdgcn_s_setprio(0); } while (0)
#define PG8_WAIT_V(n) asm volatile("s_waitcnt vmcnt(" #n ")" ::: "memory")
#define PG8_WAIT_L(n) asm volatile("s_waitcnt lgkmcnt(" #n ")" ::: "memory")
#define PG8_BAR __builtin_amdgcn_s_barrier()
#define PG8_SCHED __builtin_amdgcn_sched_barrier(0)
    Unit cur, nxt; int ui = 0;
    if (!S.next(0, cur)) return;
    f32x4 acc[2][2][4][2];
#pragma unroll
    for (int a = 0; a < 2; ++a)
#pragma unroll
        for (int b = 0; b < 2; ++b)
#pragma unroll
            for (int m = 0; m < 4; ++m)
#pragma unroll
                for (int n = 0; n < 2; ++n) acc[a][b][m][n] = (f32x4){0.f, 0.f, 0.f, 0.f};
    bf16x8 At[4][2], B0[2][2], B1[2][2];
    v8i_t At8[4], B08[2], B18[2];
    unsigned c00 = S.a_off(cur, 0, RA[0]) + CA[0], c01 = S.a_off(cur, 0, RA[1]) + CA[1], c10 = S.a_off(cur, 1, RA[0]) + CA[0], c11 = S.a_off(cur, 1, RA[1]) + CA[1];
    const char* cA = S.a_base(cur); const char* cB = S.b_base(cur);
    PG8_STAGE(PG8_SB(0, 0), cB, voffB[0], voffB[1]); PG8_STAGE(PG8_SB(0, 1), cB + hstep, voffB[0], voffB[1]); PG8_STAGE(PG8_SA(0, 0), cA, c00, c01); PG8_STAGE(PG8_SA(0, 1), cA, c10, c11);
    if (wr == 1) PG8_BAR;
    PG8_WAIT_V(2); PG8_BAR;
    PG8_STAGE(PG8_SB(1, 0), cB + kstep, voffB[0], voffB[1]); PG8_STAGE(PG8_SA(1, 0), cA + kstep, c00, c01); PG8_STAGE(PG8_SB(1, 1), cB + hstep + kstep, voffB[0], voffB[1]);
    PG8_WAIT_V(6); PG8_BAR;
    LAS u32x4* stash = (LAS u32x4*)(lds + STASH_OFF) + tid;
    for (;;) {
        const bool has_next = S.next(ui + 1, nxt);
        const char* nA = cA; const char* nB = cB;
        if (has_next) { nA = S.a_base(nxt); nB = S.b_base(nxt); }
        if constexpr (Sched::GATHER) {
            u32x4 sv = (u32x4){c00, c01, c10, c11};
            if (has_next) { sv.x = S.a_off(nxt, 0, RA[0]) + CA[0]; sv.y = S.a_off(nxt, 0, RA[1]) + CA[1]; sv.z = S.a_off(nxt, 1, RA[0]) + CA[0]; sv.w = S.a_off(nxt, 1, RA[1]) + CA[1]; }
            *stash = sv;
        }
#pragma clang loop unroll(disable)
        for (int t = 0; t < nt; t += 2) {
            const bool last = (t == nt - 2);
            const char* a1 = cA + (size_t)(t + 1) * kstep;
            const char* a2 = last ? nA : cA + (size_t)(t + 2) * kstep; const char* b2 = last ? nB : cB + (size_t)(t + 2) * kstep;
            const char* a3 = a2 + kstep; const char* b3 = b2 + kstep;
            unsigned x00 = c00, x01 = c01, x10 = c10, x11 = c11;
            if constexpr (Sched::GATHER) { if (last) { const u32x4 sv = *stash; x00 = sv.x; x01 = sv.y; x10 = sv.z; x11 = sv.w; } }
            PG8_LDB(B0, 0, 0); PG8_LDB(B1, 0, 1); PG8_SCHED; PG8_LDA(At, 0, 0); PG8_STAGE(PG8_SA(1, 1), a1, c10, c11);
            PG8_WAIT_V(8); PG8_WAIT_L(0); PG8_BAR; PG8_MMA(0, 0, At, B0); PG8_MMA(0, 1, At, B1); PG8_BAR; PG8_SCHED;
            PG8_LDA(At, 0, 1); PG8_STAGE(PG8_SB(0, 0), b2, voffB[0], voffB[1]); PG8_STAGE(PG8_SB(0, 1), b2 + hstep, voffB[0], voffB[1]); PG8_STAGE(PG8_SA(0, 0), a2, x00, x01);
            PG8_WAIT_V(8); PG8_WAIT_L(0); PG8_BAR; PG8_MMA(1, 0, At, B0); PG8_MMA(1, 1, At, B1); PG8_BAR; PG8_SCHED;
            PG8_LDB(B0, 1, 0); PG8_LDB(B1, 1, 1); PG8_SCHED; PG8_LDA(At, 1, 0); PG8_STAGE(PG8_SA(0, 1), a2, x10, x11);
            PG8_WAIT_V(8); PG8_WAIT_L(0); PG8_BAR; PG8_MMA(0, 0, At, B0); PG8_MMA(0, 1, At, B1); PG8_BAR; PG8_SCHED;
            PG8_LDA(At, 1, 1); PG8_STAGE(PG8_SB(1, 0), b3, voffB[0], voffB[1]); PG8_STAGE(PG8_SB(1, 1), b3 + hstep, voffB[0], voffB[1]); PG8_STAGE(PG8_SA(1, 0), a3, x00, x01);
            PG8_WAIT_V(8); PG8_WAIT_L(0); PG8_BAR; PG8_MMA(1, 0, At, B0); PG8_MMA(1, 1, At, B1); PG8_BAR; PG8_SCHED;
        }
        if constexpr (ALIGN_EPI_) { if (wr == 0) PG8_BAR; }
        if constexpr (FP8) asm volatile("s_nop 15\n\ts_nop 15" ::: "memory");
        if constexpr (EPI_REP == 0) { if (!(GEMM_PROBE_NOEPI && skip_epi)) E(acc, cur, wr, wc, fr, fq); }
        else { int nrep_ = EPI_REP + 1; asm volatile("" : "+s"(nrep_)); for (int er_ = 0; er_ < nrep_; ++er_) { asm volatile("" ::: "memory"); E(acc, cur, wr, wc, fr, fq); } }
        if (!has_next) break;
#pragma unroll
        for (int a = 0; a < 2; ++a)
#pragma unroll
            for (int b = 0; b < 2; ++b)
#pragma unroll
                for (int m = 0; m < 4; ++m)
#pragma unroll
                    for (int n = 0; n < 2; ++n) acc[a][b][m][n] = (f32x4){0.f, 0.f, 0.f, 0.f};
        cur = nxt; cA = nA; cB = nB; ++ui;
        if constexpr (Sched::GATHER) { const u32x4 sv = *stash; c00 = sv.x; c01 = sv.y; c10 = sv.z; c11 = sv.w; }
        if constexpr (ALIGN_EPI_) { if (wr == 1) PG8_BAR; }
    }
    PG8_WAIT_V(0);
    if constexpr (!ALIGN_EPI_) { if (wr == 0) PG8_BAR; }
    PG8_BAR;
#undef PG8_SA
#undef PG8_SB
#undef PG8_STAGE
#undef PG8_LDA
#undef PG8_LD8
#undef PG8_LDB
#undef PG8_MMA
#undef PG8_CAT
#undef PG8_WAIT_V
#undef PG8_WAIT_L
#undef PG8_BAR
#undef PG8_SCHED
}

struct DenseOrder {
    static constexpr bool GATHER = false;
    const char* A; const char* Bt; int K; int nMe, nN, nwg, ntot, G, c; int mode;
    __device__ __forceinline__ void init(const void* A_, const void* Bt_, int K_, int N, int mode_, int G_, int c_) { A = (const char*)A_; Bt = (const char*)Bt_; K = K_; mode = mode_; nMe = mode_ ? 128 : 144; nN = N / BM; nwg = nMe * nN; ntot = nwg + (mode_ == 2 ? 160 : 0); G = G_; c = c_; }
    __device__ __forceinline__ bool next(int i, Unit& u) const {
        const long L = (long)i * G + c; if (L >= ntot) return false;
        u.e = 0; u.mt = 0;
        if (L >= nwg) { const int idx = (int)L - nwg; const int b = idx / 10, j = idx - b * 10; u.pm = 9 * b; u.pn = j < 2 ? 4 + j : 8 + j; return true; }
        int wgid = (int)L; { const int q = nwg / NXCD, r = nwg % NXCD, xcd = wgid % NXCD, off = wgid / NXCD; wgid = (xcd < r ? xcd * (q + 1) : r * (q + 1) + (xcd - r) * q) + off; }
        const int nig = WGM * nN, gid = wgid / nig, fm = gid * WGM, gsz = (nMe - fm) < WGM ? (nMe - fm) : WGM;
        const int pme = fm + ((wgid % nig) % gsz); u.pn = (wgid % nig) / gsz; u.pm = mode ? pme + (pme >> 3) + 1 : pme; return true;
    }
    __device__ __forceinline__ const char* a_base(const Unit& u) const { return A + (size_t)u.pm * BM * K * 2; }
    __device__ __forceinline__ const char* b_base(const Unit& u) const { return Bt + (size_t)u.pn * BM * K * 2; }
    __device__ __forceinline__ unsigned a_off(const Unit&, int h, int R) const { return (unsigned)((h * HALF + R) * K * 2); }
};
template <bool GATHER_>
struct GroupedOrder {
    static constexpr bool GATHER = GATHER_;
    const char* A; const char* Bt; int K; size_t bstride; const int* list; const LAS int* tb; int G, vcu;
    __device__ __forceinline__ bool next(int i, Unit& u) const {
        const int L = i * G + vcu; const int T = tb[16]; if (L >= T * 8) return false;
        u.pm = L >> 3; u.pn = L & 7; u.e = tb[33 + u.pm]; u.mt = u.pm - tb[u.e]; return true;
    }
    __device__ __forceinline__ const char* a_base(const Unit& u) const { return GATHER ? A : A + (size_t)u.pm * BM * K * 2; }
    __device__ __forceinline__ const char* b_base(const Unit& u) const { return Bt + (size_t)u.e * bstride + (size_t)u.pn * BM * K * 2; }
    __device__ __forceinline__ unsigned a_off(const Unit& u, int h, int R) const {
        if (!GATHER) return (unsigned)((h * HALF + R) * K * 2);
        const int s = u.mt * BM + h * HALF + R; const int n = tb[17 + u.e];
        const int pair = (s < n) ? list[(size_t)u.e * LCAP + s] : 0;
        return (unsigned)(pair >> 1) * (unsigned)(K * 2);
    }
};

struct EpiQKV {
    bf16_t* RAW; unsigned char* Q8; unsigned char* QN8; const float* CS; unsigned ropemask, qnmask, k8mask, rawmask; unsigned char* K8; unsigned char* V8; bool dry;
    __device__ __forceinline__ void operator()(const f32x4 (&acc)[2][2][4][2], const Unit& u, int wr, int wc, int fr, int fq) const {
        const int pn = u.pn; const int bidx = u.pm / 9; const bool isctx = (u.pm - bidx * 9) == 0;
        const bool rope = !isctx && ((ropemask >> pn) & 1u) && !((EPIQKV_PROBE & 1) && dry); const bool qn = !isctx && ((qnmask >> pn) & 1u) && !((EPIQKV_PROBE & 2) && dry);
        const int row0 = u.pm * BM + wr * 64 + fr;
        const int col0 = pn * BM + wc * 32 + 8 * fq;
        const int qncol0 = ((pn < 4) ? 256 * pn : 1024 + 256 * (pn - 6)) + wc * 32 + 8 * fq;
        const int p0 = 16 * wc + 4 * fq;
        const bool raw = (rawmask >> pn) & 1u;
        const bool isv = (pn == 5) || (pn >= 14); const bool k8 = ((k8mask >> pn) & 1u) || isv;
        const int k8col0 = (isv ? (pn == 5 ? 0 : 256 + (pn - 14) * 256) : (pn == 4 ? 0 : 256 + (pn - 10) * 256)) + wc * 32 + 8 * fq;
        unsigned char* KV8 = isv ? V8 : K8;
        f32x4 csA[8], csB[8];
#pragma unroll
        for (int i = 0; i < 8; ++i) { csA[i] = (f32x4){1.f, 0.f, 1.f, 0.f}; csB[i] = csA[i];
            if (rope) { const int t = row0 + (i >> 2) * HALF + (i & 3) * 16 - bidx * PB - CTXL; const float* cp = CS + ((size_t)t * 64 + p0) * 2; csA[i] = *(const f32x4*)cp; csB[i] = *(const f32x4*)(cp + 4); } }
#pragma unroll
        for (int ai = 0; ai < 2; ++ai)
#pragma unroll
            for (int m = 0; m < 4; ++m) {
                const int row = row0 + ai * HALF + m * 16;
                const f32x4 cs0 = csA[ai * 4 + m], cs1 = csB[ai * 4 + m];
#pragma unroll
                for (int bj = 0; bj < 2; ++bj) {
                    f32x4 v0 = acc[ai][bj][m][0] * (1.0f / W8SCALE), v1 = acc[ai][bj][m][1] * (1.0f / W8SCALE);
                    if (qn) { u32x2 w; w.x = cvt4_fp8(v0[0], v0[1], v0[2], v0[3]); w.y = cvt4_fp8(v1[0], v1[1], v1[2], v1[3]);
                        *(u32x2*)(QN8 + (size_t)row * DM + qncol0 + bj * HALF) = w; }
                    if (rope) {
                        f32x4 r0, r1;
                        r0[0] = v0[0] * cs0[0] - v0[1] * cs0[1]; r0[1] = v0[0] * cs0[1] + v0[1] * cs0[0];
                        r0[2] = v0[2] * cs0[2] - v0[3] * cs0[3]; r0[3] = v0[2] * cs0[3] + v0[3] * cs0[2];
                        r1[0] = v1[0] * cs1[0] - v1[1] * cs1[1]; r1[1] = v1[0] * cs1[1] + v1[1] * cs1[0];
                        r1[2] = v1[2] * cs1[2] - v1[3] * cs1[3]; r1[3] = v1[2] * cs1[3] + v1[3] * cs1[2];
                        v0 = r0; v1 = r1;
                    }
                    if (k8) { u32x2 w; w.x = cvt4_fp8(v0[0], v0[1], v0[2], v0[3]); w.y = cvt4_fp8(v1[0], v1[1], v1[2], v1[3]);
                        *(u32x2*)(KV8 + (size_t)row * 1280 + k8col0 + bj * HALF) = w; }
                    else if (raw) { u32x4 w; w.x = cvt_pk_bf16(v0[0], v0[1]); w.y = cvt_pk_bf16(v0[2], v0[3]); w.z = cvt_pk_bf16(v1[0], v1[1]); w.w = cvt_pk_bf16(v1[2], v1[3]);
                        *(u32x4*)(RAW + (size_t)row * 1280 + col0 + bj * HALF) = w; }
                    else { u32x2 w; w.x = cvt4_fp8(v0[0], v0[1], v0[2], v0[3]); w.y = cvt4_fp8(v1[0], v1[1], v1[2], v1[3]);
                        *(u32x2*)(Q8 + (size_t)row * NQKV + col0 + bj * HALF) = w; }
                }
            }
    }
};
struct EpiPlain {
    unsigned char* O; int ldc; float scale; bool dry;
    __device__ __forceinline__ void operator()(const f32x4 (&acc)[2][2][4][2], const Unit& u, int wr, int wc, int fr, int fq) const {
        const int row0 = u.pm * BM + wr * 64 + fr; const int col0 = u.pn * BM + wc * 32 + 8 * fq;
#pragma unroll
        for (int ai = 0; ai < 2; ++ai)
#pragma unroll
            for (int m = 0; m < 4; ++m) { unsigned char* rowp = O + (size_t)(row0 + ai * HALF + m * 16) * ldc + col0;
#pragma unroll
                for (int bj = 0; bj < 2; ++bj) { const f32x4 v0 = acc[ai][bj][m][0] * scale, v1 = acc[ai][bj][m][1] * scale;
                    u32x2 w; w.x = cvt4_fp8(v0[0], v0[1], v0[2], v0[3]); w.y = cvt4_fp8(v1[0], v1[1], v1[2], v1[3]);
                    if (!(GEMM_PROBE_HALFST && dry && bj == 1)) *(u32x2*)(rowp + bj * HALF) = w; } }
    }
};
struct EpiSwiGLU {
    unsigned char* ACT;
    __device__ __forceinline__ void operator()(const f32x4 (&acc)[2][2][4][2], const Unit& u, int wr, int wc, int fr, int fq) const {
        const int row0 = u.pm * BM + wr * 64 + fr; const int col0 = u.pn * HALF + wc * 32 + 8 * fq;
#pragma unroll
        for (int ai = 0; ai < 2; ++ai)
#pragma unroll
            for (int m = 0; m < 4; ++m) {
                float o[8];
#pragma unroll
                for (int n = 0; n < 2; ++n)
#pragma unroll
                    for (int j = 0; j < 4; ++j) { const float g = acc[ai][0][m][n][j] * (1.0f / W8SCALE), up = acc[ai][1][m][n][j] * (1.0f / W8SCALE);
                        const float s = __builtin_amdgcn_rcpf(1.0f + __builtin_amdgcn_exp2f(-g * 1.4426950408889634f)); o[n * 4 + j] = g * s * up; }
                u32x2 w; w.x = cvt4_fp8(o[0], o[1], o[2], o[3]); w.y = cvt4_fp8(o[4], o[5], o[6], o[7]);
                *(u32x2*)(ACT + (size_t)(row0 + ai * HALF + m * 16) * FF + col0) = w;
            }
    }
};
struct EpiSlots {
    unsigned char* DNS;
    __device__ __forceinline__ void operator()(const f32x4 (&acc)[2][2][4][2], const Unit& u, int wr, int wc, int fr, int fq) const {
        const int row0 = u.pm * BM + wr * 64 + fr; const int col0 = u.pn * BM + wc * 32 + 8 * fq; constexpr float sc = Y8SCALE / W8SCALE;
#pragma unroll
        for (int ai = 0; ai < 2; ++ai)
#pragma unroll
            for (int m = 0; m < 4; ++m) { unsigned char* rowp = DNS + (size_t)(row0 + ai * HALF + m * 16) * DM + col0;
#pragma unroll
                for (int bj = 0; bj < 2; ++bj) { const f32x4 v0 = acc[ai][bj][m][0] * sc, v1 = acc[ai][bj][m][1] * sc;
                    u32x2 w; w.x = cvt4_fp8(v0[0], v0[1], v0[2], v0[3]); w.y = cvt4_fp8(v1[0], v1[1], v1[2], v1[3]);
                    *(u32x2*)(rowp + bj * HALF) = w; } }
    }
};
}
typedef GAS unsigned gu32;
#define XB_TMO      128
#define XB_XCNT(j)  (256  + 64 * (j))
#define XB_XSUB(j)  (1280 + 64 * (j))
#define XB_XGEN(j)  (2304 + 64 * (j))
#define XB_TOP      3328
#define XB_TOPGEN   3392
#define XCD_BAR_WORDS 3456
#define XB_SPIN_CAP (1u << 18)
__device__ __forceinline__ unsigned xb_ld(unsigned* p)              { return __hip_atomic_load((GAS unsigned*)p, __ATOMIC_RELAXED, __HIP_MEMORY_SCOPE_AGENT); }
__device__ __forceinline__ unsigned xb_add(unsigned* p, unsigned v) { return __hip_atomic_fetch_add((GAS unsigned*)p, v, __ATOMIC_RELAXED, __HIP_MEMORY_SCOPE_AGENT); }
__device__ __forceinline__ unsigned xb_xcc_id() { return (unsigned)__builtin_amdgcn_s_getreg((3 << 11) | 20) & 0xFu; }
#define XB_SPIN(cond, bar) do { unsigned _sp = 0; while (cond) { __builtin_amdgcn_s_sleep(1); \
    if ((++_sp & 255u) == 0u) { if (xb_ld(&(bar)[XB_TMO])) break; if (_sp > XB_SPIN_CAP) { (void)xb_add(&(bar)[XB_TMO], 1u); break; } } } } while (0)
struct XcdBarrier { unsigned* bar; unsigned x; volatile LAS unsigned* st; int wave; };
__device__ __forceinline__ XcdBarrier xcd_barrier_post(unsigned* bar, volatile LAS unsigned* st, int wave) {
    XcdBarrier b; b.bar = bar; b.x = xb_xcc_id(); b.st = st; b.wave = wave;
    if (wave == 0 && lane_id() == 0) (void)xb_add(&bar[XB_XCNT(b.x)], 1u);
    return b;
}
__device__ __forceinline__ void xcd_barrier_complete(unsigned* bar, unsigned x, unsigned& nloc, unsigned& nx) {
    const unsigned G = gridDim.x * gridDim.y * gridDim.z;
    unsigned sum, cnt, mine, sp = 0u;
    for (;;) {
        sum = 0u; cnt = 0u; mine = 0u;
#pragma unroll
        for (unsigned j = 0; j < 16; ++j) { const unsigned c = xb_ld(&bar[XB_XCNT(j)]); sum += c; cnt += (c > 0u) ? 1u : 0u; mine = (j == x) ? c : mine; }
        if (sum == G) break;
        __builtin_amdgcn_s_sleep(1);
        if ((++sp & 255u) == 0u) { if (xb_ld(&bar[XB_TMO])) break; if (sp > XB_SPIN_CAP) { (void)xb_add(&bar[XB_TMO], 1u); break; } }
    }
    nloc = mine > 0u ? mine : 1u; nx = cnt > 0u ? cnt : 1u;
}
__device__ __forceinline__ void xcd_barrier(const XcdBarrier& b) {
    asm volatile("s_waitcnt vmcnt(0)" ::: "memory");
    __syncthreads();
    if (b.wave == 0 && lane_id() == 0) {
        unsigned* bar = b.bar; asm volatile("" : "+s"(bar));
        __builtin_amdgcn_s_waitcnt(0);
        unsigned nloc = b.st[0], nx = b.st[1];
        if (nloc == 0u) { xcd_barrier_complete(bar, b.x, nloc, nx); b.st[0] = nloc; b.st[1] = nx; }
        const unsigned old = xb_add(&bar[XB_XSUB(b.x)], 1u);
        const unsigned gen = old / nloc;
        if (old + 1u == (gen + 1u) * nloc) {
            __builtin_amdgcn_fence(__ATOMIC_RELEASE, "agent");
            asm volatile("s_waitcnt vmcnt(0)" ::: "memory");
            const unsigned og = xb_add(&bar[XB_TOP], 1u);
            const unsigned tg = og / nx;
            if (og + 1u == (tg + 1u) * nx) xb_add(&bar[XB_TOPGEN], 1u);
            else XB_SPIN(xb_ld(&bar[XB_TOPGEN]) == tg, bar);
            __builtin_amdgcn_fence(__ATOMIC_ACQUIRE, "agent");
            xb_add(&bar[XB_XGEN(b.x)], 1u);
            asm volatile("s_waitcnt vmcnt(0)" ::: "memory");
        } else {
            XB_SPIN(xb_ld(&bar[XB_XGEN(b.x)]) == gen, bar);
            __builtin_amdgcn_fence(__ATOMIC_ACQUIRE, "agent");
            asm volatile("s_waitcnt vmcnt(0)" ::: "memory");
        }
    }
    __syncthreads();
}

__device__ __forceinline__ const float* res_in0(KArgs a, int b, int p) {
    return (p < CTXL) ? a->in[2] + ((size_t)b * CTXL + p) * DM : a->in[0] + ((size_t)b * SEQ + (p - CTXL)) * DM;
}
__device__ __forceinline__ bf16_t* res_bf(KArgs a, int b, int p) {
    return (p < CTXL) ? (bf16_t*)(a->ws + WS_XC) + ((size_t)b * CTXL + p) * DM : (bf16_t*)(a->out + ((size_t)b * SEQ + (p - CTXL)) * DM);
}
__device__ __forceinline__ const float* mod_ptr(KArgs a, int layer, int b, bool isctx, int seg) {
    return (const float*)(a->ws + WS_MOD) + ((size_t)layer * 17 + (isctx ? 16 : b)) * (6 * DM) + (size_t)seg * DM;
}

template <bool F8>
__device__ __forceinline__ void transpose_item(const float* W, int K, int N, void* WTv, int rowmode, const float* kscale, LAS float* scr, int item, int lane) {
    const int nblk = N / 32, g = item >> 3, kbh = g / nblk, nb = g - kbh * nblk, kb = kbh * 8 + (item & 7), k0 = 64 * kb, n0 = 32 * nb;
    const int kq = lane >> 3, nq = (lane & 7) * 4;
    f32x4 v[8];
#pragma unroll
    for (int i = 0; i < 8; ++i) v[i] = *(const GAS f32x4*)((const GAS float*)W + (size_t)(k0 + 8 * i + kq) * N + n0 + nq);
#pragma unroll
    for (int i = 0; i < 8; ++i) { const int kk = 8 * i + kq; const int k = k0 + kk;
        if (kscale != nullptr && k >= 1024) v[i] *= kscale[(k - 1024) & 255] * ONE_M_LI;
        LAS float* d = scr + kk * 33 + nq; d[0] = v[i][0]; d[1] = v[i][1]; d[2] = v[i][2]; d[3] = v[i][3]; }
    LDS_WAIT(); asm volatile("" ::: "memory");
    const int c = lane & 7;
#pragma unroll
    for (int j = 0; j < 4; ++j) { const int n = (lane >> 3) + 8 * j; const LAS float* s = scr + (8 * c) * 33 + n;
        const int ng = n0 + n; const int dest = (rowmode == 0) ? ng : ((ng >> 7) * 256 + (ng & 127) + (rowmode == 2 ? 128 : 0));
        if constexpr (F8) { u32x2 o; o.x = cvt4_fp8(s[0 * 33] * W8SCALE, s[1 * 33] * W8SCALE, s[2 * 33] * W8SCALE, s[3 * 33] * W8SCALE); o.y = cvt4_fp8(s[4 * 33] * W8SCALE, s[5 * 33] * W8SCALE, s[6 * 33] * W8SCALE, s[7 * 33] * W8SCALE);
            *(GAS u32x2*)((GAS unsigned char*)WTv + (size_t)dest * K + k0 + 8 * c) = o; }
        else { u32x4 o; o.x = cvt_pk_bf16(s[0 * 33], s[1 * 33]); o.y = cvt_pk_bf16(s[2 * 33], s[3 * 33]); o.z = cvt_pk_bf16(s[4 * 33], s[5 * 33]); o.w = cvt_pk_bf16(s[6 * 33], s[7 * 33]);
            *(u32x4*)((bf16_t*)WTv + (size_t)dest * K + k0 + 8 * c) = o; } }
    LDS_WAIT(); asm volatile("" ::: "memory");
}
struct TrItem { const float* W; unsigned char* WT; const float* ks; int K, N, rowmode, k0, n0; };
__device__ __forceinline__ void tr_set(TrItem& t, const float* W, int K, int N, unsigned char* WT, int rowmode, const float* ks, int item) {
    const int nblk = N / 32, g = item >> 3, kbh = g / nblk, nb = g - kbh * nblk, kb = kbh * 8 + (item & 7);
    t.W = W; t.WT = WT; t.ks = ks; t.K = K; t.N = N; t.rowmode = rowmode; t.k0 = 64 * kb; t.n0 = 32 * nb;
}
__device__ __forceinline__ void tr_load(const TrItem& t, int lane, f32x4* v) {
    const int kq = lane >> 3, nq = (lane & 7) * 4;
#pragma unroll
    for (int i = 0; i < 8; ++i) v[i] = *(const GAS f32x4*)((const GAS float*)t.W + (size_t)(t.k0 + 8 * i + kq) * t.N + t.n0 + nq);
}
__device__ __forceinline__ void tr_stage(const TrItem& t, int lane, f32x4* v, LAS float* scr) {
    const int kq = lane >> 3, nq = (lane & 7) * 4;
#pragma unroll
    for (int i = 0; i < 8; ++i) { const int kk = 8 * i + kq; const int k = t.k0 + kk;
        if (t.ks != nullptr && k >= 1024) v[i] *= t.ks[(k - 1024) & 255] * ONE_M_LI;
        LAS float* d = scr + kk * 33 + nq; d[0] = v[i][0]; d[1] = v[i][1]; d[2] = v[i][2]; d[3] = v[i][3]; }
    LDS_WAIT(); asm volatile("" ::: "memory");
}
__device__ __forceinline__ void tr_store(const TrItem& t, int lane, const LAS float* scr) {
    const int c = lane & 7;
#pragma unroll
    for (int j = 0; j < 4; ++j) { const int n = (lane >> 3) + 8 * j; const LAS float* s = scr + (8 * c) * 33 + n;
        const int ng = t.n0 + n; const int dest = (t.rowmode == 0) ? ng : ((ng >> 7) * 256 + (ng & 127) + (t.rowmode == 2 ? 128 : 0));
        u32x2 o; o.x = cvt4_fp8(s[0 * 33] * W8SCALE, s[1 * 33] * W8SCALE, s[2 * 33] * W8SCALE, s[3 * 33] * W8SCALE); o.y = cvt4_fp8(s[4 * 33] * W8SCALE, s[5 * 33] * W8SCALE, s[6 * 33] * W8SCALE, s[7 * 33] * W8SCALE);
        *(GAS u32x2*)((GAS unsigned char*)t.WT + (size_t)dest * t.K + t.k0 + 8 * c) = o; }
    LDS_WAIT(); asm volatile("" ::: "memory");
}
template <int DEPTH, class Dec>
__device__ __forceinline__ void tr_pipeline(Dec decode, int e0, int estep, int etot, int lane, LAS float* scr) {
    f32x4 v[DEPTH][8]; TrItem t[DEPTH];
#pragma unroll
    for (int i = 0; i < DEPTH; ++i) if (e0 + i * estep < etot) { decode(e0 + i * estep, t[i]); tr_load(t[i], lane, v[i]); }
    for (int e = e0; e < etot; e += DEPTH * estep) {
#pragma unroll
        for (int i = 0; i < DEPTH; ++i) {
            if (e + i * estep < etot) { tr_stage(t[i], lane, v[i], scr); const TrItem tc = t[i];
                if (e + (i + DEPTH) * estep < etot) { decode(e + (i + DEPTH) * estep, t[i]); tr_load(t[i], lane, v[i]); }
                tr_store(tc, lane, scr); } }
    }
}
#if MK_MULTI
constexpr int DEF_DOWN = 0, DEF_UP = 0, DEF_GATE = 0, DEF_S1 = 0, DEF_S2 = 0, DEF_S3 = 0;
#else
constexpr int DEF_DOWN = 16384, DEF_UP = 16384, DEF_GATE = 16384, DEF_S1 = 17920, DEF_S2 = 28160, DEF_S3 = 42496;
#endif
constexpr int DEF_TOTAL = DEF_DOWN + DEF_UP + DEF_GATE;
__device__ __forceinline__ void deferred_items(KArgs a, LAS unsigned char* lds, int slot, int c, int ntot, int G, int wave, int lane) {
    const int rem = ntot % G; const int rank = rem ? c - rem : c, nidle = rem ? G - rem : G;
    if (rank < 0) return;
    const int lo = slot == 0 ? 0 : slot == 1 ? DEF_S1 : slot == 2 ? DEF_S2 : DEF_S3, hi = slot == 0 ? DEF_S1 : slot == 1 ? DEF_S2 : slot == 2 ? DEF_S3 : DEF_TOTAL;
    __syncthreads();
    LAS float* scr = (LAS float*)(lds + wave * 16384);
    auto decode = [&](int d, TrItem& t) {
        if (d < DEF_DOWN) { const int r = 16384 + d; const int le = r >> 10, ri = r & 1023; tr_set(t, a->in[27] + (size_t)le * FF * DM, FF, DM, (unsigned char*)(a->ws + WS_WD) + (size_t)le * DM * FF, 0, nullptr, ri); }
        else if (d < DEF_DOWN + DEF_UP) { const int r = 16384 + (d - DEF_DOWN); const int le = r >> 10, ri = r & 1023; tr_set(t, a->in[26] + (size_t)le * DM * FF, DM, FF, (unsigned char*)(a->ws + WS_WGU) + (size_t)le * DM * DM, 2, nullptr, ri); }
        else { const int r = 16384 + (d - DEF_DOWN - DEF_UP); const int le = r >> 10, ri = r & 1023; tr_set(t, a->in[25] + (size_t)le * DM * FF, DM, FF, (unsigned char*)(a->ws + WS_WGU) + (size_t)le * DM * DM, 1, nullptr, ri); }
    };
    tr_pipeline<2>(decode, lo + rank * 8 + wave, nidle * 8, hi, lane, scr);
    __syncthreads();
}
constexpr int CONV0_TOTAL = 2048 + 3 * 16384;
__device__ __forceinline__ void conv_layer0_burst(KArgs a, LAS unsigned char* lds, int c, int G, int wave, int lane) {
    __syncthreads();
    LAS float* scr = (LAS float*)(lds + wave * 16384);
    auto decode = [&](int e, TrItem& t) {
        if (e < 2048) tr_set(t, a->in[11], DM, DM, (unsigned char*)(a->ws + WS_WOUT), 0, nullptr, e);
        else { const int x = e - 2048, kind = x >> 14, r = x & 16383, le = r >> 10, ri = r & 1023;
            if (kind == 0) tr_set(t, a->in[25] + (size_t)le * DM * FF, DM, FF, (unsigned char*)(a->ws + WS_WGU) + (size_t)le * DM * DM, 1, nullptr, ri);
            else if (kind == 1) tr_set(t, a->in[26] + (size_t)le * DM * FF, DM, FF, (unsigned char*)(a->ws + WS_WGU) + (size_t)le * DM * DM, 2, nullptr, ri);
            else tr_set(t, a->in[27] + (size_t)le * FF * DM, FF, DM, (unsigned char*)(a->ws + WS_WD) + (size_t)le * DM * FF, 0, nullptr, ri); }
    };
    tr_pipeline<4>(decode, c * 8 + wave, G * 8, CONV0_TOTAL, lane, scr);
    __syncthreads();
}
__device__ __forceinline__ void phase_prologue(KArgs a, LAS unsigned char* lds, int tid, int lane, int wave, int G) {
    const int bx = blockIdx.x;
    if (bx < 192) {
        const int l = bx / 96, jg = bx - l * 96;
        LAS float* S = (LAS float*)lds;
        for (int idx = tid; idx < 17 * DM; idx += 512) { const int r = idx >> 11, k = idx & 2047; const float v = (r < 16) ? a->in[1][r * DM + k] : a->in[3][k]; S[idx] = v / (1.0f + __expf(-v)); }
        __syncthreads();
        const int c2 = tid & 63, kp = wave;
        const float* wbase = a->in[4] + (size_t)l * DM * (6 * DM) + jg * 128 + 2 * c2;
        float acc0[17], acc1[17];
#pragma unroll
        for (int r = 0; r < 17; ++r) { acc0[r] = 0.f; acc1[r] = 0.f; }
        for (int k16 = 0; k16 < 16; ++k16) {
            const int k = kp * 256 + k16 * 16;
            f32x2 w[16];
#pragma unroll
            for (int q = 0; q < 16; ++q) w[q] = *(const f32x2*)(wbase + (size_t)(k + q) * (6 * DM));
#pragma unroll
            for (int r = 0; r < 17; ++r) {
#pragma unroll
                for (int g = 0; g < 4; ++g) { const f32x4 s4 = *(const LAS f32x4*)(S + r * DM + k + 4 * g);
#pragma unroll
                    for (int q = 0; q < 4; ++q) { acc0[r] += s4[q] * w[4 * g + q].x; acc1[r] += s4[q] * w[4 * g + q].y; } }
                __builtin_amdgcn_sched_barrier(0); }
        }
        __syncthreads();
        LAS float* P = (LAS float*)lds;
#pragma unroll
        for (int r = 0; r < 17; ++r) { P[(kp * 17 + r) * 128 + 2 * c2] = acc0[r]; P[(kp * 17 + r) * 128 + 2 * c2 + 1] = acc1[r]; }
        __syncthreads();
        float* MOD = (float*)(a->ws + WS_MOD);
        for (int idx = tid; idx < 17 * 128; idx += 512) { const int r = idx >> 7, cc = idx & 127; float s = 0.f;
#pragma unroll
            for (int q = 0; q < 8; ++q) s += P[(q * 17 + r) * 128 + cc];
            const int col = jg * 128 + cc; MOD[((size_t)l * 17 + r) * (6 * DM) + col] = s + a->in[5][l * (6 * DM) + col]; }
        VM_WAIT(); __syncthreads();
        if (bx < 32 && tid == 0) { __builtin_amdgcn_fence(__ATOMIC_RELEASE, "agent"); (void)xb_add((unsigned*)(a->ws + WS_CTL) + CW_MODF, 1u); }
    }
    {
        float* CS = (float*)(a->ws + WS_CS);
        for (int idx = bx * 512 + tid; idx < SEQ * 64; idx += G * 512) { const int t = idx >> 6, p = idx & 63; const int i = p & 31;
            const float inv = powf(10000.0f, -(float)i / 32.0f); const float pos = (p < 32) ? (float)(t / GRIDW) : (float)(t % GRIDW); const float ang = pos * inv;
            CS[2 * idx] = cosf(ang); CS[2 * idx + 1] = sinf(ang); }
    }
    {
        LAS float* scr = (LAS float*)(lds + wave * 16384);
        const int gwv = bx * 8 + wave, NGW = G * 8;
        constexpr int I_IN = 32 * 144, I_OUT = 32 * 64, I_E = 1024;
        constexpr int NITEMS = 2 * I_IN + 2 * I_OUT + 3 * 32 * I_E;
        bf16_t* WIN = (bf16_t*)(a->ws + WS_WIN); bf16_t* WOUT = (bf16_t*)(a->ws + WS_WOUT); bf16_t* WGU = (bf16_t*)(a->ws + WS_WGU); bf16_t* WD = (bf16_t*)(a->ws + WS_WD);
        constexpr int CUTG = 2 * I_IN + 2 * I_OUT + 16 * I_E, CUTU = 2 * I_IN + 2 * I_OUT + 32 * I_E + 16 * I_E, NKEEP = 2 * I_IN + I_OUT;     (void)CUTG; (void)CUTU;
        const int nfw = (G > 192) ? (G - 192) * 8 : 0, HEAD = nfw * 16;
        for (int k = (bx >= 192 ? 0 : 16); ; ++k) { const int n = k < 16 ? (bx - 192) * 8 + wave + nfw * k : HEAD + gwv + NGW * (k - 16); if (n >= NKEEP) break;
            const int it = n < 2 * I_IN ? n : n + I_OUT;
            int r = it;
            if (r < I_IN) { transpose_item<true>(a->in[10], DM, NQKV, (unsigned char*)WIN, 0, nullptr, scr, r, lane); continue; } r -= I_IN;
            if (r < I_IN) { transpose_item<true>(a->in[14], DM, NQKV, (unsigned char*)WIN + (size_t)NQKV * DM, 0, nullptr, scr, r, lane); continue; } r -= I_IN;
            if (r < I_OUT) { transpose_item<true>(a->in[11], DM, DM, (unsigned char*)WOUT, 0, nullptr, scr, r, lane); continue; } r -= I_OUT;
            if (r < I_OUT) { transpose_item<true>(a->in[15], DM, DM, (unsigned char*)WOUT + (size_t)DM * DM, 0, a->in[22], scr, r, lane); continue; } r -= I_OUT;
            if (r < 32 * I_E) { const int le = r >> 10, ri = r & 1023; transpose_item<true>(a->in[25] + (size_t)le * DM * FF, DM, FF, (unsigned char*)WGU + (size_t)le * DM * DM, 1, nullptr, scr, ri, lane); continue; } r -= 32 * I_E;
            if (r < 32 * I_E) { const int le = r >> 10, ri = r & 1023; transpose_item<true>(a->in[26] + (size_t)le * DM * FF, DM, FF, (unsigned char*)WGU + (size_t)le * DM * DM, 2, nullptr, scr, ri, lane); continue; } r -= 32 * I_E;
            { const int le = r >> 10, ri = r & 1023; transpose_item<true>(a->in[27] + (size_t)le * FF * DM, FF, DM, (unsigned char*)WD + (size_t)le * DM * FF, 0, nullptr, scr, ri, lane); }
        }
    }
}

__device__ __forceinline__ void phase_h0(KArgs a, LAS unsigned char* lds, int tid, int lane, int wave) {
    unsigned char* H = (unsigned char*)(a->ws + WS_H);
    const int bx = blockIdx.x, b = bx >> 4; LAS float* L = (LAS float*)lds;
    __syncthreads();
    if (tid == 0) { unsigned* f = (unsigned*)(a->ws + WS_CTL) + CW_MODF; unsigned sp = 0u; while (xb_ld(f) < 32u) { __builtin_amdgcn_s_sleep(1); if (++sp > (1u << 22)) break; } __builtin_amdgcn_fence(__ATOMIC_ACQUIRE, "agent"); }
    __syncthreads();
    for (int k = tid; k < DM; k += 512) { L[k] = mod_ptr(a, 0, b, false, 1)[k] + 1.0f; L[DM + k] = mod_ptr(a, 0, b, false, 0)[k]; L[2 * DM + k] = mod_ptr(a, 0, b, true, 1)[k] + 1.0f; L[3 * DM + k] = mod_ptr(a, 0, b, true, 0)[k]; }
    __syncthreads();
    const unsigned l16 = lane * 16, l4 = lane * 4;
    for (int i0 = wave; i0 < 144; i0 += 24) {
        f32x4 xv[3][8];
#pragma unroll
        for (int q = 0; q < 3; ++q) { const int row = bx * 144 + i0 + 8 * q, p = row - b * PB; const float* x = res_in0(a, b, p); asm volatile("" : "+s"(x));
#pragma unroll
            for (int j = 0; j < 8; ++j) xv[q][j] = *(const GAS f32x4*)((const GAS char*)x + l16 + j * 1024); }
#pragma unroll
        for (int q = 0; q < 3; ++q) { const int row = bx * 144 + i0 + 8 * q, p = row - b * PB; const bool isctx = p < CTXL;
            unsigned char* hp = H + (size_t)row * DM; asm volatile("" : "+s"(hp));
            const LAS unsigned char* V = lds + (isctx ? 2 * DM * 4 : 0);
#pragma unroll
            for (int j = 0; j < 8; ++j) { const f32x4 s1 = *(const LAS f32x4*)(V + l16 + j * 1024), s0 = *(const LAS f32x4*)(V + DM * 4 + l16 + j * 1024);
                const f32x4 h = xv[q][j] * s1 + s0; *(GAS unsigned*)((GAS unsigned char*)hp + l4 + j * 256) = cvt4_fp8(h[0], h[1], h[2], h[3]); } }
    }
    __syncthreads();
}

__device__ __forceinline__ void phase_prep(KArgs a, int lane, int gwv, int ngw) {
    const bf16_t* RAW = (const bf16_t*)(a->ws + WS_QKV); const float* CS = (const float*)(a->ws + WS_CS); unsigned char* K8 = (unsigned char*)(a->ws + WS_K8);
    const f32x2 gk = *(const f32x2*)(a->in[17] + 2 * lane);
    for (int row0 = gwv; row0 < MROWS; row0 += 3 * ngw) {
        unsigned w[3][2]; f32x2 cs[3];
#pragma unroll
        for (int q = 0; q < 3; ++q) { const int row = row0 + q * ngw; if (row >= MROWS) continue; const int b = row / PB, p = row - b * PB; const bool isctx = p < CTXL;
            cs[q] = (f32x2){1.f, 0.f}; if (!isctx) cs[q] = *(const f32x2*)(CS + ((size_t)(p - CTXL) * 64 + lane) * 2);
            w[q][0] = *((const unsigned*)(RAW + (size_t)row * 1280 + 8 * HD) + lane); w[q][1] = *((const unsigned*)(RAW + (size_t)row * 1280 + 9 * HD) + lane); }
#pragma unroll
        for (int q = 0; q < 3; ++q) { const int row = row0 + q * ngw; if (row >= MROWS) continue;
#pragma unroll
            for (int h = 0; h < 2; ++h) {
                const float x0 = bf_lo(w[q][h]), x1 = bf_hi(w[q][h]); const float ss = wave_sum(x0 * x0 + x1 * x1);
                const float rstd = 1.0f / sqrtf(ss * (1.0f / 128.0f) + 1e-6f);
                const float y0 = x0 * rstd * gk.x, y1 = x1 * rstd * gk.y;
                const float r0 = y0 * cs[q].x - y1 * cs[q].y, r1 = y0 * cs[q].y + y1 * cs[q].x;
                *((unsigned short*)(K8 + (size_t)row * 1280 + h * HD) + lane) = (unsigned short)__builtin_amdgcn_cvt_pk_fp8_f32(r0, r1, 0, false);
            } }
    }
}

__device__ __forceinline__ void phase_combine(KArgs a, int lane, int gwv, int ngw) {
    const bf16_t* OD = (const bf16_t*)(a->ws + WS_H); unsigned char* O = (unsigned char*)(a->ws + WS_O);
    float lam;
    { const f32x2 q1 = *(const f32x2*)(a->in[18] + 2 * lane), k1 = *(const f32x2*)(a->in[19] + 2 * lane), q2 = *(const f32x2*)(a->in[20] + 2 * lane), k2 = *(const f32x2*)(a->in[21] + 2 * lane);
      const float d1 = wave_sum(q1.x * k1.x + q1.y * k1.y), d2 = wave_sum(q2.x * k2.x + q2.y * k2.y); lam = expf(d1) - expf(d2) + LAMBDA_INIT1; }
    for (int lr = gwv; lr < NB * SEQ; lr += ngw) {
        const int b = lr / SEQ, t = lr - b * SEQ; const int row = b * PB + CTXL + t;
        u32x2 w0[4], w1[4];
#pragma unroll
        for (int h = 0; h < 4; ++h) { w0[h] = *(const u32x2*)(OD + (size_t)row * 1024 + h * 256 + 4 * lane); w1[h] = *(const u32x2*)(OD + (size_t)MROWS * 1024 + (size_t)row * 1024 + h * 256 + 4 * lane); }
#pragma unroll
        for (int h = 0; h < 4; ++h) {
            const float d0 = bf_lo(w0[h].x) - lam * bf_lo(w1[h].x), d1 = bf_hi(w0[h].x) - lam * bf_hi(w1[h].x), d2 = bf_lo(w0[h].y) - lam * bf_lo(w1[h].y), d3 = bf_hi(w0[h].y) - lam * bf_hi(w1[h].y);
            const float ss = wave_sum(d0 * d0 + d1 * d1 + d2 * d2 + d3 * d3); const float rstd = 1.0f / sqrtf(ss * (1.0f / 256.0f) + 1e-6f);
            const float rs = rstd * att_OSCALE;
            *(unsigned*)(O + (size_t)row * DM + 1024 + h * 256 + 4 * lane) = cvt4_fp8(d0 * rs, d1 * rs, d2 * rs, d3 * rs);
        }
    }
}
#define UNI(p) asm volatile("" : "+s"(p))
#define LD4F(p, j) (*(const GAS f32x4*)((const GAS char*)(p) + l16 + (j) * 1024))
#define LD4H(p, j) (*(const GAS u32x2*)((const GAS char*)(p) + l8 + (j) * 512))
#define LD4B(p, j) (*(const GAS unsigned*)((const GAS char*)(p) + l4 + (j) * 256))
__device__ __forceinline__ int ln_row(int layer, int n) { return layer == 0 ? n : (n >> 11) * PB + CTXL + (n & 2047); }
__device__ __forceinline__ void phase_ln1(KArgs a, int layer, LAS unsigned char* lds, int tid, int lane, int gwv, int ngw, bool dry = false) {
    LAS float* WT = (LAS float*)lds;
    for (int k = tid; k < DM; k += 512) { const f32x4* wr = (const f32x4*)(a->in[23] + (size_t)k * 16);
#pragma unroll
        for (int c = 0; c < 4; ++c) { const f32x4 w = wr[c]; WT[(4 * c + 0) * DM + k] = w[0]; WT[(4 * c + 1) * DM + k] = w[1]; WT[(4 * c + 2) * DM + k] = w[2]; WT[(4 * c + 3) * DM + k] = w[3]; } }
    const int wg_ = gwv >> 3; const bool stc = (layer == 0) && ((wg_ & 15) < 2); const int sb_ = wg_ >> 4;
    LAS float* A2 = (LAS float*)(lds + RING_BYTES); LAS float* B2 = A2 + DM; LAS bf16_t* G1h = (LAS bf16_t*)(lds + RING_BYTES + 16384); LAS bf16_t* LGh = G1h + DM; LAS bf16_t* LBh = LGh + DM;
    for (int k = tid; k < DM; k += 512) { const float lg = a->in[6][layer * DM + k], lb = a->in[7][layer * DM + k], s2 = mod_ptr(a, layer, sb_, stc, 4)[k] + 1.0f, sh = mod_ptr(a, layer, sb_, stc, 3)[k];
        A2[k] = lg * s2; B2[k] = lb * s2 + sh; const unsigned w = cvt_pk_bf16(mod_ptr(a, layer, sb_, stc, 2)[k], lg); G1h[k] = (bf16_t)(w & 0xffffu); LGh[k] = (bf16_t)(w >> 16); LBh[k] = (bf16_t)(cvt_pk_bf16(lb, lb) & 0xffffu); }
    LAS unsigned* lcnt = (LAS unsigned*)(lds + RING_BYTES + 16384 + 12288); LAS unsigned* nent = lcnt + 16; LAS unsigned* gbase = lcnt + 32; LAS unsigned* ent = lcnt + 64;
    if (tid < 17) lcnt[tid] = 0u;
    __syncthreads();
    const unsigned l16 = lane * 16, l8 = lane * 8, l4 = lane * 4;
    float* GW = (float*)(a->ws + WS_GW); int* LIST = (int*)(a->ws + WS_LIST); int* PPOS = (int*)(a->ws + WS_PPOS); unsigned* CNT = (unsigned*)(a->ws + WS_CTL) + CW_CNT + layer * 16 * 64;
    const int NV = layer == 0 ? MROWS : NB * SEQ;
    const int my_e = (lane >> 1) & 15, my_g = my_e >> 2, my_i = my_e & 3;
    const float my_rb = a->in[24][my_e];
    const int npw = NV / 2 / (ngw >> 3), wv = gwv & 7, pr0 = (gwv >> 3) * npw;
    for (int pi = wv; pi < npw; pi += 8) { const int pr = pr0 + pi;
        f32x4 v[2][8]; int rows[2];
        const int row0 = ln_row(layer, 2 * pr); rows[0] = row0; rows[1] = row0 + 1;
        const int b = row0 / PB, p = row0 - b * PB; const bool isctx = p < CTXL;
        const float* g1 = mod_ptr(a, layer, b, isctx, 2); const float* sh2 = mod_ptr(a, layer, b, isctx, 3); const float* sc2 = mod_ptr(a, layer, b, isctx, 4);
        const float* lng = a->in[6] + layer * DM; const float* lnb = a->in[7] + layer * DM; UNI(lng); UNI(lnb);
        const float* x0 = res_in0(a, b, p); const float* x1p = res_in0(a, b, p + 1); bf16_t* xb0 = res_bf(a, b, p); bf16_t* xb1 = res_bf(a, b, p + 1);
        const unsigned char* y0 = (const unsigned char*)(a->ws + WS_QKV) + (size_t)row0 * DM; const unsigned char* y1 = y0 + DM;
        unsigned char* h80 = (unsigned char*)(a->ws + WS_H) + (size_t)row0 * DM; unsigned char* h81 = h80 + DM;
        bf16_t* xo0 = xb0; bf16_t* xo1 = xb1;
        if (dry) { xo0 = (bf16_t*)(a->ws + WS_QN) + (size_t)row0 * DM; xo1 = xo0 + DM; h80 = (unsigned char*)(a->ws + WS_QN + 160 * MiB) + (size_t)row0 * DM; h81 = h80 + DM; }
        UNI(g1); UNI(sh2); UNI(sc2); UNI(x0); UNI(x1p); UNI(xb0); UNI(xb1); UNI(y0); UNI(y1); UNI(h80); UNI(h81); UNI(xo0); UNI(xo1);
        float s0 = 0.f, s1 = 0.f;
        const bool fast = (isctx == stc);
#pragma unroll
        for (int j = 0; j < 8; ++j) { f32x4 gv; if (fast) { const u32x2 gw_ = *(const LAS u32x2*)((const LAS unsigned char*)G1h + l8 + j * 512); gv[0] = bf_lo(gw_.x); gv[1] = bf_hi(gw_.x); gv[2] = bf_lo(gw_.y); gv[3] = bf_hi(gw_.y); } else gv = LD4F(g1, j);
#pragma unroll
            for (int q = 0; q < 2; ++q) { f32x4 xv; if (layer == 0) xv = LD4F(q ? x1p : x0, j); else { const u32x2 xw = LD4H(q ? xb1 : xb0, j); xv[0] = bf_lo(xw.x); xv[1] = bf_hi(xw.x); xv[2] = bf_lo(xw.y); xv[3] = bf_hi(xw.y); }
                const f32x4 yv = fp8x4_to_f32(LD4B(q ? y1 : y0, j)) * (1.0f / Y8SCALE);
                v[q][j] = xv * ALPHA + gv * yv; const float ss = (v[q][j][0] + v[q][j][1]) + (v[q][j][2] + v[q][j][3]); if (q) s1 += ss; else s0 += ss; } }
        const float mean0 = wave_sum(s0) * (1.0f / DM), mean1 = wave_sum(s1) * (1.0f / DM); float q0 = 0.f, q1 = 0.f;
#pragma unroll
        for (int j = 0; j < 8; ++j) { v[0][j] = v[0][j] - mean0; q0 += (v[0][j][0] * v[0][j][0] + v[0][j][1] * v[0][j][1]) + (v[0][j][2] * v[0][j][2] + v[0][j][3] * v[0][j][3]);
            v[1][j] = v[1][j] - mean1; q1 += (v[1][j][0] * v[1][j][0] + v[1][j][1] * v[1][j][1]) + (v[1][j][2] * v[1][j][2] + v[1][j][3] * v[1][j][3]); }
        const float rstd0 = 1.0f / sqrtf(wave_sum(q0) * (1.0f / DM) + 1e-5f), rstd1 = 1.0f / sqrtf(wave_sum(q1) * (1.0f / DM) + 1e-5f);
#pragma unroll
        for (int j = 0; j < 8; ++j) { f32x4 lg4, lb4, a4, b4;
            if (fast) { const u32x2 gw_ = *(const LAS u32x2*)((const LAS unsigned char*)LGh + l8 + j * 512), bw_ = *(const LAS u32x2*)((const LAS unsigned char*)LBh + l8 + j * 512);
                lg4[0] = bf_lo(gw_.x); lg4[1] = bf_hi(gw_.x); lg4[2] = bf_lo(gw_.y); lg4[3] = bf_hi(gw_.y); lb4[0] = bf_lo(bw_.x); lb4[1] = bf_hi(bw_.x); lb4[2] = bf_lo(bw_.y); lb4[3] = bf_hi(bw_.y);
                a4 = *(const LAS f32x4*)((const LAS unsigned char*)A2 + l16 + j * 1024); b4 = *(const LAS f32x4*)((const LAS unsigned char*)B2 + l16 + j * 1024); }
            else { lg4 = LD4F(lng, j); lb4 = LD4F(lnb, j); const f32x4 s4 = LD4F(sc2, j) + 1.0f; a4 = lg4 * s4; b4 = lb4 * s4 + LD4F(sh2, j); }
#pragma unroll
            for (int q = 0; q < 2; ++q) { const f32x4 nn = v[q][j] * (q ? rstd1 : rstd0); const f32x4 x1 = nn * lg4 + lb4;
                { u32x2 w; w.x = cvt_pk_bf16(x1[0], x1[1]); w.y = cvt_pk_bf16(x1[2], x1[3]); *(GAS u32x2*)((GAS char*)(q ? xo1 : xo0) + l8 + j * 512) = w; }
                const f32x4 h2 = nn * a4 + b4; v[q][j] = h2;
                *(GAS unsigned*)((GAS unsigned char*)(q ? h81 : h80) + l4 + j * 256) = cvt4_fp8(h2[0], h2[1], h2[2], h2[3]); } }
        if (LN1_DRYVAR >= 1 && dry) continue;
        float t[32];
#pragma unroll
        for (int e = 0; e < 16; ++e) { float t0 = 0.f, t1 = 0.f;
#pragma unroll
            for (int j = 0; j < 8; ++j) { const f32x4 w4 = *(const LAS f32x4*)(WT + e * DM + 4 * lane + 256 * j);
                t0 += (v[0][j][0] * w4[0] + v[0][j][1] * w4[1]) + (v[0][j][2] * w4[2] + v[0][j][3] * w4[3]);
                t1 += (v[1][j][0] * w4[0] + v[1][j][1] * w4[1]) + (v[1][j][2] * w4[2] + v[1][j][3] * w4[3]); }
            t[e] = t0; t[16 + e] = t1; }
#define RSTEP(N, BIT, OFF) _Pragma("unroll") for (int i = 0; i < N; ++i) { const bool up = (lane & BIT) != 0; const float send = up ? t[i] : t[N + i], keep = up ? t[N + i] : t[i]; t[i] = keep + __shfl_xor(send, OFF); }
        RSTEP(16, 32, 32) RSTEP(8, 16, 16) RSTEP(4, 8, 8) RSTEP(2, 4, 4) RSTEP(1, 2, 2)
#undef RSTEP
        const float lg = t[0] + __shfl_xor(t[0], 1);
        const float sc = 1.0f / (1.0f + __expf(-lg)), bi = sc + my_rb;
        const float b1 = __shfl_xor(bi, 2), b2 = __shfl_xor(bi, 4), b3 = __shfl_xor(bi, 6);
        const float h1 = fmaxf(bi, b1), l1 = fminf(bi, b1), h2m = fmaxf(b2, b3), l2 = fminf(b2, b3);
        const float gs = fmaxf(h1, h2m) + fmaxf(fminf(h1, h2m), fmaxf(l1, l2));
        const int rank = ((b1 > bi) || (b1 == bi && (my_i ^ 1) < my_i)) + ((b2 > bi) || (b2 == bi && (my_i ^ 2) < my_i)) + ((b3 > bi) || (b3 == bi && (my_i ^ 3) < my_i));
        const float g1s = __shfl_xor(gs, 8), g2s = __shfl_xor(gs, 16), g3s = __shfl_xor(gs, 24);
        const bool best = !((g1s > gs) || (g1s == gs && (my_g ^ 1) < my_g)) && !((g2s > gs) || (g2s == gs && (my_g ^ 2) < my_g)) && !((g3s > gs) || (g3s == gs && (my_g ^ 3) < my_g));
        const float c = (rank < 2) ? sc : 0.f;
        const float csum = c + __shfl_xor(c, 2) + __shfl_xor(c, 4) + __shfl_xor(c, 6);
        if (best && rank < 2 && (lane & 1) == 0 && !dry) {
            const int row = (lane & 32) ? rows[1] : rows[0]; const int pair = 2 * row + rank;
            const unsigned lp = __hip_atomic_fetch_add(lcnt + my_e, 1u, __ATOMIC_RELAXED, __HIP_MEMORY_SCOPE_WORKGROUP);
            const unsigned slot = __hip_atomic_fetch_add(nent, 1u, __ATOMIC_RELAXED, __HIP_MEMORY_SCOPE_WORKGROUP);
            ent[slot] = (unsigned)pair | ((unsigned)my_e << 17) | (lp << 21);
            GW[pair] = sc / csum;
        }
    }
    __syncthreads();
    if (tid < 16) { const unsigned n = lcnt[tid]; gbase[tid] = n ? __hip_atomic_fetch_add(CNT + tid * 64, n, __ATOMIC_RELAXED, __HIP_MEMORY_SCOPE_AGENT) : 0u; }
    __syncthreads();
    { const unsigned ne = nent[0]; for (unsigned i = tid; i < ne; i += 512) { const unsigned w = ent[i]; const unsigned e = (w >> 17) & 15u; const unsigned pos = gbase[e] + (w >> 21); LIST[(size_t)e * LCAP + pos] = (int)(w & 0x1FFFFu); PPOS[w & 0x1FFFFu] = (int)((e << 20) | pos); } }
}

__device__ __forceinline__ void phase_ln2(KArgs a, int layer, LAS unsigned char* lds, int tid, int lane, int gwv, int ngw, bool dry = false) {
    const unsigned l16 = lane * 16, l8 = lane * 8, l4 = lane * 4;
    const int NV = layer == 0 ? MROWS : NB * SEQ;
    const int npw = NV / 2 / (ngw >> 3), wv = gwv & 7, wg = gwv >> 3, pr0 = wg * npw, b = wg >> 4;
    LAS float* L = (LAS float*)lds;
    for (int k = tid; k < DM; k += 512) { L[k] = a->in[8][layer * DM + k]; L[DM + k] = a->in[9][layer * DM + k];
        L[2 * DM + k] = mod_ptr(a, layer, b, false, 5)[k]; L[3 * DM + k] = mod_ptr(a, 1, b, false, 1)[k] + 1.0f; L[4 * DM + k] = mod_ptr(a, 1, b, false, 0)[k];
        L[5 * DM + k] = mod_ptr(a, layer, b, true, 5)[k]; L[6 * DM + k] = mod_ptr(a, 1, b, true, 1)[k] + 1.0f; L[7 * DM + k] = mod_ptr(a, 1, b, true, 0)[k]; }
    LAS int* TBE = (LAS int*)(lds + 8 * DM * 4);
    if (tid == 0) { int base = 0; for (int e = 0; e < 16; ++e) { TBE[e] = base * 256; base += ((int)__hip_atomic_load((unsigned*)(a->ws + WS_CTL) + CW_CNT + (layer * 16 + e) * 64, __ATOMIC_RELAXED, __HIP_MEMORY_SCOPE_AGENT) + 255) >> 8; } }
    __syncthreads();
#define LV(idx, j) (*(const LAS f32x4*)(lds + (idx) * (DM * 4) + l16 + (j) * 1024))
    for (int pi = wv; pi < npw; pi += 8) { const int pr = pr0 + pi;
        const int row0 = ln_row(layer, 2 * pr);
        const int p = row0 - b * PB; const bool isctx = p < CTXL; const int vo = isctx ? 3 : 0;
        bf16_t* xo0 = res_bf(a, b, p); bf16_t* xo1 = res_bf(a, b, p + 1);
        const u32x4 pp4 = *(const u32x4*)((const int*)(a->ws + WS_PPOS) + 2 * row0); const f32x4 gw4 = *(const f32x4*)((const float*)(a->ws + WS_GW) + 2 * row0) * (1.0f / Y8SCALE);
        const unsigned char* DNS = (const unsigned char*)(a->ws + WS_QKV);
        const int sl0 = __builtin_amdgcn_readfirstlane(TBE[pp4.x >> 20] + (int)(pp4.x & 0xFFFFFu)), sl1 = __builtin_amdgcn_readfirstlane(TBE[pp4.y >> 20] + (int)(pp4.y & 0xFFFFFu));
        const int sl2 = __builtin_amdgcn_readfirstlane(TBE[pp4.z >> 20] + (int)(pp4.z & 0xFFFFFu)), sl3 = __builtin_amdgcn_readfirstlane(TBE[pp4.w >> 20] + (int)(pp4.w & 0xFFFFFu));
        const unsigned char* dn0 = DNS + (size_t)sl0 * DM; const unsigned char* dn1 = DNS + (size_t)sl1 * DM; const unsigned char* dn2 = DNS + (size_t)sl2 * DM; const unsigned char* dn3 = DNS + (size_t)sl3 * DM;
        unsigned char* hp0 = (unsigned char*)(a->ws + WS_H) + (size_t)row0 * DM; unsigned char* hp1 = hp0 + DM;
        bf16_t* xw0 = xo0; bf16_t* xw1 = xo1;
        if (dry) { xw0 = (bf16_t*)(a->ws + WS_QN) + (size_t)row0 * 2 * DM; xw1 = xw0 + 2 * DM; hp0 = (unsigned char*)(a->ws + WS_H) + (size_t)MROWS * DM + (size_t)row0 * DM; hp1 = hp0 + DM; }
        UNI(xo0); UNI(xo1); UNI(hp0); UNI(hp1); UNI(xw0); UNI(xw1);
        f32x4 v[2][8]; float s0 = 0.f, s1 = 0.f;
#pragma unroll
        for (int j = 0; j < 8; ++j) { const f32x4 gv = LV(2 + vo, j);
#pragma unroll
            for (int q = 0; q < 2; ++q) { const u32x2 xw = LD4H(q ? xo1 : xo0, j); f32x4 xv; xv[0] = bf_lo(xw.x); xv[1] = bf_hi(xw.x); xv[2] = bf_lo(xw.y); xv[3] = bf_hi(xw.y);
                const f32x4 f = fp8x4_to_f32(LD4B(q ? dn2 : dn0, j)) * (q ? gw4[2] : gw4[0]) + fp8x4_to_f32(LD4B(q ? dn3 : dn1, j)) * (q ? gw4[3] : gw4[1]);
                v[q][j] = xv * ALPHA + gv * f; const float ss = (v[q][j][0] + v[q][j][1]) + (v[q][j][2] + v[q][j][3]); if (q) s1 += ss; else s0 += ss; } }
        const float mean0 = wave_sum(s0) * (1.0f / DM), mean1 = wave_sum(s1) * (1.0f / DM); float q0 = 0.f, q1 = 0.f;
#pragma unroll
        for (int j = 0; j < 8; ++j) { v[0][j] = v[0][j] - mean0; q0 += (v[0][j][0] * v[0][j][0] + v[0][j][1] * v[0][j][1]) + (v[0][j][2] * v[0][j][2] + v[0][j][3] * v[0][j][3]);
            v[1][j] = v[1][j] - mean1; q1 += (v[1][j][0] * v[1][j][0] + v[1][j][1] * v[1][j][1]) + (v[1][j][2] * v[1][j][2] + v[1][j][3] * v[1][j][3]); }
        const float rstd0 = 1.0f / sqrtf(wave_sum(q0) * (1.0f / DM) + 1e-5f), rstd1 = 1.0f / sqrtf(wave_sum(q1) * (1.0f / DM) + 1e-5f);
#pragma unroll
        for (int j = 0; j < 8; ++j) { const f32x4 lg4 = LV(0, j), lb4 = LV(1, j); f32x4 sc4 = lg4, sh4 = lb4; if (layer == 0) { sc4 = LV(3 + vo, j); sh4 = LV(4 + vo, j); }
#pragma unroll
            for (int q = 0; q < 2; ++q) { const f32x4 x2 = v[q][j] * (q ? rstd1 : rstd0) * lg4 + lb4;
                if (layer == 1) *(GAS f32x4*)((GAS char*)(q ? xw1 : xw0) + l16 + j * 1024) = x2;
                else { u32x2 w; w.x = cvt_pk_bf16(x2[0], x2[1]); w.y = cvt_pk_bf16(x2[2], x2[3]); *(GAS u32x2*)((GAS char*)(q ? xw1 : xw0) + l8 + j * 512) = w;
                    const f32x4 h = x2 * sc4 + sh4; *(GAS unsigned*)((GAS char*)(q ? hp1 : hp0) + l4 + j * 256) = cvt4_fp8(h[0], h[1], h[2], h[3]); } } }
    }
#undef LV
    __syncthreads();
}
#undef LD4F
#undef LD4H
#undef LD4B
#undef UNI

__device__ __forceinline__ float dot128(const LAS float* q, const bf16_t* kp) {
    float s = 0.f;
#pragma unroll
    for (int c = 0; c < 16; ++c) { const u32x4 kv = *(const u32x4*)(kp + 8 * c); const f32x4 qa = *(const LAS f32x4*)(q + 8 * c), qb = *(const LAS f32x4*)(q + 8 * c + 4);
        s += (qa[0] * bf_lo(kv.x) + qa[1] * bf_hi(kv.x)) + (qa[2] * bf_lo(kv.y) + qa[3] * bf_hi(kv.y)) + (qb[0] * bf_lo(kv.z) + qb[1] * bf_hi(kv.z)) + (qb[2] * bf_lo(kv.w) + qb[3] * bf_hi(kv.w)); }
    return s;
}
__device__ __forceinline__ int naive_local_row(int mode, int b, int idx, int lo, int r0, int c0) {
    if (mode == 0) return b * PB + CTXL + lo + idx;
    if (mode == 1) return b * PB + CTXL + (r0 + (idx >> 4)) * GRIDW + c0 + (idx & 15);
    return b * PB + CTXL + idx;
}
__device__ __forceinline__ void naive_attn_task(KArgs a, int layer, int task, LAS float* wl, int lane) {
    const bf16_t* QKV = (const bf16_t*)(a->ws + WS_QKV); const bf16_t* QN = (const bf16_t*)(a->ws + WS_QN); bf16_t* O = (bf16_t*)(a->ws + WS_O); bf16_t* OD = (bf16_t*)(a->ws + WS_H);
    constexpr int NL = NB * 8 * SEQ, NX = NB * 8 * CTXL;
    int mode, idx;
    if (layer == 0) { if (task < NL) { mode = 0; idx = task; } else if (task < 2 * NL) { mode = 1; idx = task - NL; } else if (task < 2 * NL + NX) { mode = 2; idx = task - 2 * NL; } else { mode = 3; idx = task - 2 * NL - NX; } }
    else { if (task < NL) { mode = 4; idx = task; } else { mode = 5; idx = task - NL; } }
    const bool ctxq = (mode == 2 || mode == 3); const int nq = ctxq ? CTXL : SEQ;
    const int qi = idx % nq, h = (idx / nq) & 7, b = idx / (nq * 8);
    const int qrow = b * PB + (ctxq ? qi : CTXL + qi);
    const bool bfam = (mode == 1 || mode == 3);
    const int qcol = (bfam || mode == 5) ? 1536 + h * HD : h * HD;
    const int kcol = bfam ? 2560 + h * HD : (mode == 5 ? 2560 + h * HD : 1024 + (h >> 2) * HD);
    const int vcol = bfam ? 3584 + h * HD : (mode == 5 ? 3584 + (h >> 1) * 256 : 1280 + (h >> 2) * HD);
    LAS float* sc = wl; LAS float* qr = wl + 2304; LAS float* qn = wl + 2304 + 128;
    { const unsigned w = *((const unsigned*)(QKV + (size_t)qrow * NQKV + qcol) + lane); qr[2 * lane] = bf_lo(w); qr[2 * lane + 1] = bf_hi(w);
      unsigned w2 = w;
      if (mode == 0 || mode == 4) w2 = *((const unsigned*)(QN + (size_t)qrow * DM + h * HD) + lane);
      if (mode == 5) w2 = *((const unsigned*)(QN + (size_t)qrow * DM + 1024 + h * HD) + lane);
      qn[2 * lane] = bf_lo(w2); qn[2 * lane + 1] = bf_hi(w2); }
    LDS_WAIT();
    int nloc = 0, lo = 0, r0 = 0, c0 = 0; const int rq = qi >> 6, cq = qi & 63;
    if (mode == 0) { lo = max(0, qi - 128); const int hi = min(SEQ - 1, qi + 128); nloc = hi - lo + 1; }
    else if (mode == 1) { r0 = min(max(rq - 4, 0), 24); c0 = min(max(cq - 8, 0), 48); nloc = 128; }
    else if (mode >= 4) nloc = SEQ;
    float mx = -1e30f;
    for (int j = lane; j < CTXL; j += 64) { const float s = dot128(qn, QKV + (size_t)(b * PB + j) * NQKV + kcol) * SM_SCALE; sc[j] = s; mx = fmaxf(mx, s); }
    for (int j = lane; j < nloc; j += 64) { const int kr = naive_local_row(mode, b, j, lo, r0, c0);
        float s = dot128(qr, QKV + (size_t)kr * NQKV + kcol) * SM_SCALE;
        if (mode == 1) { const int krr = r0 + (j >> 4), kcc = c0 + (j & 15); s += a->in[13][h * 465 + (krr - rq + 7) * 31 + (kcc - cq + 15)]; }
        sc[CTXL + j] = s; mx = fmaxf(mx, s); }
    mx = wave_max(mx);
    const bool sink = (mode == 0 || mode == 2); const float sk = sink ? a->in[12][h] : 0.f;
    if (sink) mx = fmaxf(mx, sk);
    float sum = 0.f; const int ntot = CTXL + nloc;
    for (int j = lane; j < ntot; j += 64) { const float pp = __expf(sc[j] - mx); sc[j] = pp; sum += pp; }
    sum = wave_sum(sum); if (sink) sum += __expf(sk - mx);
    LDS_WAIT();
    const float inv = 1.0f / sum;
    if (mode != 5) {
        float a0 = 0.f, a1 = 0.f;
        for (int j = 0; j < ntot; ++j) { const int kr = (j < CTXL) ? b * PB + j : naive_local_row(mode, b, j - CTXL, lo, r0, c0);
            const float pp = sc[j]; const unsigned w = *((const unsigned*)(QKV + (size_t)kr * NQKV + vcol) + lane); a0 += pp * bf_lo(w); a1 += pp * bf_hi(w); }
        const int ocol = bfam ? 1024 + h * HD : h * HD;
        *((unsigned*)(O + (size_t)qrow * DM + ocol) + lane) = cvt_pk_bf16(a0 * inv, a1 * inv);
    } else {
        float a0 = 0.f, a1 = 0.f, a2 = 0.f, a3 = 0.f;
        for (int j = 0; j < ntot; ++j) { const int kr = (j < CTXL) ? b * PB + j : b * PB + j;
            const float pp = sc[j]; const u32x2 w = *((const u32x2*)(QKV + (size_t)kr * NQKV + vcol) + lane); a0 += pp * bf_lo(w.x); a1 += pp * bf_hi(w.x); a2 += pp * bf_lo(w.y); a3 += pp * bf_hi(w.y); }
        u32x2 o; o.x = cvt_pk_bf16(a0 * inv, a1 * inv); o.y = cvt_pk_bf16(a2 * inv, a3 * inv);
        *((u32x2*)(OD + (size_t)(h & 1) * MROWS * 1024 + (size_t)qrow * 1024 + (h >> 1) * 256) + lane) = o;
    }
    LDS_WAIT();
}
__device__ __noinline__ void phase_attn_naive(KArgs a, int layer, LAS unsigned char* lds, int lane, int wave, int gwv, int ngw) {
    LAS float* wl = (LAS float*)(lds + wave * 10240);
    const int ntask = (layer == 0) ? 2 * NB * 8 * SEQ + 2 * NB * 8 * CTXL : 2 * NB * 8 * SEQ;
    for (int t = gwv; t < ntask; t += ngw) naive_attn_task(a, layer, t, wl, lane);
}
namespace att {
constexpr int LDK8 = 1280, LDV8 = 1280;
constexpr int SHM_V = 64 * 128 * 2, SHM_K = 64 * 128 * 2;
constexpr int OFF_V = 0, OFF_K = 2 * SHM_V, OFF_WS = 2 * SHM_V + 2 * SHM_K, OFF_BT = OFF_WS + 8 * 256, ATT_LDS = OFF_BT + 2048;
constexpr float THR = 6.f;
constexpr float NEGM = -1e30f;
constexpr float OSCALE = att_OSCALE;
using s16x4 = __attribute__((ext_vector_type(4))) short;
#define KSWZ(row, colB) ((row) * 256 + ((colB) ^ (((row) & 7) << 4)))
#define SBAR() __builtin_amdgcn_sched_barrier(0)
__device__ __forceinline__ int crow(int r, int hi) { return (r & 3) + 8 * (r >> 2) + 4 * hi; }

__device__ __forceinline__ void partialSM(f32x16& p0, f32x16& p1, float& m_reg, float& mn, float& alpha) {
  constexpr float C = SM_SCALE * 1.4426950408889634f;
  float pmax = p0[0];
#pragma unroll
  for (int r = 1; r < 16; ++r) pmax = fmaxf(pmax, p0[r]);
#pragma unroll
  for (int r = 0; r < 16; ++r) pmax = fmaxf(pmax, p1[r]);
  { auto rr = __builtin_amdgcn_permlane32_swap(__float_as_uint(pmax), __float_as_uint(pmax), false, false);
    pmax = fmaxf(__uint_as_float(rr[0]), __uint_as_float(rr[1])); }
  if (__builtin_expect(__all(pmax - m_reg <= THR / SM_SCALE), 1)) { mn = m_reg; alpha = 1.f; }
  else { mn = fmaxf(m_reg, pmax); alpha = __builtin_amdgcn_exp2f((m_reg - mn) * C); m_reg = mn; }
  const float mnC = -mn * C;
#pragma unroll
  for (int r = 0; r < 16; ++r) p0[r] = fmaf(p0[r], C, mnC);
#pragma unroll
  for (int r = 0; r < 16; ++r) p1[r] = fmaf(p1[r], C, mnC);
#pragma unroll
  for (int r = 0; r < 16; ++r) p0[r] = __builtin_amdgcn_exp2f(p0[r]);
}
__device__ __forceinline__ void finishSM(f32x16& p0, f32x16& p1, float alpha, float& l_reg, bf16x8& pa0, bf16x8& pa1, bf16x8& pa2, bf16x8& pa3) {
#pragma unroll
  for (int r = 0; r < 16; ++r) p1[r] = __builtin_amdgcn_exp2f(p1[r]);
  float ps = 0;
#pragma unroll
  for (int r = 0; r < 16; ++r) ps += p0[r];
#pragma unroll
  for (int r = 0; r < 16; ++r) ps += p1[r];
  { auto rr = __builtin_amdgcn_permlane32_swap(__float_as_uint(ps), __float_as_uint(ps), false, false);
    ps = __uint_as_float(rr[0]) + __uint_as_float(rr[1]); }
  l_reg = l_reg * alpha + ps;
#define PK4(P, BASE, OUT) do { unsigned a0 = cvt_pk_bf16(P[BASE + 0], P[BASE + 1]), a1 = cvt_pk_bf16(P[BASE + 2], P[BASE + 3]);   \
    unsigned b0 = cvt_pk_bf16(P[BASE + 4], P[BASE + 5]), b1 = cvt_pk_bf16(P[BASE + 6], P[BASE + 7]);                              \
    auto r0 = __builtin_amdgcn_permlane32_swap(a0, b0, false, false); auto r1 = __builtin_amdgcn_permlane32_swap(a1, b1, false, false); \
    u32x4 w = {r0[0], r1[0], r0[1], r1[1]}; OUT = __builtin_bit_cast(bf16x8, w); } while (0)
  PK4(p0, 0, pa0); PK4(p0, 8, pa1); PK4(p1, 0, pa2); PK4(p1, 8, pa3);
#undef PK4
}
__device__ __forceinline__ void qkt(f32x16& p0, f32x16& p1, const LAS unsigned char* Ks, const bf16x8* qr, int r32, int hi) {
  p0 = f32x16{}; p1 = f32x16{};
#pragma unroll
  for (int d0 = 0; d0 < 8; ++d0) { const int cb = (d0 * 16 + hi * 8) * 2;
    const bf16x8 b0 = *(const LAS bf16x8*)(Ks + KSWZ(r32, cb));
    const bf16x8 b1 = *(const LAS bf16x8*)(Ks + KSWZ(32 + r32, cb));
    p0 = __builtin_amdgcn_mfma_f32_32x32x16_bf16(b0, qr[d0], p0, 0, 0, 0);
    p1 = __builtin_amdgcn_mfma_f32_32x32x16_bf16(b1, qr[d0], p1, 0, 0, 0); }
}
typedef int v8i_t __attribute__((ext_vector_type(8)));
typedef int v4i_t __attribute__((ext_vector_type(4)));
#define K8SWZ(row, cb) ((row) * 128 + (((((cb) >> 4) ^ (((row) >> 1) & 7))) << 4) + ((cb) & 15))
__device__ __forceinline__ void qkt8(f32x16& p0, f32x16& p1, const LAS unsigned char* Ks, const v8i_t* qr8, int r32, int hi) {
  p0 = f32x16{}; p1 = f32x16{};
#pragma unroll
  for (int s = 0; s < 2; ++s) { const int cb = 64 * s + 32 * hi;
    const v8i_t a0 = __builtin_shufflevector(*(const LAS v4i_t*)(Ks + K8SWZ(r32, cb)), *(const LAS v4i_t*)(Ks + K8SWZ(r32, cb + 16)), 0, 1, 2, 3, 4, 5, 6, 7);
    const v8i_t a1 = __builtin_shufflevector(*(const LAS v4i_t*)(Ks + K8SWZ(32 + r32, cb)), *(const LAS v4i_t*)(Ks + K8SWZ(32 + r32, cb + 16)), 0, 1, 2, 3, 4, 5, 6, 7);
    p0 = __builtin_amdgcn_mfma_scale_f32_32x32x64_f8f6f4(a0, qr8[s], p0, 0, 0, 0, 0, 0, 0);
    p1 = __builtin_amdgcn_mfma_scale_f32_32x32x64_f8f6f4(a1, qr8[s], p1, 0, 0, 0, 0, 0, 0); }
}
__device__ __forceinline__ int v_st(int k, int c) { const int kk = (k & ~0xC) | ((k & 4) << 1) | ((k & 8) >> 1); return ((kk >> 3) * 4 + (c >> 5)) * 512 + ((kk & 7) * 32 + (c & 31)) * 2; }
__device__ __forceinline__ int v_rd_base(int lane) { return ((lane & 3) << 3) | (((lane >> 2) & 3) << 6) | (((lane >> 4) & 1) << 5) | (((lane >> 5) & 1) << 8); }
constexpr int v_rd_off(int d0, int ks, int half) { return d0 * 512 + ks * 4096 + half * 2048; }
template <int OFF> __device__ __forceinline__ s16x4 tr_read(int vb) {
  s16x4 r; asm volatile("ds_read_b64_tr_b16 %0, %1 offset:%2" : "=&v"(r) : "v"(vb), "i"(OFF) : "memory"); return r;
}
template <int D0> __device__ __forceinline__ void pv_one(f32x16& od, int vb, bf16x8 pa0, bf16x8 pa1, bf16x8 pa2, bf16x8 pa3) {
  const s16x4 l0 = tr_read<v_rd_off(D0, 0, 0)>(vb), h0 = tr_read<v_rd_off(D0, 0, 1)>(vb), l1 = tr_read<v_rd_off(D0, 1, 0)>(vb), h1 = tr_read<v_rd_off(D0, 1, 1)>(vb);
  const s16x4 l2 = tr_read<v_rd_off(D0, 2, 0)>(vb), h2 = tr_read<v_rd_off(D0, 2, 1)>(vb), l3 = tr_read<v_rd_off(D0, 3, 0)>(vb), h3 = tr_read<v_rd_off(D0, 3, 1)>(vb);
  asm volatile("s_waitcnt lgkmcnt(0)" ::: "memory"); SBAR();
#define PK(L, H) (bf16x8){L[0], L[1], L[2], L[3], H[0], H[1], H[2], H[3]}
  od = __builtin_amdgcn_mfma_f32_32x32x16_bf16(pa0, PK(l0, h0), od, 0, 0, 0);
  od = __builtin_amdgcn_mfma_f32_32x32x16_bf16(pa1, PK(l1, h1), od, 0, 0, 0);
  od = __builtin_amdgcn_mfma_f32_32x32x16_bf16(pa2, PK(l2, h2), od, 0, 0, 0);
  od = __builtin_amdgcn_mfma_f32_32x32x16_bf16(pa3, PK(l3, h3), od, 0, 0, 0);
#undef PK
}
__device__ __forceinline__ void pv_d0(f32x16* o, int vb, bf16x8 pa0, bf16x8 pa1, bf16x8 pa2, bf16x8 pa3) {
  pv_one<0>(o[0], vb, pa0, pa1, pa2, pa3); pv_one<1>(o[1], vb, pa0, pa1, pa2, pa3); pv_one<2>(o[2], vb, pa0, pa1, pa2, pa3); pv_one<3>(o[3], vb, pa0, pa1, pa2, pa3);
}


__device__ __forceinline__ void finishSM8(f32x16& p0, f32x16& p1, float alpha, float& l_reg, v8i_t& pa) {
#pragma unroll
  for (int r = 0; r < 16; ++r) p1[r] = __builtin_amdgcn_exp2f(p1[r]);
  float ps = 0;
#pragma unroll
  for (int r = 0; r < 16; ++r) ps += p0[r];
#pragma unroll
  for (int r = 0; r < 16; ++r) ps += p1[r];
  { auto rr = __builtin_amdgcn_permlane32_swap(__float_as_uint(ps), __float_as_uint(ps), false, false);
    ps = __uint_as_float(rr[0]) + __uint_as_float(rr[1]); }
  l_reg = l_reg * alpha + ps;
  pa = (v8i_t){(int)cvt4_fp8(p0[0], p0[1], p0[2], p0[3]), (int)cvt4_fp8(p0[4], p0[5], p0[6], p0[7]), (int)cvt4_fp8(p0[8], p0[9], p0[10], p0[11]), (int)cvt4_fp8(p0[12], p0[13], p0[14], p0[15]),
               (int)cvt4_fp8(p1[0], p1[1], p1[2], p1[3]), (int)cvt4_fp8(p1[4], p1[5], p1[6], p1[7]), (int)cvt4_fp8(p1[8], p1[9], p1[10], p1[11]), (int)cvt4_fp8(p1[12], p1[13], p1[14], p1[15])};
}
template <int ND = 4>
__device__ __forceinline__ void pv8(f32x16* o, const LAS unsigned char* vlo, const LAS unsigned char* vhi, v8i_t pa) {
#pragma unroll
  for (int d0 = 0; d0 < ND; ++d0) {
    const v8i_t vb = __builtin_shufflevector(*(const LAS v4i_t*)(vlo + d0 * 2048), *(const LAS v4i_t*)(vhi + d0 * 2048), 0, 1, 2, 3, 4, 5, 6, 7);
    o[d0] = __builtin_amdgcn_mfma_scale_f32_32x32x64_f8f6f4(pa, vb, o[d0], 0, 0, 0, 0, 0, 0); }
}

struct UnitP {
  const unsigned char* Qn; const unsigned char* Qr; int ldqn, ldqr;
  const unsigned char* K; const unsigned char* V;
  int ctx_row0, loc_row0, nloc, NT;
  bf16_t* O; int ldo; int o8;
  float sink; int has_sink;
  int qpos0, kpos0;
  int R, rlo;
  int fuse; float lam; const bf16_t* O1; unsigned char* Oc;
  int qraw; const float* gq;
  int rot; const float* CS;
};
template <int MODE>
__device__ __forceinline__ void attn_unit(const UnitP& U, LAS unsigned char* lds, const int wid) {
  const int lane = lane_id(), tid = wid * 64 + lane, r32 = lane & 31, hi = lane >> 5;
  LAS unsigned char* V_lds = lds + OFF_V; LAS unsigned char* K_lds = lds + OFF_K;
  LAS float* wsf = (LAS float*)(lds + OFF_WS) + wid * 64; LAS float* li_l = wsf; LAS float* al_l = wsf + 32;
  const LAS float* bt = (const LAS float*)(lds + OFF_BT);
  float m_reg = -1e30f, l_reg = 0; f32x16 o[4] = {}; v8i_t qr8[2];
#define QLOAD(Qp, ldq) do { const unsigned char* Qw_ = (Qp) + (size_t)(wid * 32 + r32) * (ldq) + hi * 32; \
    _Pragma("unroll") for (int s_ = 0; s_ < 2; ++s_) qr8[s_] = __builtin_shufflevector(*(const v4i_t*)(Qw_ + s_ * 64), *(const v4i_t*)(Qw_ + s_ * 64 + 16), 0, 1, 2, 3, 4, 5, 6, 7); } while (0)
  bool qdone_ = false;
  if constexpr (MODE == 2) { if (U.qraw) { qdone_ = true;
    const unsigned char* Qw_ = U.Qn + (size_t)(wid * 32 + r32) * U.ldqn + hi * 64; u32x4 rw[2][4]; float ss = 0.f;
#pragma unroll
    for (int s_ = 0; s_ < 2; ++s_)
#pragma unroll
      for (int c_ = 0; c_ < 4; ++c_) rw[s_][c_] = *(const GAS u32x4*)((const GAS unsigned char*)Qw_ + s_ * 128 + c_ * 16);
#pragma unroll
    for (int s_ = 0; s_ < 2; ++s_)
#pragma unroll
      for (int c_ = 0; c_ < 4; ++c_)
#pragma unroll
        for (int k_ = 0; k_ < 4; ++k_) { const float x0 = bf_lo(rw[s_][c_][k_]), x1 = bf_hi(rw[s_][c_][k_]); ss += x0 * x0 + x1 * x1; }
    ss += __shfl_xor(ss, 32);
    const float rstd = 1.0f / sqrtf(ss * (1.0f / 128.0f) + 1e-6f);
#pragma unroll
    for (int s_ = 0; s_ < 2; ++s_)
#pragma unroll
      for (int c_ = 0; c_ < 4; ++c_) { const GAS float* g_ = (const GAS float*)U.gq + hi * 32 + 64 * s_ + 8 * c_; const f32x4 g0 = *(const GAS f32x4*)g_, g1 = *(const GAS f32x4*)(g_ + 4); const u32x4 w_ = rw[s_][c_];
        qr8[s_][2 * c_] = (int)cvt4_fp8(bf_lo(w_.x) * rstd * g0[0], bf_hi(w_.x) * rstd * g0[1], bf_lo(w_.y) * rstd * g0[2], bf_hi(w_.y) * rstd * g0[3]);
        qr8[s_][2 * c_ + 1] = (int)cvt4_fp8(bf_lo(w_.z) * rstd * g1[0], bf_hi(w_.z) * rstd * g1[1], bf_lo(w_.w) * rstd * g1[2], bf_hi(w_.w) * rstd * g1[3]); }
  } }
  if (!qdone_) QLOAD(U.Qn, U.ldqn);
  const int sr = tid >> 4, sc = (tid & 15) * 8;
  const int cgq = tid >> 4, kg = tid & 15;
  const int vwr = (4 * cgq) * 64 + ((((2 * (kg & 1) + (kg >> 3)) ^ (cgq & 3))) << 4) + ((kg & 7) >> 1) * 4;
  const int vsw = (r32 >> 2) & 3;
  const LAS unsigned char* vlo0 = V_lds + r32 * 64 + (((2 * hi) ^ vsw) << 4); const LAS unsigned char* vhi0 = V_lds + r32 * 64 + (((2 * hi + 1) ^ vsw) << 4);
  const unsigned char* Kh = U.K; const unsigned char* Vh = U.V;
  constexpr int SD = 2;
  u32x4 vsa, vsb; u32x2 ks0a, ks1a, ks0b, ks1b;
#define TROW(j) ((j) < 4 ? U.ctx_row0 + 64 * (j) : U.loc_row0 + 64 * (((j) - 4) < U.nloc ? ((j) - 4) : U.nloc - 1))
#define SLOAD_A(j) do { const size_t v_ = (size_t)(TROW(j) + 4 * kg) * LDV8 + 4 * cgq; vsa.x = *(const unsigned*)(Vh + v_); vsa.y = *(const unsigned*)(Vh + v_ + LDV8); vsa.z = *(const unsigned*)(Vh + v_ + 2 * LDV8); vsa.w = *(const unsigned*)(Vh + v_ + 3 * LDV8); const size_t k_ = (size_t)(TROW(j) + sr) * LDK8 + sc; ks0a = *(const u32x2*)(Kh + k_); ks1a = *(const u32x2*)(Kh + k_ + (size_t)32 * LDK8); } while (0)
#define SLOAD_B(j) do { const size_t v_ = (size_t)(TROW(j) + 4 * kg) * LDV8 + 4 * cgq; vsb.x = *(const unsigned*)(Vh + v_); vsb.y = *(const unsigned*)(Vh + v_ + LDV8); vsb.z = *(const unsigned*)(Vh + v_ + 2 * LDV8); vsb.w = *(const unsigned*)(Vh + v_ + 3 * LDV8); const size_t k_ = (size_t)(TROW(j) + sr) * LDK8 + sc; ks0b = *(const u32x2*)(Kh + k_); ks1b = *(const u32x2*)(Kh + k_ + (size_t)32 * LDK8); } while (0)
#define SWRITE_A(b) do { { const unsigned t0_ = __builtin_amdgcn_perm(vsa.y, vsa.x, 0x05010400u), t1_ = __builtin_amdgcn_perm(vsa.y, vsa.x, 0x07030602u), t2_ = __builtin_amdgcn_perm(vsa.w, vsa.z, 0x05010400u), t3_ = __builtin_amdgcn_perm(vsa.w, vsa.z, 0x07030602u); \
      LAS unsigned char* vp_ = V_lds + (b) * SHM_V + vwr; *(LAS unsigned*)(vp_) = __builtin_amdgcn_perm(t2_, t0_, 0x05040100u); *(LAS unsigned*)(vp_ + 64) = __builtin_amdgcn_perm(t2_, t0_, 0x07060302u); \
      *(LAS unsigned*)(vp_ + 128) = __builtin_amdgcn_perm(t3_, t1_, 0x05040100u); *(LAS unsigned*)(vp_ + 192) = __builtin_amdgcn_perm(t3_, t1_, 0x07060302u); } \
    *(LAS u32x2*)(K_lds + (b) * SHM_K + K8SWZ(sr, sc)) = ks0a; *(LAS u32x2*)(K_lds + (b) * SHM_K + K8SWZ(32 + sr, sc)) = ks1a; } while (0)
#define SWRITE_B(b) do { { const unsigned t0_ = __builtin_amdgcn_perm(vsb.y, vsb.x, 0x05010400u), t1_ = __builtin_amdgcn_perm(vsb.y, vsb.x, 0x07030602u), t2_ = __builtin_amdgcn_perm(vsb.w, vsb.z, 0x05010400u), t3_ = __builtin_amdgcn_perm(vsb.w, vsb.z, 0x07030602u); \
      LAS unsigned char* vp_ = V_lds + (b) * SHM_V + vwr; *(LAS unsigned*)(vp_) = __builtin_amdgcn_perm(t2_, t0_, 0x05040100u); *(LAS unsigned*)(vp_ + 64) = __builtin_amdgcn_perm(t2_, t0_, 0x07060302u); \
      *(LAS unsigned*)(vp_ + 128) = __builtin_amdgcn_perm(t3_, t1_, 0x05040100u); *(LAS unsigned*)(vp_ + 192) = __builtin_amdgcn_perm(t3_, t1_, 0x07060302u); } \
    *(LAS u32x2*)(K_lds + (b) * SHM_K + K8SWZ(sr, sc)) = ks0b; *(LAS u32x2*)(K_lds + (b) * SHM_K + K8SWZ(32 + sr, sc)) = ks1b; } while (0)
#define SLOAD_E(j) SLOAD_A(j)
#define SWRITE_E(b) SWRITE_A(b)
#define SLOAD_O(j) do { if constexpr (SD == 2) SLOAD_B(j); else SLOAD_A(j); } while (0)
#define SWRITE_O(b) do { if constexpr (SD == 2) SWRITE_B(b); else SWRITE_A(b); } while (0)
#define SWAIT() do { if constexpr (SD == 2) asm volatile("s_waitcnt vmcnt(6)" ::: "memory"); else asm volatile("s_waitcnt vmcnt(0)" ::: "memory"); } while (0)
#define RESC(a) do { if (__any((a) < 1.f)) { if (hi == 0) al_l[r32] = (a); asm volatile("s_waitcnt lgkmcnt(0)" ::: "memory"); \
    _Pragma("unroll") for (int d = 0; d < 4; ++d) _Pragma("unroll") for (int r = 0; r < 16; ++r) o[d][r] *= al_l[crow(r, hi)]; } } while (0)
  const int qrow_l = wid * 32 + r32;
  unsigned boff[8];
  if constexpr (MODE == 1) { const int cq = 32 * (wid & 1) + r32; int c0 = cq - 8; c0 = c0 < 0 ? 0 : (c0 > 48 ? 48 : c0);
#pragma unroll
    for (int g = 0; g < 8; ++g) { unsigned w = 0;
#pragma unroll
      for (int q = 0; q < 4; ++q) { const int r = (g & 3) * 4 + q; const int kc = 4 * hi + (r & 3) + 8 * (r >> 2) + 32 * (g >> 2);
        const unsigned byte = ((unsigned)(kc - c0) < 16u) ? (unsigned)(kc - cq + 15) : 31u; w |= byte << (8 * q); }
      boff[g] = w; } }
#define MASK(P0, P1, j) do { if ((j) >= 4) { const int jl_ = (j) - 4; \
    if constexpr (MODE == 0) { const int d0_ = U.kpos0 + 64 * jl_ + 4 * hi - (U.qpos0 + qrow_l); const int dw_ = U.kpos0 + 64 * jl_ - (U.qpos0 + wid * 32); \
      if (dw_ - 31 < -128 || dw_ + 63 > 128) _Pragma("unroll") for (int r = 0; r < 16; ++r) { const int d_ = d0_ + (r & 3) + 8 * (r >> 2); \
        if (d_ < -128 || d_ > 128) P0[r] = NEGM; if (d_ + 32 < -128 || d_ + 32 > 128) P1[r] = NEGM; } } \
    if constexpr (MODE == 1) { const int kr_ = U.rlo + jl_; const int rq_ = U.R + (wid >> 1); \
      int r0_ = rq_ - 4; r0_ = r0_ < 0 ? 0 : (r0_ > 24 ? 24 : r0_); \
      const bool rowok_ = (jl_ < U.nloc) && kr_ >= r0_ && kr_ <= r0_ + 7; \
      const LAS unsigned char* tb_ = (const LAS unsigned char*)bt + (rowok_ ? (kr_ - rq_ + 7) : 15) * 128; \
      _Pragma("unroll") for (int g = 0; g < 4; ++g) { SBAR(); \
        _Pragma("unroll") for (int q = 0; q < 4; ++q) { const int r = 4 * g + q; \
          const unsigned o0_ = __builtin_amdgcn_ubfe(boff[g], 8 * q, 8), o1_ = __builtin_amdgcn_ubfe(boff[4 + g], 8 * q, 8); \
          P0[r] += *(const LAS float*)(tb_ + o0_ * 4); P1[r] += *(const LAS float*)(tb_ + o1_ * 4); } \
        asm volatile("s_waitcnt lgkmcnt(0)" ::: "memory"); SBAR(); } } } } while (0)
#define QSWITCH(j) do { if ((j) == 4 && U.rot) { const float* cs_ = U.CS + ((size_t)(U.qpos0 + wid * 32 + r32) * 64 + 16 * hi) * 2; \
    _Pragma("unroll") for (int s_ = 0; s_ < 2; ++s_) _Pragma("unroll") for (int d_ = 0; d_ < 8; ++d_) { const f32x4 c4_ = *(const f32x4*)(cs_ + (32 * s_ + 2 * d_) * 2);   \
      const int w_ = qr8[s_][d_]; const f32x2 a_ = __builtin_amdgcn_cvt_pk_f32_fp8(w_, false), b_ = __builtin_amdgcn_cvt_pk_f32_fp8(w_, true); \
      int o_ = __builtin_amdgcn_cvt_pk_fp8_f32(a_.x * c4_[0] - a_.y * c4_[1], a_.x * c4_[1] + a_.y * c4_[0], 0, false); \
      o_ = __builtin_amdgcn_cvt_pk_fp8_f32(b_.x * c4_[2] - b_.y * c4_[3], b_.x * c4_[3] + b_.y * c4_[2], o_, true); qr8[s_][d_] = o_; } } } while (0)
  f32x16 pA0, pA1, pB0, pB1; float mnA, mnB, alA, alB; v8i_t pa; const int NT = U.NT;
  SLOAD_E(0); asm volatile("s_waitcnt vmcnt(0)" ::: "memory"); SWRITE_E(0); __syncthreads();
  qkt8(pA0, pA1, K_lds, qr8, r32, hi); partialSM(pA0, pA1, m_reg, mnA, alA);
  SLOAD_O(1); if constexpr (SD == 2) { if (2 < NT) SLOAD_E(2); }
  SWAIT(); SWRITE_O(1); __syncthreads();
  for (int j = 1; j + 1 < NT; j += 2) {
    QSWITCH(j);
    SBAR(); qkt8(pB0, pB1, K_lds + SHM_K, qr8, r32, hi); MASK(pB0, pB1, j);
    finishSM8(pA0, pA1, alA, l_reg, pa); SBAR();
    if constexpr (SD == 2) SLOAD_O(j + 2); else SLOAD_E(j + 1);
    SBAR();
    pv8(o, vlo0, vhi0, pa); partialSM(pB0, pB1, m_reg, mnB, alB);
    __syncthreads(); SWAIT(); SWRITE_E(0);
    RESC(alB); __syncthreads();
    QSWITCH(j + 1);
    SBAR(); qkt8(pA0, pA1, K_lds, qr8, r32, hi); MASK(pA0, pA1, j + 1);
    finishSM8(pB0, pB1, alB, l_reg, pa); SBAR();
    if constexpr (SD == 2) { if (j + 3 < NT) SLOAD_E(j + 3); } else SLOAD_O(j + 2);
    SBAR();
    pv8(o, vlo0 + SHM_V, vhi0 + SHM_V, pa); partialSM(pA0, pA1, m_reg, mnA, alA);
    __syncthreads(); SWAIT(); SWRITE_O(1);
    RESC(alA); __syncthreads();
  }
  QSWITCH(NT - 1);
  SBAR(); qkt8(pB0, pB1, K_lds + SHM_K, qr8, r32, hi); MASK(pB0, pB1, NT - 1);
  finishSM8(pA0, pA1, alA, l_reg, pa); SBAR();
  pv8(o, vlo0, vhi0, pa); partialSM(pB0, pB1, m_reg, mnB, alB);
  __syncthreads(); RESC(alB);
  finishSM8(pB0, pB1, alB, l_reg, pa); SBAR();
  pv8(o, vlo0 + SHM_V, vhi0 + SHM_V, pa);
  if (U.has_sink) l_reg += __builtin_amdgcn_exp2f(U.sink * 1.4426950408889634f - m_reg * (SM_SCALE * 1.4426950408889634f));
  if (hi == 0) li_l[r32] = l_reg; asm volatile("s_waitcnt lgkmcnt(0)" ::: "memory");
  if (U.o8) {
    LAS unsigned char* st = K_lds + wid * 4096;
#pragma unroll
    for (int r = 0; r < 16; ++r) {
      const float rl = __builtin_amdgcn_rcpf(li_l[crow(r, hi)]) * OSCALE; const int orow = crow(r, hi);
#pragma unroll
      for (int d0 = 0; d0 < 4; ++d0) { const float x = o[d0][r] * rl; st[orow * 128 + d0 * 32 + r32] = (unsigned char)__builtin_amdgcn_cvt_pk_fp8_f32(x, x, 0, false); }
    }
    asm volatile("s_waitcnt lgkmcnt(0)" ::: "memory");
    unsigned char* Ob8 = (unsigned char*)U.O; int ld8 = U.ldo; asm volatile("" : "+s"(Ob8), "+s"(ld8));
#pragma unroll
    for (int i4 = 0; i4 < 4; ++i4) { const int chunk = i4 * 64 + lane; const int row = chunk >> 3, cb = chunk & 7;
      *(GAS u32x4*)((GAS unsigned char*)Ob8 + (size_t)(wid * 32 + row) * ld8 + cb * 16) = *(const LAS u32x4*)(st + chunk * 16); }
  } else {
  bf16_t* Ob_ = U.O; int ldo_ = U.ldo; asm volatile("" : "+s"(Ob_), "+s"(ldo_));
  bf16_t* Ow = Ob_ + (size_t)(wid * 32) * ldo_;
  const bool odd = (lane & 1) != 0;
#pragma unroll
  for (int r = 0; r < 16; r += 2) {
    const float rl0 = __builtin_amdgcn_rcpf(li_l[crow(r, hi)]), rl1 = __builtin_amdgcn_rcpf(li_l[crow(r + 1, hi)]);
    const int orow = crow(odd ? r + 1 : r, hi);
#pragma unroll
    for (int d0 = 0; d0 < 4; ++d0) {
      const float x0 = o[d0][r] * rl0, x1 = o[d0][r + 1] * rl1;
      const float mine = odd ? x1 : x0, give = odd ? x0 : x1;
      const float got = __shfl_xor(give, 1);
      const unsigned w = cvt_pk_bf16(odd ? got : mine, odd ? mine : got);
      *(GAS unsigned*)((GAS bf16_t*)Ow + (size_t)orow * ldo_ + d0 * 32 + (r32 & ~1)) = w;
    }
  }
  }
  __syncthreads();
#undef TROW
#undef SLOAD_A
#undef SLOAD_B
#undef SWRITE_A
#undef SWRITE_B
#undef SWAIT
#undef SLOAD_E
#undef SLOAD_O
#undef SWRITE_E
#undef SWRITE_O
#undef RESC
#undef MASK
#undef QSWITCH
#undef QLOAD
}
template <int MODE, int NV = 1>
__device__ __forceinline__ void attn_unit_simple(const UnitP& U, LAS unsigned char* lds, const int wid) {
  const int lane = lane_id(), tid = wid * 64 + lane, r32 = lane & 31, hi = lane >> 5;
  LAS unsigned char* V_lds = lds + OFF_V; LAS unsigned char* K_lds = lds + OFF_K;
  LAS float* wsf = (LAS float*)(lds + OFF_WS) + wid * 64; LAS float* li_l = wsf; LAS float* al_l = wsf + 32;
  const LAS float* bt = (const LAS float*)(lds + OFF_BT);
  float m_reg = -1e30f, l_reg = 0; f32x16 o[4 * NV] = {}; v8i_t qr8[2];
#define QLOAD(Qp, ldq) do { const unsigned char* Qw_ = (Qp) + (size_t)(wid * 32 + r32) * (ldq) + hi * 32; \
    _Pragma("unroll") for (int s_ = 0; s_ < 2; ++s_) qr8[s_] = __builtin_shufflevector(*(const v4i_t*)(Qw_ + s_ * 64), *(const v4i_t*)(Qw_ + s_ * 64 + 16), 0, 1, 2, 3, 4, 5, 6, 7); } while (0)
  QLOAD(U.Qn, U.ldqn);
  const int sr = tid >> 4, sc = (tid & 15) * 8;
  const int cgq = tid >> 4, kg = tid & 15;
  const int vwr = (4 * cgq) * 64 + ((((2 * (kg & 1) + (kg >> 3)) ^ (cgq & 3))) << 4) + ((kg & 7) >> 1) * 4;
  const int vsw = (r32 >> 2) & 3;
  const LAS unsigned char* vlo0 = V_lds + r32 * 64 + (((2 * hi) ^ vsw) << 4); const LAS unsigned char* vhi0 = V_lds + r32 * 64 + (((2 * hi + 1) ^ vsw) << 4);
  const unsigned char* Kh = U.K; const unsigned char* Vh = U.V;
  constexpr int SD = 1;
  u32x4 vsa, vsb, vsa2; u32x2 ks0a, ks1a, ks0b, ks1b;
#define TROW(j) ((j) < 4 ? U.ctx_row0 + 64 * (j) : U.loc_row0 + 64 * (((j) - 4) < U.nloc ? ((j) - 4) : U.nloc - 1))
#define SLOAD_A(j) do { const size_t v_ = (size_t)(TROW(j) + 4 * kg) * LDV8 + 4 * cgq; vsa.x = *(const unsigned*)(Vh + v_); vsa.y = *(const unsigned*)(Vh + v_ + LDV8); vsa.z = *(const unsigned*)(Vh + v_ + 2 * LDV8); vsa.w = *(const unsigned*)(Vh + v_ + 3 * LDV8); if constexpr (NV == 2) { vsa2.x = *(const unsigned*)(Vh + v_ + 128); vsa2.y = *(const unsigned*)(Vh + v_ + LDV8 + 128); vsa2.z = *(const unsigned*)(Vh + v_ + 2 * LDV8 + 128); vsa2.w = *(const unsigned*)(Vh + v_ + 3 * LDV8 + 128); } const size_t k_ = (size_t)(TROW(j) + sr) * LDK8 + sc; ks0a = *(const u32x2*)(Kh + k_); ks1a = *(const u32x2*)(Kh + k_ + (size_t)32 * LDK8); } while (0)
#define SLOAD_B(j) do { const size_t v_ = (size_t)(TROW(j) + 4 * kg) * LDV8 + 4 * cgq; vsb.x = *(const unsigned*)(Vh + v_); vsb.y = *(const unsigned*)(Vh + v_ + LDV8); vsb.z = *(const unsigned*)(Vh + v_ + 2 * LDV8); vsb.w = *(const unsigned*)(Vh + v_ + 3 * LDV8); const size_t k_ = (size_t)(TROW(j) + sr) * LDK8 + sc; ks0b = *(const u32x2*)(Kh + k_); ks1b = *(const u32x2*)(Kh + k_ + (size_t)32 * LDK8); } while (0)
#define SWRITE_A(b) do { { const unsigned t0_ = __builtin_amdgcn_perm(vsa.y, vsa.x, 0x05010400u), t1_ = __builtin_amdgcn_perm(vsa.y, vsa.x, 0x07030602u), t2_ = __builtin_amdgcn_perm(vsa.w, vsa.z, 0x05010400u), t3_ = __builtin_amdgcn_perm(vsa.w, vsa.z, 0x07030602u); \
      LAS unsigned char* vp_ = V_lds + (b) * SHM_V + vwr; *(LAS unsigned*)(vp_) = __builtin_amdgcn_perm(t2_, t0_, 0x05040100u); *(LAS unsigned*)(vp_ + 64) = __builtin_amdgcn_perm(t2_, t0_, 0x07060302u); \
      *(LAS unsigned*)(vp_ + 128) = __builtin_amdgcn_perm(t3_, t1_, 0x05040100u); *(LAS unsigned*)(vp_ + 192) = __builtin_amdgcn_perm(t3_, t1_, 0x07060302u); } \
    if constexpr (NV == 2) { const unsigned t0_ = __builtin_amdgcn_perm(vsa2.y, vsa2.x, 0x05010400u), t1_ = __builtin_amdgcn_perm(vsa2.y, vsa2.x, 0x07030602u), t2_ = __builtin_amdgcn_perm(vsa2.w, vsa2.z, 0x05010400u), t3_ = __builtin_amdgcn_perm(vsa2.w, vsa2.z, 0x07030602u); \
      LAS unsigned char* vp_ = V_lds + (b) * SHM_V + vwr + 8192; *(LAS unsigned*)(vp_) = __builtin_amdgcn_perm(t2_, t0_, 0x05040100u); *(LAS unsigned*)(vp_ + 64) = __builtin_amdgcn_perm(t2_, t0_, 0x07060302u); \
      *(LAS unsigned*)(vp_ + 128) = __builtin_amdgcn_perm(t3_, t1_, 0x05040100u); *(LAS unsigned*)(vp_ + 192) = __builtin_amdgcn_perm(t3_, t1_, 0x07060302u); } \
    *(LAS u32x2*)(K_lds + (b) * SHM_K + K8SWZ(sr, sc)) = ks0a; *(LAS u32x2*)(K_lds + (b) * SHM_K + K8SWZ(32 + sr, sc)) = ks1a; } while (0)
#define SWRITE_B(b) do { { const unsigned t0_ = __builtin_amdgcn_perm(vsb.y, vsb.x, 0x05010400u), t1_ = __builtin_amdgcn_perm(vsb.y, vsb.x, 0x07030602u), t2_ = __builtin_amdgcn_perm(vsb.w, vsb.z, 0x05010400u), t3_ = __builtin_amdgcn_perm(vsb.w, vsb.z, 0x07030602u); \
      LAS unsigned char* vp_ = V_lds + (b) * SHM_V + vwr; *(LAS unsigned*)(vp_) = __builtin_amdgcn_perm(t2_, t0_, 0x05040100u); *(LAS unsigned*)(vp_ + 64) = __builtin_amdgcn_perm(t2_, t0_, 0x07060302u); \
      *(LAS unsigned*)(vp_ + 128) = __builtin_amdgcn_perm(t3_, t1_, 0x05040100u); *(LAS unsigned*)(vp_ + 192) = __builtin_amdgcn_perm(t3_, t1_, 0x07060302u); } \
    *(LAS u32x2*)(K_lds + (b) * SHM_K + K8SWZ(sr, sc)) = ks0b; *(LAS u32x2*)(K_lds + (b) * SHM_K + K8SWZ(32 + sr, sc)) = ks1b; } while (0)
#define SLOAD_E(j) SLOAD_A(j)
#define SWRITE_E(b) SWRITE_A(b)
#define SLOAD_O(j) do { if constexpr (SD == 2) SLOAD_B(j); else SLOAD_A(j); } while (0)
#define SWRITE_O(b) do { if constexpr (SD == 2) SWRITE_B(b); else SWRITE_A(b); } while (0)
#define SWAIT() do { if constexpr (SD == 2) asm volatile("s_waitcnt vmcnt(6)" ::: "memory"); else asm volatile("s_waitcnt vmcnt(0)" ::: "memory"); } while (0)
#define RESC(a) do { if (__any((a) < 1.f)) { if (hi == 0) al_l[r32] = (a); asm volatile("s_waitcnt lgkmcnt(0)" ::: "memory"); \
    _Pragma("unroll") for (int d = 0; d < 4 * NV; ++d) _Pragma("unroll") for (int r = 0; r < 16; ++r) o[d][r] *= al_l[crow(r, hi)]; } } while (0)
  const int qrow_l = wid * 32 + r32;
  unsigned boff[8];
  if constexpr (MODE == 1) { const int cq = 32 * (wid & 1) + r32; int c0 = cq - 8; c0 = c0 < 0 ? 0 : (c0 > 48 ? 48 : c0);
#pragma unroll
    for (int g = 0; g < 8; ++g) { unsigned w = 0;
#pragma unroll
      for (int q = 0; q < 4; ++q) { const int r = (g & 3) * 4 + q; const int kc = 4 * hi + (r & 3) + 8 * (r >> 2) + 32 * (g >> 2);
        const unsigned byte = ((unsigned)(kc - c0) < 16u) ? (unsigned)(kc - cq + 15) : 31u; w |= byte << (8 * q); }
      boff[g] = w; } }
#define MASK(P0, P1, j) do { if ((j) >= 4) { const int jl_ = (j) - 4; \
    if constexpr (MODE == 0) { const int d0_ = U.kpos0 + 64 * jl_ + 4 * hi - (U.qpos0 + qrow_l); const int dw_ = U.kpos0 + 64 * jl_ - (U.qpos0 + wid * 32); \
      if (dw_ - 31 < -128 || dw_ + 63 > 128) _Pragma("unroll") for (int r = 0; r < 16; ++r) { const int d_ = d0_ + (r & 3) + 8 * (r >> 2); \
        if (d_ < -128 || d_ > 128) P0[r] = NEGM; if (d_ + 32 < -128 || d_ + 32 > 128) P1[r] = NEGM; } } \
    if constexpr (MODE == 1) { const int kr_ = U.rlo + jl_; const int rq_ = U.R + (wid >> 1); \
      int r0_ = rq_ - 4; r0_ = r0_ < 0 ? 0 : (r0_ > 24 ? 24 : r0_); \
      const bool rowok_ = (jl_ < U.nloc) && kr_ >= r0_ && kr_ <= r0_ + 7; \
      const LAS unsigned char* tb_ = (const LAS unsigned char*)bt + (rowok_ ? (kr_ - rq_ + 7) : 15) * 128; \
      _Pragma("unroll") for (int g = 0; g < 4; ++g) { SBAR(); \
        _Pragma("unroll") for (int q = 0; q < 4; ++q) { const int r = 4 * g + q; \
          const unsigned o0_ = __builtin_amdgcn_ubfe(boff[g], 8 * q, 8), o1_ = __builtin_amdgcn_ubfe(boff[4 + g], 8 * q, 8); \
          P0[r] += *(const LAS float*)(tb_ + o0_ * 4); P1[r] += *(const LAS float*)(tb_ + o1_ * 4); } \
        asm volatile("s_waitcnt lgkmcnt(0)" ::: "memory"); SBAR(); } } } } while (0)
#define QSWITCH(j) do { if ((j) == 4 && U.rot) { const float* cs_ = U.CS + ((size_t)(U.qpos0 + wid * 32 + r32) * 64 + 16 * hi) * 2; \
    _Pragma("unroll") for (int s_ = 0; s_ < 2; ++s_) _Pragma("unroll") for (int d_ = 0; d_ < 8; ++d_) { const f32x4 c4_ = *(const f32x4*)(cs_ + (32 * s_ + 2 * d_) * 2);   \
      const int w_ = qr8[s_][d_]; const f32x2 a_ = __builtin_amdgcn_cvt_pk_f32_fp8(w_, false), b_ = __builtin_amdgcn_cvt_pk_f32_fp8(w_, true); \
      int o_ = __builtin_amdgcn_cvt_pk_fp8_f32(a_.x * c4_[0] - a_.y * c4_[1], a_.x * c4_[1] + a_.y * c4_[0], 0, false); \
      o_ = __builtin_amdgcn_cvt_pk_fp8_f32(b_.x * c4_[2] - b_.y * c4_[3], b_.x * c4_[3] + b_.y * c4_[2], o_, true); qr8[s_][d_] = o_; } } } while (0)
  f32x16 p0, p1; float mn, al; v8i_t pa; const int NT = U.NT;
  SLOAD_A(0);
  for (int j = 0; j < NT; ++j) {
    const int buf = j & 1;
    asm volatile("s_waitcnt vmcnt(0)" ::: "memory"); SWRITE_A(buf);
    if (j + 1 < NT) SLOAD_A(j + 1);
    __syncthreads();
    QSWITCH(j);
    bool live = true;
    if constexpr (MODE == 1) { if (j >= 4) { const int jl = j - 4, kr = U.rlo + jl, rq = U.R + (wid >> 1); int r0 = rq - 4; r0 = r0 < 0 ? 0 : (r0 > 24 ? 24 : r0); live = (jl < U.nloc) && kr >= r0 && kr <= r0 + 7; } }
    if (live) {
      qkt8(p0, p1, K_lds + buf * SHM_K, qr8, r32, hi); MASK(p0, p1, j);
      partialSM(p0, p1, m_reg, mn, al);
      finishSM8(p0, p1, al, l_reg, pa);
      RESC(al);
      pv8<4 * NV>(o, vlo0 + buf * SHM_V, vhi0 + buf * SHM_V, pa);
    }
  }
  if (U.has_sink) l_reg += __builtin_amdgcn_exp2f(U.sink * 1.4426950408889634f - m_reg * (SM_SCALE * 1.4426950408889634f));
  if (hi == 0) li_l[r32] = l_reg; asm volatile("s_waitcnt lgkmcnt(0)" ::: "memory");
  bool fused_ = false;
  if constexpr (NV == 2) { if (U.fuse) { fused_ = true;
    __syncthreads();
    LAS unsigned char* st = lds + (wid < 4 ? wid * 16384 : 69632 + (wid - 4) * 16384);
#pragma unroll
    for (int r = 0; r < 16; ++r) { const float rl = __builtin_amdgcn_rcpf(li_l[crow(r, hi)]); const int orow = crow(r, hi);
#pragma unroll
      for (int d0 = 0; d0 < 8; ++d0) *(LAS unsigned short*)(st + orow * 512 + (d0 * 32 + r32) * 2) = (unsigned short)cvt_pk_bf16(o[d0 < 4 * NV ? d0 : 0][r] * rl, 0.f); }
    const bf16_t* O1 = U.O1; unsigned char* Oc = U.Oc; const float lam = U.lam; asm volatile("" : "+s"(O1), "+s"(Oc));
    const int rsel = lane >> 5, cc = lane & 31;
    u32x4 w1[16];
#pragma unroll
    for (int it = 0; it < 16; ++it) w1[it] = *(const GAS u32x4*)((const GAS bf16_t*)O1 + (size_t)(wid * 32 + 2 * it + rsel) * 1024 + cc * 8);
    asm volatile("s_waitcnt lgkmcnt(0)" ::: "memory");
#pragma unroll
    for (int it = 0; it < 16; ++it) { const int row = 2 * it + rsel;
      const u32x4 a4 = *(const LAS u32x4*)(st + row * 512 + cc * 16); const u32x4 b4 = w1[it];
      const float e0 = bf_lo(a4.x) - lam * bf_lo(b4.x), e1 = bf_hi(a4.x) - lam * bf_hi(b4.x), e2 = bf_lo(a4.y) - lam * bf_lo(b4.y), e3 = bf_hi(a4.y) - lam * bf_hi(b4.y);
      const float e4 = bf_lo(a4.z) - lam * bf_lo(b4.z), e5 = bf_hi(a4.z) - lam * bf_hi(b4.z), e6 = bf_lo(a4.w) - lam * bf_lo(b4.w), e7 = bf_hi(a4.w) - lam * bf_hi(b4.w);
      float ss = ((e0 * e0 + e1 * e1) + (e2 * e2 + e3 * e3)) + ((e4 * e4 + e5 * e5) + (e6 * e6 + e7 * e7));
#pragma unroll
      for (int o_ = 1; o_ < 32; o_ <<= 1) ss += __shfl_xor(ss, o_);
      const float rs = (1.0f / sqrtf(ss * (1.0f / 256.0f) + 1e-6f)) * OSCALE;
      u32x2 ov; ov.x = cvt4_fp8(e0 * rs, e1 * rs, e2 * rs, e3 * rs); ov.y = cvt4_fp8(e4 * rs, e5 * rs, e6 * rs, e7 * rs);
      *(GAS u32x2*)((GAS unsigned char*)Oc + (size_t)(wid * 32 + row) * DM + cc * 8) = ov; }
  } }
  if (fused_) { } else
  if (NV == 1 && U.o8) {
    __syncthreads();
    LAS unsigned char* st = K_lds + wid * 4096;
#pragma unroll
    for (int r = 0; r < 16; ++r) {
      const float rl = __builtin_amdgcn_rcpf(li_l[crow(r, hi)]) * OSCALE; const int orow = crow(r, hi);
#pragma unroll
      for (int d0 = 0; d0 < 4; ++d0) { const float x = o[d0 < 4 * NV ? d0 : 0][r] * rl; st[orow * 128 + d0 * 32 + r32] = (unsigned char)__builtin_amdgcn_cvt_pk_fp8_f32(x, x, 0, false); }
    }
    asm volatile("s_waitcnt lgkmcnt(0)" ::: "memory");
    unsigned char* Ob8 = (unsigned char*)U.O; int ld8 = U.ldo; asm volatile("" : "+s"(Ob8), "+s"(ld8));
#pragma unroll
    for (int i4 = 0; i4 < 4; ++i4) { const int chunk = i4 * 64 + lane; const int row = chunk >> 3, cb = chunk & 7;
      *(GAS u32x4*)((GAS unsigned char*)Ob8 + (size_t)(wid * 32 + row) * ld8 + cb * 16) = *(const LAS u32x4*)(st + chunk * 16); }
  } else {
  bf16_t* Ob_ = U.O; int ldo_ = U.ldo; asm volatile("" : "+s"(Ob_), "+s"(ldo_));
  bf16_t* Ow = Ob_ + (size_t)(wid * 32) * ldo_;
  const bool odd = (lane & 1) != 0;
#pragma unroll
  for (int r = 0; r < 16; r += 2) {
    const float rl0 = __builtin_amdgcn_rcpf(li_l[crow(r, hi)]), rl1 = __builtin_amdgcn_rcpf(li_l[crow(r + 1, hi)]);
    const int orow = crow(odd ? r + 1 : r, hi);
#pragma unroll
    for (int d0 = 0; d0 < 4 * NV; ++d0) {
      const float x0 = o[d0][r] * rl0, x1 = o[d0][r + 1] * rl1;
      const float mine = odd ? x1 : x0, give = odd ? x0 : x1;
      const float got = __shfl_xor(give, 1);
      const unsigned w = cvt_pk_bf16(odd ? got : mine, odd ? mine : got);
      *(GAS unsigned*)((GAS bf16_t*)Ow + (size_t)orow * ldo_ + d0 * 32 + (r32 & ~1)) = w;
    }
  }
  }
  __syncthreads();
#undef TROW
#undef SLOAD_A
#undef SLOAD_B
#undef SWRITE_A
#undef SWRITE_B
#undef SWAIT
#undef SLOAD_E
#undef SLOAD_O
#undef SWRITE_E
#undef SWRITE_O
#undef RESC
#undef MASK
#undef QSWITCH
#undef QLOAD
}
#undef KSWZ
#undef SBAR
}

__device__ __forceinline__ void phase_attn0(KArgs a, LAS unsigned char* lds, int tid, int wave, int G, int vcu) {
  const unsigned char* QKV = (const unsigned char*)(a->ws + WS_Q8); const unsigned char* QN = (const unsigned char*)(a->ws + WS_QN); unsigned char* O = (unsigned char*)(a->ws + WS_O);
  const unsigned char* K8 = (const unsigned char*)(a->ws + WS_K8); const unsigned char* V8 = (const unsigned char*)(a->ws + WS_V8);
  LAS float* bt = (LAS float*)(lds + att::OFF_BT); const float* CSt = (const float*)(a->ws + WS_CS);
  int pos_ = 0; const int mypos = vcu % 9;
  for (int i_ = 0, u = vcu; i_ * G < 1024; ++i_, u = i_ * G + ((vcu + 2 * i_) % G)) {
    if (u >= 1024) break;
    if (pos_++ == mypos) conv_layer0_burst(a, lds, vcu, G, wave, lane_id());
    att::UnitP U; U.has_sink = 0; U.sink = 0.f; U.qpos0 = 0; U.kpos0 = 0; U.ldo = DM; U.o8 = 1; U.rot = 0; U.CS = CSt;
    const int qb = u & 7, h = (u >> 3) & 7, b = u >> 6; const int row0 = b * PB + CTXL + 256 * qb;
    { const int dr = tid >> 5, dc = tid & 31; bt[tid] = (dr < 15 && dc < 31) ? a->in[13][h * 465 + dr * 31 + dc] * (1.0f / SM_SCALE) : att::NEGM; }
    U.Qn = QKV + (size_t)row0 * NQKV + 1536 + h * HD; U.Qr = U.Qn; U.ldqn = NQKV; U.ldqr = NQKV;
    U.K = K8 + 256 + h * HD; U.V = V8 + 256 + h * HD;
    const int R = 4 * qb; int rlo = R - 4; rlo = rlo < 0 ? 0 : rlo; rlo = rlo > 24 ? 24 : rlo; int rh = R + 3 - 4; rh = rh < 0 ? 0 : (rh > 24 ? 24 : rh); const int rhi = rh + 7;
    U.R = R; U.rlo = rlo; U.nloc = rhi - rlo + 1; U.NT = 4 + ((U.nloc + 1) & ~1);
    U.ctx_row0 = b * PB; U.loc_row0 = b * PB + CTXL + 64 * rlo;
    U.O = (bf16_t*)(O + (size_t)row0 * DM + 1024 + h * HD);
    __syncthreads();
    att::attn_unit_simple<1>(U, lds, wave);
  }
  for (int i_ = 0, u = vcu; i_ * G < 1024; ++i_, u = i_ * G + ((vcu + 2 * i_) % G)) {
    if (u >= 1024) break;
    if (pos_++ == mypos) conv_layer0_burst(a, lds, vcu, G, wave, lane_id());
    att::UnitP U; U.R = 0; U.rlo = 0; U.ldo = DM; U.o8 = 1; U.rot = 1; U.CS = CSt; U.qraw = 0; U.gq = nullptr;
    const int qb = u & 7, h = (u >> 3) & 7, b = u >> 6; const int row0 = b * PB + CTXL + 256 * qb;
    U.Qn = QKV + (size_t)row0 * NQKV + h * HD; U.ldqn = NQKV; U.Qr = U.Qn; U.ldqr = NQKV;
    U.K = K8 + (h >> 2) * HD; U.V = V8 + (h >> 2) * HD;
    int tlo = 4 * qb - 2; tlo = tlo < 0 ? 0 : tlo; int thi = 4 * qb + 5; thi = thi > 31 ? 31 : thi;
    U.nloc = thi - tlo + 1; U.NT = 4 + U.nloc; U.qpos0 = 256 * qb; U.kpos0 = 64 * tlo;
    U.ctx_row0 = b * PB; U.loc_row0 = b * PB + CTXL + 64 * tlo;
    U.has_sink = 1; U.sink = a->in[12][h];
    U.O = (bf16_t*)(O + (size_t)row0 * DM + h * HD);
    att::attn_unit<0>(U, lds, wave);
  }
  for (int u = vcu; u < 256; u += G) {
    if (pos_++ == mypos) conv_layer0_burst(a, lds, vcu, G, wave, lane_id());
    att::UnitP U; U.qpos0 = 0; U.kpos0 = 0; U.R = 0; U.rlo = 0; U.ldo = DM; U.o8 = 1; U.rot = 0; U.CS = CSt; U.qraw = 0; U.gq = nullptr;
    const int hh = u & 15, b = u >> 4; const int row0 = b * PB; const bool fa = hh < 8; const int h = hh & 7;
    U.Qn = QKV + (size_t)row0 * NQKV + (fa ? h * HD : 1536 + h * HD); U.Qr = U.Qn; U.ldqn = NQKV; U.ldqr = NQKV;
    U.K = K8 + (fa ? (h >> 2) * HD : 256 + h * HD); U.V = V8 + (fa ? (h >> 2) * HD : 256 + h * HD);
    U.nloc = 1; U.NT = 4; U.ctx_row0 = b * PB; U.loc_row0 = b * PB;
    U.has_sink = fa ? 1 : 0; U.sink = fa ? a->in[12][h] : 0.f;
    U.O = (bf16_t*)(O + (size_t)row0 * DM + (fa ? h * HD : 1024 + h * HD));
    att::attn_unit<2>(U, lds, wave);
  }
  if (pos_ <= mypos) conv_layer0_burst(a, lds, vcu, G, wave, lane_id());
}
__device__ __forceinline__ void phase_attn1(KArgs a, LAS unsigned char* lds, int tid, int wave, int G, int vcu) {
  const unsigned char* QKV = (const unsigned char*)(a->ws + WS_Q8); const unsigned char* QN = (const unsigned char*)(a->ws + WS_QN); unsigned char* O = (unsigned char*)(a->ws + WS_O); bf16_t* OD = (bf16_t*)(a->ws + WS_H);
  const unsigned char* K8 = (const unsigned char*)(a->ws + WS_K8); const unsigned char* V8 = (const unsigned char*)(a->ws + WS_V8); const float* CSt = (const float*)(a->ws + WS_CS);
  for (int u = vcu; u < 1024; u += G) {
    att::UnitP U; U.has_sink = 0; U.sink = 0.f; U.qpos0 = 0; U.kpos0 = 0; U.R = 0; U.rlo = 0; U.nloc = 32; U.NT = 36; U.rot = 1; U.CS = CSt;
    const int qb = u & 7, h = (u >> 3) & 7, b = u >> 6; const int row0 = b * PB + CTXL + 256 * qb;
    U.Qn = (const unsigned char*)(a->ws + WS_QKV) + ((size_t)row0 * 1280 + h * HD) * 2; U.ldqn = 2560; U.Qr = U.Qn; U.ldqr = 2560; U.qpos0 = 256 * qb; U.qraw = 1; U.gq = a->in[16];
    U.K = K8 + (h >> 2) * HD; U.V = V8 + (h >> 2) * HD;
    U.ctx_row0 = b * PB; U.loc_row0 = b * PB + CTXL;
    U.O = (bf16_t*)(O + (size_t)row0 * DM + h * HD); U.ldo = DM; U.o8 = 1;
    att::attn_unit<2>(U, lds, wave);
  }
  float lam;
  { const int lane = lane_id(); const f32x2 q1 = *(const f32x2*)(a->in[18] + 2 * lane), k1 = *(const f32x2*)(a->in[19] + 2 * lane), q2 = *(const f32x2*)(a->in[20] + 2 * lane), k2 = *(const f32x2*)(a->in[21] + 2 * lane);
    const float d1 = wave_sum(q1.x * k1.x + q1.y * k1.y), d2 = wave_sum(q2.x * k2.x + q2.y * k2.y); lam = __uint_as_float(__builtin_amdgcn_readfirstlane(__float_as_uint(expf(d1) - expf(d2) + LAMBDA_INIT1))); }
  for (int pu = vcu; pu < 512; pu += G) {
    const int qb = pu & 7, j = (pu >> 3) & 3, b = pu >> 5; const int row0 = b * PB + CTXL + 256 * qb;
#pragma clang loop unroll(disable)
    for (int s = 1; s >= 0; --s) { const int hd = 2 * j + s;
      att::UnitP U; U.has_sink = 0; U.sink = 0.f; U.qpos0 = 0; U.kpos0 = 0; U.R = 0; U.rlo = 0; U.nloc = 32; U.NT = 36; U.rot = 1; U.CS = CSt;
      U.Qn = QKV + (size_t)row0 * NQKV + 1536 + hd * HD; U.ldqn = NQKV; U.Qr = U.Qn; U.ldqr = NQKV; U.qpos0 = 256 * qb;
      U.K = K8 + 256 + hd * HD; U.V = V8 + 256 + j * 256;
      U.ctx_row0 = b * PB; U.loc_row0 = b * PB + CTXL;
      U.O1 = OD + (size_t)MROWS * 1024 + (size_t)row0 * 1024 + j * 256; U.O = (bf16_t*)U.O1; U.ldo = 1024; U.o8 = 0;
      U.fuse = (s == 0) ? 1 : 0; U.lam = lam; U.Oc = O + (size_t)row0 * DM + 1024 + j * 256;
      att::attn_unit_simple<2, 2>(U, lds, wave);
    }
  }
}
constexpr int NPHASE = 20;
__host__ __device__ __forceinline__ bool phase_active(int k) { return !(k == 3 || k == 5); }

__device__ __forceinline__ void moe_tables(KArgs a, int layer, LAS int* tb, int tid) {
    if (tid < 16) tb[17 + tid] = (int)__hip_atomic_load((unsigned*)(a->ws + WS_CTL) + CW_CNT + (layer * 16 + tid) * 64, __ATOMIC_RELAXED, __HIP_MEMORY_SCOPE_AGENT);
    __syncthreads();
    if (tid == 0) { int base = 0; for (int e = 0; e < 16; ++e) { tb[e] = base; const int nt = (tb[17 + e] + 255) >> 8; for (int t = 0; t < nt; ++t) tb[33 + base + t] = e; base += nt; } tb[16] = base; }
    __syncthreads();
}


#if MK_MULTI
#define PH_KERNEL_HEAD extern __shared__ __attribute__((aligned(16))) unsigned char lds_raw[]; LAS unsigned char* lds = (LAS unsigned char*)lds_raw; KArgs a = kargs(); \
    const int l = a->ph_lo; const int wave = __builtin_amdgcn_readfirstlane(threadIdx.x >> 6), lane = lane_id(), tid = wave * 64 + lane; const int G = gridDim.x, bx = blockIdx.x; \
    const int vcu = (G % 8 == 0) ? (bx % 8) * (G / 8) + bx / 8 : bx; const int gwv = bx * 8 + wave, ngw = G * 8; (void)l; (void)lane; (void)vcu; (void)gwv; (void)ngw; (void)lds;
__global__ void __launch_bounds__(512, 2) k_pro(Args kparam) { PH_KERNEL_HEAD phase_prologue(a, lds, tid, lane, wave, G); }
__global__ void __launch_bounds__(512, 2) k_h0(Args kparam) { PH_KERNEL_HEAD phase_h0(a, lds, tid, lane, wave); }
__global__ void __launch_bounds__(512, 2) k_inproj(Args kparam) { PH_KERNEL_HEAD
    pg8::DenseOrder S; S.init(a->ws + WS_H, a->ws + WS_WIN + (size_t)l * NQKV * DM, DM / 2, NQKV, l == 1 ? 2 : 0, G, bx);
    pg8::EpiQKV E{(bf16_t*)(a->ws + WS_QKV), (unsigned char*)(a->ws + WS_Q8), (unsigned char*)(a->ws + WS_QN), (const float*)(a->ws + WS_CS), l == 0 ? 0x10u : 0x3C00u, 0u, l == 0 ? 0x3C10u : 0x3C00u, l == 0 ? 0u : 0x1Fu,     (unsigned char*)(a->ws + WS_K8), (unsigned char*)(a->ws + WS_V8), false};
    pg8::gemm_phase<pg8::EpiQKV, pg8::DenseOrder, true>(lds, DM / 2, S, E, wave); }
__global__ void __launch_bounds__(512, 2) k_prep(Args kparam) { PH_KERNEL_HEAD phase_prep(a, lane, gwv, ngw); }
#if NAIVE_ATTN
__global__ void __launch_bounds__(512, 2) k_attn(Args kparam) { PH_KERNEL_HEAD phase_attn_naive(a, l, lds, lane, wave, gwv, ngw); }
#else
__global__ void __launch_bounds__(512, 2) k_attn(Args kparam) { PH_KERNEL_HEAD if (l == 0) phase_attn0(a, lds, tid, wave, G, vcu); else phase_attn1(a, lds, tid, wave, G, vcu); }
#endif
__global__ void __launch_bounds__(512, 2) k_combine(Args kparam) { PH_KERNEL_HEAD phase_combine(a, lane, gwv, ngw); }
__global__ void __launch_bounds__(512, 2) k_outproj(Args kparam) { PH_KERNEL_HEAD
    pg8::DenseOrder S; S.init(a->ws + WS_O, a->ws + WS_WOUT + (size_t)l * DM * DM, DM / 2, DM, l == 1 ? 1 : 0, G, bx);
    pg8::EpiPlain E{(unsigned char*)(a->ws + WS_QKV), DM, Y8SCALE / (W8SCALE * att_OSCALE), false};
    pg8::gemm_phase<pg8::EpiPlain, pg8::DenseOrder, true>(lds, DM / 2, S, E, wave); }
__global__ void __launch_bounds__(512, 2) k_ln1(Args kparam) { PH_KERNEL_HEAD phase_ln1(a, l, lds, tid, lane, gwv, ngw); }
__global__ void __launch_bounds__(512, 2) k_moe1(Args kparam) { PH_KERNEL_HEAD
    LAS int* tb = (LAS int*)(lds + TB_OFF); moe_tables(a, l, tb, tid);
    pg8::GroupedOrder<true> S{(const char*)(a->ws + WS_H), (const char*)(a->ws + WS_WGU + (size_t)l * 16 * DM * DM), DM / 2, (size_t)DM * DM, (const int*)(a->ws + WS_LIST), tb, G, vcu};
    pg8::EpiSwiGLU E{(unsigned char*)(a->ws + WS_O)};
    pg8::gemm_phase<pg8::EpiSwiGLU, pg8::GroupedOrder<true>, true>(lds, DM / 2, S, E, wave); }
__global__ void __launch_bounds__(512, 2) k_moe2(Args kparam) { PH_KERNEL_HEAD
    LAS int* tb = (LAS int*)(lds + TB_OFF); moe_tables(a, l, tb, tid);
    pg8::GroupedOrder<false> S{(const char*)(a->ws + WS_O), (const char*)(a->ws + WS_WD + (size_t)l * 16 * DM * FF), FF / 2, (size_t)DM * FF, (const int*)(a->ws + WS_LIST), tb, G, vcu};
    pg8::EpiSlots E{(unsigned char*)(a->ws + WS_QKV)};
    pg8::gemm_phase<pg8::EpiSlots, pg8::GroupedOrder<false>, true>(lds, FF / 2, S, E, wave); }
__global__ void __launch_bounds__(512, 2) k_ln2(Args kparam) { PH_KERNEL_HEAD phase_ln2(a, l, lds, tid, lane, gwv, ngw); }
typedef void (*phase_kernel_t)(Args);
#endif
#if !MK_MULTI
#if STAMP_PHASE >= 0
#define STAMP(k) do { if (blockIdx.x == 0 && wave == 0 && lane_id() == 0) { volatile LAS unsigned long long* ts_ = (volatile LAS unsigned long long*)(lds + MISC_OFF - 512); const unsigned long long now_ = __builtin_amdgcn_s_memrealtime(); \
    if ((k) == 31) ts_[32] = now_; else { ts_[(k)] = now_ - ts_[32]; ts_[32] = now_; } } } while (0)
#else
#define STAMP(k) do { } while (0)
#endif
template <int L>
__device__ __forceinline__ void layer_phases(LAS unsigned char* lds, const XcdBarrier& bar, const int lo, const int hi, const int wave) {
    constexpr int l = L, pb = 2 + 9 * L;
    const int G = gridDim.x, bx = blockIdx.x;
    const int vcu = (G % 8 == 0) ? (bx % 8) * (G / 8) + bx / 8 : bx;
    const int gwv = bx * 8 + wave, ngw = G * 8;
#define IN(k) (lo <= (k) && (k) < hi)
#define PHASE_END(k) do { if (hi > (k) + 1) xcd_barrier(bar); STAMP(k); } while (0)
#define PH_BEGIN(k) for (int rep_ = 0; rep_ <= ((REP_MASK >> (k)) & 1); ++rep_) { const bool dry_ = rep_ < ((REP_MASK >> (k)) & 1); (void)dry_; KArgs a = kargs(); const int lane = lane_id(), tid = wave * 64 + lane; (void)tid; (void)lane;
#define PH_END(k) if (rep_ < ((REP_MASK >> (k)) & 1)) xcd_barrier(bar); } PHASE_END(k);
    if (IN(pb + 0)) { PH_BEGIN(pb + 0)
        pg8::DenseOrder S; S.init(a->ws + WS_H, a->ws + WS_WIN + (size_t)l * NQKV * DM, DM / 2, NQKV, l == 1 ? 2 : 0, G, bx);
        pg8::EpiQKV E{(bf16_t*)(a->ws + WS_QKV), (unsigned char*)(a->ws + WS_Q8), (unsigned char*)(a->ws + WS_QN), (const float*)(a->ws + WS_CS), l == 0 ? 0x10u : 0x3C00u, 0u, l == 0 ? 0x3C10u : 0x3C00u, l == 0 ? 0u : 0x1Fu,     (unsigned char*)(a->ws + WS_K8), (unsigned char*)(a->ws + WS_V8), dry_};
        pg8::gemm_phase<pg8::EpiQKV, pg8::DenseOrder, true>(lds, DM / 2, S, E, wave, dry_);
        if constexpr (L == 0) deferred_items(a, lds, 0, bx, S.ntot, G, wave, lane);
        PH_END(pb + 0) }
    if (l == 1 && IN(pb + 1)) { PH_BEGIN(pb + 1) phase_prep(a, lane, gwv, ngw); PH_END(pb + 1) }
    if (IN(pb + 2)) { PH_BEGIN(pb + 2)
#if NAIVE_ATTN
        phase_attn_naive(a, l, lds, lane, wave, gwv, ngw);
#else
        if (l == 0) phase_attn0(a, lds, tid, wave, G, vcu); else phase_attn1(a, lds, tid, wave, G, vcu);
#endif
        PH_END(pb + 2) }
    if (IN(pb + 4)) { PH_BEGIN(pb + 4)
        pg8::DenseOrder S; S.init(a->ws + WS_O, a->ws + WS_WOUT + (size_t)l * DM * DM, DM / 2, DM, l == 1 ? 1 : 0, G, bx);
        pg8::EpiPlain E{(unsigned char*)(a->ws + WS_QKV), DM, Y8SCALE / (W8SCALE * att_OSCALE), dry_};
        pg8::gemm_phase<pg8::EpiPlain, pg8::DenseOrder, true>(lds, DM / 2, S, E, wave, dry_);
        if constexpr (L == 0) deferred_items(a, lds, 1, bx, S.ntot, G, wave, lane);
        PH_END(pb + 4) }
    if (IN(pb + 5)) { PH_BEGIN(pb + 5) phase_ln1(a, l, lds, tid, lane, gwv, ngw, rep_ < ((REP_MASK >> (pb + 5)) & 1)); PH_END(pb + 5) }
    if (IN(pb + 6)) { PH_BEGIN(pb + 6)
        LAS int* tb = (LAS int*)(lds + TB_OFF); moe_tables(a, l, tb, tid);
        pg8::GroupedOrder<true> S{(const char*)(a->ws + WS_H), (const char*)(a->ws + WS_WGU + (size_t)l * 16 * DM * DM), DM / 2, (size_t)DM * DM, (const int*)(a->ws + WS_LIST), tb, G, vcu};
        pg8::EpiSwiGLU E{(unsigned char*)(a->ws + WS_O)};
        pg8::gemm_phase<pg8::EpiSwiGLU, pg8::GroupedOrder<true>, true>(lds, DM / 2, S, E, wave, dry_);
        if constexpr (L == 0) deferred_items(a, lds, 2, vcu, tb[16] * 8, G, wave, lane);
        PH_END(pb + 6) }
    if (IN(pb + 7)) { PH_BEGIN(pb + 7)
        LAS int* tb = (LAS int*)(lds + TB_OFF); moe_tables(a, l, tb, tid);
        pg8::GroupedOrder<false> S{(const char*)(a->ws + WS_O), (const char*)(a->ws + WS_WD + (size_t)l * 16 * DM * FF), FF / 2, (size_t)DM * FF, (const int*)(a->ws + WS_LIST), tb, G, vcu};
        pg8::EpiSlots E{(unsigned char*)(a->ws + WS_QKV)};
        pg8::gemm_phase<pg8::EpiSlots, pg8::GroupedOrder<false>, true>(lds, FF / 2, S, E, wave, dry_);
        if constexpr (L == 0) deferred_items(a, lds, 3, vcu, tb[16] * 8, G, wave, lane);
        PH_END(pb + 7) }
    if (IN(pb + 8)) { PH_BEGIN(pb + 8) phase_ln2(a, l, lds, tid, lane, gwv, ngw, rep_ < ((REP_MASK >> (pb + 8)) & 1)); PH_END(pb + 8) }
#undef IN
#undef PHASE_END
#undef PH_BEGIN
#undef PH_END
}
__global__ void __launch_bounds__(512, 2) mk_fwd(Args kparam) {
    extern __shared__ __attribute__((aligned(16))) unsigned char lds_raw[];
    LAS unsigned char* lds = (LAS unsigned char*)lds_raw;
    const int wave = __builtin_amdgcn_readfirstlane((int)(threadIdx.x >> 6));
    const int G = gridDim.x, bx = blockIdx.x;
    volatile LAS unsigned* MISC = (volatile LAS unsigned*)(lds + MISC_OFF);
    if (wave == 0 && lane_id() < 4) MISC[lane_id()] = 0u;
    __syncthreads();
    XcdBarrier bar = xcd_barrier_post((unsigned*)(kargs()->ws + WS_CTL) + CW_BAR, MISC, wave);
    const int lo = kargs()->ph_lo, hi = kargs()->ph_hi;
#define IN(k) (lo <= (k) && (k) < hi)
#define PHASE_END(k) do { if (hi > (k) + 1) xcd_barrier(bar); STAMP(k); } while (0)
    STAMP(31);

    if (IN(0)) { for (int rep_ = 0; rep_ <= (REP_MASK & 1); ++rep_) { KArgs a = kargs(); const int lane = lane_id(); phase_prologue(a, lds, wave * 64 + lane, lane, wave, G); if (rep_ < (REP_MASK & 1)) xcd_barrier(bar); } STAMP(0); }
    if (IN(1)) { KArgs a = kargs(); { const int lane = lane_id(); phase_h0(a, lds, wave * 64 + lane, lane, wave); } PHASE_END(1); }
    for (int xb_ = 0; xb_ < BAR_PROBE; ++xb_) xcd_barrier(bar);

    layer_phases<0>(lds, bar, lo, hi, wave);
    layer_phases<1>(lds, bar, lo, hi, wave);
#if STAMP_PHASE >= 0
    { xcd_barrier(bar); STAMP(19);
      float* cw = (float*)(kargs()->ws + WS_CTL) + 3000;
      if (blockIdx.x == 0 && wave == 0 && lane_id() == 0) { volatile LAS unsigned long long* ts_ = (volatile LAS unsigned long long*)(lds + MISC_OFF - 512); __hip_atomic_store(cw, floorf(((float)ts_[STAMP_PHASE] * 0.01f + STAMP_OFS) * (1.0f / STAMP_BIN)), __ATOMIC_RELAXED, __HIP_MEMORY_SCOPE_AGENT);     }
      xcd_barrier(bar);
      const float c = __hip_atomic_load(cw, __ATOMIC_RELAXED, __HIP_MEMORY_SCOPE_AGENT); float* o = kargs()->out; const int lane = lane_id();
      for (size_t i = (size_t)(blockIdx.x * 512 + wave * 64 + lane) * 4; i < (size_t)NB * SEQ * DM; i += (size_t)gridDim.x * 512 * 4) *(f32x4*)(o + i) = (f32x4){c, c, c, c}; }
#endif
#undef IN
#undef PHASE_END
}

#endif

extern "C" void kernel_launch(void* const* d_in, const int* in_sizes, int n_in, void* d_out, int out_size, void* d_ws, size_t ws_size, hipStream_t stream) {
    static int grid = 0;
    if (grid == 0) {
        if (n_in != 28 || out_size != NB * SEQ * DM || ws_size < WS_END) { fprintf(stderr, "kernel_launch: shape/workspace mismatch (n_in %d out %d ws %zu need %zu)\n", n_in, out_size, ws_size, (size_t)WS_END); grid = -1; return; }
        int dev = 0, cus = 0;
        if (hipGetDevice(&dev) != hipSuccess || hipDeviceGetAttribute(&cus, hipDeviceAttributeMultiprocessorCount, dev) != hipSuccess) { grid = -1; return; }
#if MK_MULTI
        const void* ks[] = {(const void*)k_pro, (const void*)k_h0, (const void*)k_inproj, (const void*)k_prep, (const void*)k_attn, (const void*)k_combine, (const void*)k_outproj, (const void*)k_ln1, (const void*)k_moe1, (const void*)k_moe2, (const void*)k_ln2};
        for (int i = 0; i < 11; ++i) if (hipFuncSetAttribute(ks[i], hipFuncAttributeMaxDynamicSharedMemorySize, LDS_BYTES) != hipSuccess) { fprintf(stderr, "kernel_launch: hipFuncSetAttribute failed\n"); grid = -1; return; }
#else
        if (hipFuncSetAttribute((const void*)mk_fwd, hipFuncAttributeMaxDynamicSharedMemorySize, LDS_BYTES) != hipSuccess) { fprintf(stderr, "kernel_launch: hipFuncSetAttribute failed\n"); grid = -1; return; }
        int per_cu = 0;
        if (hipOccupancyMaxActiveBlocksPerMultiprocessor(&per_cu, (const void*)mk_fwd, 512, LDS_BYTES) != hipSuccess || per_cu < 1) fprintf(stderr, "kernel_launch: occupancy query says %d\n", per_cu);
        (void)hipGetLastError();
#endif
        grid = cus;
    }
    if (grid < 0) return;
    (void)hipMemsetAsync((char*)d_ws + WS_CTL, 0, CTL_BYTES, stream);
    Args a{};
    for (int i = 0; i < 28; ++i) a.in[i] = (const float*)d_in[i];
    a.out = (float*)d_out; a.ws = (unsigned char*)d_ws;
#if MK_MULTI
    {
        const phase_kernel_t seq[9] = {k_inproj, k_prep, k_attn, k_combine, k_outproj, k_ln1, k_moe1, k_moe2, k_ln2};
        a.ph_lo = 0; a.ph_hi = 0;
        hipLaunchKernelGGL(k_pro, dim3(grid), dim3(512), LDS_BYTES, stream, a);
        hipLaunchKernelGGL(k_h0, dim3(grid), dim3(512), LDS_BYTES, stream, a);
        for (int l = 0; l < 2; ++l) for (int j = 0; j < 9; ++j) { if (j == 3 || (l == 0 && j == 1)) continue; a.ph_lo = l; a.ph_hi = l; hipLaunchKernelGGL(seq[j], dim3(grid), dim3(512), LDS_BYTES, stream, a); }
    }
#else
    a.ph_lo = 0; a.ph_hi = NPHASE; hipLaunchKernelGGL(mk_fwd, dim3(grid), dim3(512), LDS_BYTES, stream, a);
#endif
    const hipError_t le = hipPeekAtLastError();
    if (le != hipSuccess) fprintf(stderr, "kernel_launch: launch failed: %s\n", hipGetErrorName(le));
}
```
